# Optimizing an MI355X kernel written in HIP

```python
import jax
import jax.numpy as jnp
from jax import lax
import numpy as np

D_MODEL = 2048
BATCH = 1
SEQ = 8192
DEPTH = 1

CHUNK = 64
PLE_DIM = 256
D_FF = 5632
GDN_HEADS = 8
GDN_DK = 128
GDN_DV = 128
GDN_QKV = 2 * GDN_HEADS * GDN_DK + GDN_HEADS * GDN_DV
GDN_W = GDN_HEADS * GDN_DV
CONV_K = 4
ATT_HEADS = 8
ATT_DH = 128
ATT_W = ATT_HEADS * ATT_DH
LEFT_CHUNKS = 8
BAND = (LEFT_CHUNKS + 1) * CHUNK
MAX_REL = 128
N_REL = (CHUNK - 1) + MAX_REL + 1
EPS = 1e-6
NEG_INF = -1e30
IN_SPLITS = (GDN_QKV, GDN_W, GDN_HEADS, GDN_HEADS, 3 * ATT_W, D_MODEL, D_MODEL)
IN_COLS = sum(IN_SPLITS)

kernel_name = "hybrid_gdn_bandattn_macaron_block"


def rmsnorm(x, w, eps=EPS):
    xf = x.astype(jnp.float32)
    y = xf * lax.rsqrt(jnp.mean(xf * xf, axis=-1, keepdims=True) + eps)
    return (y * w.astype(jnp.float32)).astype(x.dtype)


def l2norm(x, eps=EPS):
    xf = x.astype(jnp.float32)
    return xf * lax.rsqrt(jnp.sum(xf * xf, axis=-1, keepdims=True) + eps)


def swiglu_ffn(h, w_gu, w_down):
    g, u = jnp.split(h @ w_gu, 2, axis=-1)
    return (jax.nn.silu(g) * u) @ w_down


def causal_short_conv(x, w):
    ksz = w.shape[0]
    seqlen = x.shape[1]
    xp = jnp.pad(x, ((0, 0), (ksz - 1, 0), (0, 0)))
    y = xp[:, 0:seqlen] * w[0]
    for j in range(1, ksz):
        y = y + xp[:, j:j + seqlen] * w[j]
    return y


def to_chunks(t):
    b, s, h, d = t.shape
    return t.reshape(b, s // CHUNK, CHUNK, h, d).transpose(0, 3, 1, 2, 4)


def to_chunks_h(t):
    b, s, h = t.shape
    return t.reshape(b, s // CHUNK, CHUNK, h).transpose(0, 3, 1, 2)


def gated_delta_rule_chunked(q, k, v, g, beta):
    c = q.shape[-2]
    dv = v.shape[-1]
    gc = jnp.cumsum(g, axis=-1)
    idx = jnp.arange(c)
    incl = idx[:, None] >= idx[None, :]
    strict = idx[:, None] > idx[None, :]
    diff = gc[..., :, None] - gc[..., None, :]
    decay = jnp.where(incl, jnp.exp(jnp.where(incl, diff, 0.0)), 0.0)
    kb = k * beta[..., None]
    lmat = jnp.where(strict, jnp.einsum('bhnid,bhnjd->bhnij', kb, k) * decay, 0.0)
    rhs = jnp.concatenate([v * beta[..., None], kb * jnp.exp(gc)[..., None]], axis=-1)
    sol = lax.linalg.triangular_solve(lmat + jnp.eye(c, dtype=lmat.dtype), rhs,
                                      left_side=True, lower=True, unit_diagonal=True)
    u, w = sol[..., :dv], sol[..., dv:]
    aqk = jnp.einsum('bhnid,bhnjd->bhnij', q, k) * decay
    q_dec = q * jnp.exp(gc)[..., None]
    k_tail = k * jnp.exp(gc[..., -1:] - gc)[..., None]
    tail = jnp.exp(gc[..., -1])

    def step(state, xs):
        u_c, w_c, aqk_c, qd_c, kt_c, tl_c = xs
        v_new = u_c - jnp.einsum('bhcd,bhde->bhce', w_c, state)
        o_c = (jnp.einsum('bhcd,bhde->bhce', qd_c, state)
               + jnp.einsum('bhcj,bhje->bhce', aqk_c, v_new))
        state = state * tl_c[..., None, None] + jnp.einsum('bhcd,bhce->bhde', kt_c, v_new)
        return state, o_c

    xs = tuple(jnp.moveaxis(t, 2, 0) for t in (u, w, aqk, q_dec, k_tail, tail))
    s0 = jnp.zeros(q.shape[:2] + (q.shape[-1], dv), jnp.float32)
    _, o = lax.scan(step, s0, xs)
    return jnp.moveaxis(o, 0, 2)


def gated_deltanet_branch(qkv, z, a_raw, b_raw, conv_w, a_log, dt_bias, norm_w):
    bsz, seqlen, _ = qkv.shape
    qkv = jax.nn.silu(causal_short_conv(qkv, conv_w))
    q, k, v = jnp.split(qkv, [GDN_HEADS * GDN_DK, 2 * GDN_HEADS * GDN_DK], axis=-1)
    q = l2norm(q.reshape(bsz, seqlen, GDN_HEADS, GDN_DK)) * (GDN_DK ** -0.5)
    k = l2norm(k.reshape(bsz, seqlen, GDN_HEADS, GDN_DK))
    v = v.reshape(bsz, seqlen, GDN_HEADS, GDN_DV).astype(jnp.float32)
    g = -jnp.exp(a_log.astype(jnp.float32)) * jax.nn.softplus(
        a_raw.astype(jnp.float32) + dt_bias.astype(jnp.float32))
    beta = jax.nn.sigmoid(b_raw.astype(jnp.float32))
    o = gated_delta_rule_chunked(to_chunks(q), to_chunks(k), to_chunks(v),
                                 to_chunks_h(g), to_chunks_h(beta))
    o = o.transpose(0, 2, 3, 1, 4).reshape(bsz, seqlen, GDN_HEADS, GDN_DV)
    zf = z.reshape(bsz, seqlen, GDN_HEADS, GDN_DV).astype(jnp.float32)
    o = rmsnorm(o, norm_w) * jax.nn.silu(zf)
    return o.reshape(bsz, seqlen, GDN_W).astype(z.dtype)


def gather_band(t):
    nc = t.shape[1]
    tp = jnp.pad(t, ((0, 0), (LEFT_CHUNKS, 0), (0, 0), (0, 0), (0, 0)))
    return jnp.concatenate([tp[:, j:j + nc] for j in range(LEFT_CHUNKS + 1)], axis=2)


def band_attention_branch(qkv, q_norm_w, k_norm_w, rel_bias):
    bsz, seqlen, _ = qkv.shape
    nc = seqlen // CHUNK
    q, k, v = jnp.split(qkv, 3, axis=-1)
    shp = (bsz, nc, CHUNK, ATT_HEADS, ATT_DH)
    q = rmsnorm(q.reshape(shp), q_norm_w)
    k_band = gather_band(rmsnorm(k.reshape(shp), k_norm_w))
    v_band = gather_band(v.reshape(shp))
    qpos = np.arange(CHUNK)[:, None]
    kpos = np.arange(BAND)[None, :] - LEFT_CHUNKS * CHUNK
    rel_idx = np.clip(qpos - kpos, -(CHUNK - 1), MAX_REL) + (CHUNK - 1)
    bias = rel_bias[:, rel_idx].astype(jnp.float32)
    valid = jnp.asarray((np.arange(nc)[:, None] - LEFT_CHUNKS
                         + np.arange(BAND)[None, :] // CHUNK) >= 0)
    s = jnp.einsum('bnqhd,bnkhd->bhnqk', q, k_band).astype(jnp.float32) * (ATT_DH ** -0.5)
    s = jnp.where(valid[:, None, :], s + bias[:, None], NEG_INF)
    pr = jax.nn.softmax(s, axis=-1).astype(v_band.dtype)
    o = jnp.einsum('bhnqk,bnkhd->bnqhd', pr, v_band)
    return o.reshape(bsz, seqlen, ATT_W)


def setup_inputs(seed: int = 0) -> dict:
    key = jax.random.key(seed)
    ks = jax.random.split(key, 24)
    f32 = jnp.float32

    def dense(k, shape):
        return jax.random.normal(k, shape, f32) * (shape[-2] ** -0.5)

    def gain(k, n):
        return 1.0 + 0.05 * jax.random.normal(k, (DEPTH, n), f32)

    dt = jnp.exp(jax.random.uniform(ks[9], (DEPTH, GDN_HEADS), f32,
                                    float(np.log(1e-3)), float(np.log(1e-1))))
    dt_bias = dt + jnp.log(-jnp.expm1(-dt))
    return {
        'x': jax.random.normal(ks[0], (BATCH, SEQ, D_MODEL), f32),
        'p': jax.random.normal(ks[1], (DEPTH, BATCH, SEQ, PLE_DIM), f32),
        'ffn1_norm': gain(ks[2], D_MODEL),
        'ffn1_w_gu': dense(ks[3], (DEPTH, D_MODEL, 2 * D_FF)),
        'ffn1_w_down': dense(ks[4], (DEPTH, D_FF, D_MODEL)),
        'mix_norm': gain(ks[5], D_MODEL),
        'w_in': dense(ks[6], (DEPTH, D_MODEL, IN_COLS)),
        'conv_w': 0.5 * jax.random.normal(ks[7], (DEPTH, CONV_K, GDN_QKV), f32),
        'a_log': jnp.log(jax.random.uniform(ks[8], (DEPTH, GDN_HEADS), f32, 1.0, 16.0)),
        'dt_bias': dt_bias,
        'gdn_norm': gain(ks[10], GDN_DV),
        'q_norm': gain(ks[11], ATT_DH),
        'k_norm': gain(ks[12], ATT_DH),
        'rel_bias': 0.5 * jax.random.normal(ks[13], (DEPTH, ATT_HEADS, N_REL), f32),
        'w_branch_a': dense(ks[14], (DEPTH, GDN_W, D_MODEL)),
        'w_branch_b': dense(ks[15], (DEPTH, ATT_W, D_MODEL)),
        'w_out': dense(ks[16], (DEPTH, D_MODEL, D_MODEL)),
        'ffn2_norm': gain(ks[17], D_MODEL),
        'ffn2_w_gu': dense(ks[18], (DEPTH, D_MODEL, 2 * D_FF)),
        'ffn2_w_down': dense(ks[19], (DEPTH, D_FF, D_MODEL)),
        'ple_norm': gain(ks[20], D_MODEL),
        'ple_gate': dense(ks[21], (DEPTH, D_MODEL, D_MODEL)),
        'ple_proj': dense(ks[22], (DEPTH, PLE_DIM, D_MODEL)),
    }


def reference(x, p, ffn1_norm, ffn1_w_gu, ffn1_w_down, mix_norm, w_in, conv_w, a_log,
              dt_bias, gdn_norm, q_norm, k_norm, rel_bias, w_branch_a, w_branch_b, w_out,
              ffn2_norm, ffn2_w_gu, ffn2_w_down, ple_norm, ple_gate, ple_proj):
    split_at = [int(s) for s in np.cumsum(IN_SPLITS)[:-1]]
    for i in range(DEPTH):
        x = x + 0.5 * swiglu_ffn(rmsnorm(x, ffn1_norm[i]), ffn1_w_gu[i], ffn1_w_down[i])
        h = rmsnorm(x, mix_norm[i])
        qkv_a, z_a, a_raw, b_raw, qkv_b, gate_a, gate_b = jnp.split(h @ w_in[i], split_at, axis=-1)
        ya = gated_deltanet_branch(qkv_a, z_a, a_raw, b_raw, conv_w[i], a_log[i],
                                   dt_bias[i], gdn_norm[i])
        yb = band_attention_branch(qkv_b, q_norm[i], k_norm[i], rel_bias[i])
        mixed = (jax.nn.sigmoid(gate_a) * (ya @ w_branch_a[i])
                 + jax.nn.sigmoid(gate_b) * (yb @ w_branch_b[i]))
        x = x + mixed @ w_out[i]
        x = x + 0.5 * swiglu_ffn(rmsnorm(x, ffn2_norm[i]), ffn2_w_gu[i], ffn2_w_down[i])
        x = x + jax.nn.sigmoid(rmsnorm(x, ple_norm[i]) @ ple_gate[i]) * (p[i] @ ple_proj[i])
    return x
```

```cpp
#include <hip/hip_runtime.h>
#include <hip/hip_cooperative_groups.h>
#include <cstdio>
namespace cg = cooperative_groups;

#define LAS __attribute__((address_space(3)))
typedef unsigned short bf16_t;
typedef short bf16x8 __attribute__((ext_vector_type(8)));
typedef float f32x4 __attribute__((ext_vector_type(4)));
typedef unsigned u32x4 __attribute__((ext_vector_type(4)));
typedef unsigned u32x2 __attribute__((ext_vector_type(2)));
typedef __bf16 bf16v2 __attribute__((ext_vector_type(2)));

constexpr int M = 8192, D = 2048, FF = 5632, NGU = 11264, NIN = 11520, NINSRC = 11280, PLE = 256;
constexpr int NH = 8, DH = 128, NCH = 128;
constexpr int C_QA = 0, C_KA = 1024, C_VA = 2048, C_Z = 3072, C_QB = 4096, C_KB = 5120, C_VB = 6144, C_GA = 7168, C_GB = 9216, C_AR = 11264, C_BR = 11272;
constexpr float EPS = 1e-6f;
constexpr size_t WS_WGU1 = 0;
constexpr size_t WS_WD1  = WS_WGU1 + (size_t)NGU * D * 2;
constexpr size_t WS_WIN  = WS_WD1 + (size_t)D * FF * 2;
constexpr size_t WS_WA   = WS_WIN + (size_t)NIN * D * 2;
constexpr size_t WS_WB   = WS_WA + (size_t)D * 1024 * 2;
constexpr size_t WS_WOUT = WS_WB + (size_t)D * 1024 * 2;
constexpr size_t WS_WGU2 = WS_WOUT + (size_t)D * D * 2;
constexpr size_t WS_WD2  = WS_WGU2 + (size_t)NGU * D * 2;
constexpr size_t WS_WPG  = WS_WD2 + (size_t)D * FF * 2;
constexpr size_t WS_WPP  = WS_WPG + (size_t)D * D * 2;
constexpr size_t WS_XB   = WS_WPP + (size_t)D * PLE * 2;
constexpr size_t WS_PROJ = WS_XB + (size_t)M * D * 2;
constexpr size_t WS_AQK  = WS_PROJ + (size_t)M * NIN * 2;
constexpr size_t WS_KTT  = WS_AQK + (size_t)1024 * 64 * 64 * 2;
constexpr size_t WS_PB   = WS_KTT + (size_t)M * 1024 * 2;
constexpr size_t WS_VT   = WS_PB + (size_t)M * PLE * 2;
constexpr size_t WS_SS   = WS_VT + (size_t)M * 1024 * 2;
constexpr size_t WS_TAIL = WS_SS + (size_t)4 * M * 4;
constexpr size_t WS_PROG = WS_TAIL + 4096;
constexpr size_t WS_BAR  = WS_PROG + 4096;
constexpr size_t WS_END  = WS_BAR + 16384;
constexpr size_t WS_ACT  = WS_PROJ;
constexpr size_t WS_RBUF = WS_PROJ;
constexpr size_t WS_U    = 0;
constexpr size_t WS_W    = WS_U + (size_t)M * 1024 * 4;
constexpr size_t WS_QD   = WS_W + (size_t)M * 1024 * 2;
constexpr size_t WS_MIX  = 0;
constexpr size_t WS_YB   = WS_XB;
constexpr size_t WS_YA   = WS_XB + (size_t)M * 1024 * 2;
static_assert(WS_QD + (size_t)M * 1024 * 2 <= WS_WIN, "gdn scratch overlaps live weights");

constexpr int LDS_BYTES = 147456;

__device__ __forceinline__ unsigned pk2(float lo, float hi) { bf16v2 v = {(__bf16)lo, (__bf16)hi}; return __builtin_bit_cast(unsigned, v); }
__device__ __forceinline__ float bf2f(bf16_t b) { return __uint_as_float(((unsigned)b) << 16); }
__device__ __forceinline__ float bflo(unsigned w) { return __uint_as_float(w << 16); }
__device__ __forceinline__ float bfhi(unsigned w) { return __uint_as_float(w & 0xffff0000u); }
__device__ __forceinline__ void unpack8(u32x4 w, float (&f)[8]) { f[0] = bflo(w.x); f[1] = bfhi(w.x); f[2] = bflo(w.y); f[3] = bfhi(w.y); f[4] = bflo(w.z); f[5] = bfhi(w.z); f[6] = bflo(w.w); f[7] = bfhi(w.w); }
__device__ __forceinline__ u32x4 pack8f(const float (&f)[8]) { u32x4 w; w.x = pk2(f[0], f[1]); w.y = pk2(f[2], f[3]); w.z = pk2(f[4], f[5]); w.w = pk2(f[6], f[7]); return w; }
__device__ __forceinline__ bf16x8 pack_acc(f32x4 a, f32x4 b) { u32x4 p; p.x = pk2(a[0], a[1]); p.y = pk2(a[2], a[3]); p.z = pk2(b[0], b[1]); p.w = pk2(b[2], b[3]); return __builtin_bit_cast(bf16x8, p); }
__device__ __forceinline__ bf16x8 ld2x8(const bf16_t* p0, const bf16_t* p1) { const u32x2 a = *(const u32x2*)p0, b = *(const u32x2*)p1; u32x4 v; v.x = a.x; v.y = a.y; v.z = b.x; v.w = b.y; return __builtin_bit_cast(bf16x8, v); }
__device__ __forceinline__ bf16x8 ld8(const bf16_t* p) { return __builtin_bit_cast(bf16x8, *(const u32x4*)p); }
__device__ __forceinline__ float sigmoidf_(float x) { return __builtin_amdgcn_rcpf(1.f + __expf(-x)); }
__device__ __forceinline__ float siluf_(float x) { return x * __builtin_amdgcn_rcpf(1.f + __expf(-x)); }
__device__ __forceinline__ float wave_sum(float v) {
#pragma unroll
    for (int o = 1; o < 64; o <<= 1) v += __shfl_xor(v, o);
    return v;
}
__device__ __forceinline__ int opaque_tid() { int t = threadIdx.x; asm volatile("" : "+v"(t)); return t; }
#define MFMA16(a, b, c) __builtin_amdgcn_mfma_f32_16x16x32_bf16((a), (b), (c), 0, 0, 0)

namespace pg8 {
constexpr int BM = 256, BK = 64, HALF = 128, HTB = HALF * BK * 2, STAGE_BYTES = 8 * HTB, NXCD = 8, WGM = 8;
__device__ __forceinline__ int lds_byte(int r, int c) { const int st = (r >> 4) * 2 + (c >> 5), rr = r & 15, cc = c & 31, ob = rr * 64 + cc * 2; return st * 1024 + (ob ^ (((ob >> 9) & 1) << 5)); }
__device__ __forceinline__ void stage_rc(int b, int& R, int& C) { const int st = b / 1024, sb = b % 1024, swz = sb ^ (((sb >> 9) & 1) << 5); R = (st >> 1) * 16 + swz / 64; C = (st & 1) * 32 + (swz % 64) / 2; }
__device__ __forceinline__ int perm32(int rho) { const int n = rho >> 4, i = rho & 15; return 8 * (i >> 2) + 4 * n + (i & 3); }

struct Unit { int pm, pn, sel; };
struct Sched {
    const bf16_t *A0, *B0, *A1, *B1;
    int nM, nN, nwg, G, c, dual;
    __device__ __forceinline__ void init(const bf16_t* a0, const bf16_t* b0, const bf16_t* a1, const bf16_t* b1, int Mr, int Nc, int G_, int c_, int dual_) {
        A0 = a0; B0 = b0; A1 = a1; B1 = b1; nM = Mr / BM; nN = Nc / BM; nwg = nM * nN; G = G_; c = c_; dual = dual_; }
    __device__ __forceinline__ bool next(int i, Unit& u) const {
        const int tile = dual ? (i >> 1) : i;
        const long L = (long)tile * G + c; if (L >= nwg) return false;
        int wgid = (int)L; { const int q = nwg / NXCD, r = nwg % NXCD, xcd = wgid % NXCD, off = wgid / NXCD; wgid = (xcd < r ? xcd * (q + 1) : r * (q + 1) + (xcd - r) * q) + off; }
        const int nig = WGM * nN, gid = wgid / nig, fm = gid * WGM, gsz = (nM - fm) < WGM ? (nM - fm) : WGM;
        u.pm = fm + ((wgid % nig) % gsz); u.pn = (wgid % nig) / gsz; u.sel = dual ? (i & 1) : 0; return true;
    }
};

template <class Epi>
__device__ __forceinline__ void gemm_phase(LAS unsigned char* lds, const int K, const Sched& S, const Epi& E) {
    const int tid = opaque_tid(), wid = __builtin_amdgcn_readfirstlane(tid >> 6), lane = tid & 63, wr = wid >> 2, wc = wid & 3, fr = lane & 15, fq = lane >> 4;
    const int nt = K / BK;
    unsigned voffA[2], voffB[2];
#pragma unroll
    for (int i = 0; i < 2; ++i) { int R, C; stage_rc(tid * 16 + i * 8192, R, C); const int Rb = Epi::PERM ? ((R & ~31) + perm32(R & 31)) : R;
        voffA[i] = (unsigned)(R * K + C) * 2u; voffB[i] = (unsigned)(Rb * K + C) * 2u; }
    const size_t kstep = (size_t)(BK * 2);
    const size_t hstep = (size_t)HALF * K * 2;
    const size_t tstep = 2 * hstep;
    const unsigned ldsw = (unsigned)wid * 1024u;
    const int aoff = lds_byte(wr * 64 + fr, fq * 8), boff = lds_byte(wc * 32 + fr, fq * 8);
#define PG8_SA(b, h) (((b) * 2 + (h)) * HTB)
#define PG8_SB(b, h) ((4 + (b) * 2 + (h)) * HTB)
#define PG8_STAGE(bufoff, gbase, voff) do { _Pragma("unroll") for (int _i = 0; _i < 2; ++_i) \
        __builtin_amdgcn_global_load_lds((const unsigned*)((const char*)(gbase) + (voff)[_i]), (LAS unsigned*)(lds + (bufoff) + ldsw + _i * 8192), 16, 0, 0); } while (0)
#define PG8_LDA(dst, b, h) do { _Pragma("unroll") for (int m = 0; m < 4; ++m) _Pragma("unroll") for (int k = 0; k < 2; ++k) dst[m][k] = *(const LAS bf16x8*)(lds + PG8_SA(b, h) + aoff + m * 2048 + k * 1024); } while (0)
#define PG8_LDB(dst, b, h) do { _Pragma("unroll") for (int n = 0; n < 2; ++n) _Pragma("unroll") for (int k = 0; k < 2; ++k) dst[n][k] = *(const LAS bf16x8*)(lds + PG8_SB(b, h) + boff + n * 2048 + k * 1024); } while (0)
#define PG8_MMA(ai, bj, At, Bt) do { __builtin_amdgcn_s_setprio(1); _Pragma("unroll") for (int m = 0; m < 4; ++m) _Pragma("unroll") for (int n = 0; n < 2; ++n) _Pragma("unroll") for (int k = 0; k < 2; ++k) \
        acc[ai][bj][m][n] = __builtin_amdgcn_mfma_f32_16x16x32_bf16(Bt[n][k], At[m][k], acc[ai][bj][m][n], 0, 0, 0); __builtin_amdgcn_s_setprio(0); } while (0)
#define PG8_WAIT_V(n) asm volatile("s_waitcnt vmcnt(" #n ")" ::: "memory")
#define PG8_WAIT_L(n) asm volatile("s_waitcnt lgkmcnt(" #n ")" ::: "memory")
#define PG8_BAR __builtin_amdgcn_s_barrier()
#define PG8_SCHED __builtin_amdgcn_sched_barrier(0)
    Unit cur, nxt; int ui = 0;
    if (!S.next(0, cur)) return;
    float ssv[8]; E.pre(cur, wr, fr, ssv);
    f32x4 acc[2][2][4][2];
#pragma unroll
    for (int a = 0; a < 2; ++a)
#pragma unroll
        for (int b = 0; b < 2; ++b)
#pragma unroll
            for (int m = 0; m < 4; ++m)
#pragma unroll
                for (int n = 0; n < 2; ++n) acc[a][b][m][n] = (f32x4){0.f, 0.f, 0.f, 0.f};
    bf16x8 At[4][2], B0[2][2], B1[2][2];
    const char* cA = (const char*)(cur.sel ? S.A1 : S.A0) + (size_t)cur.pm * tstep; const char* cB = (const char*)(cur.sel ? S.B1 : S.B0) + (size_t)cur.pn * tstep;
    PG8_STAGE(PG8_SB(0, 0), cB, voffB); PG8_STAGE(PG8_SA(0, 0), cA, voffA); PG8_STAGE(PG8_SB(0, 1), cB + hstep, voffB); PG8_STAGE(PG8_SA(0, 1), cA + hstep, voffA);
    if (wr == 1) PG8_BAR;
    PG8_WAIT_V(4); PG8_BAR;
    PG8_STAGE(PG8_SB(1, 0), cB + kstep, voffB); PG8_STAGE(PG8_SA(1, 0), cA + kstep, voffA); PG8_STAGE(PG8_SB(1, 1), cB + hstep + kstep, voffB);
    PG8_WAIT_V(6); PG8_BAR;
    for (;;) {
        const bool has_next = S.next(ui + 1, nxt);
        const char* nA = has_next ? (const char*)(nxt.sel ? S.A1 : S.A0) + (size_t)nxt.pm * tstep : cA; const char* nB = has_next ? (const char*)(nxt.sel ? S.B1 : S.B0) + (size_t)nxt.pn * tstep : cB;
        for (int t = 0; t < nt; t += 2) {
            const bool last = (t == nt - 2);
            const char* a1 = cA + (size_t)(t + 1) * kstep;
            const char* a2 = last ? nA : cA + (size_t)(t + 2) * kstep; const char* b2 = last ? nB : cB + (size_t)(t + 2) * kstep;
            const char* a3 = a2 + kstep; const char* b3 = b2 + kstep;
            PG8_LDB(B0, 0, 0); PG8_SCHED; PG8_LDA(At, 0, 0); PG8_STAGE(PG8_SA(1, 1), a1 + hstep, voffA);
            PG8_WAIT_L(8); PG8_BAR; PG8_WAIT_L(0); PG8_MMA(0, 0, At, B0); PG8_BAR; PG8_SCHED;
            PG8_LDB(B1, 0, 1); PG8_STAGE(PG8_SB(0, 0), b2, voffB);
            PG8_BAR; PG8_WAIT_L(0); PG8_MMA(0, 1, At, B1); PG8_BAR;
            PG8_LDA(At, 0, 1); PG8_STAGE(PG8_SA(0, 0), a2, voffA);
            PG8_BAR; PG8_WAIT_L(0); PG8_MMA(1, 0, At, B0); PG8_BAR; PG8_SCHED;
            PG8_STAGE(PG8_SB(0, 1), b2 + hstep, voffB);
            PG8_WAIT_V(6); PG8_BAR; PG8_MMA(1, 1, At, B1); PG8_BAR;
            PG8_LDB(B0, 1, 0); PG8_SCHED; PG8_LDA(At, 1, 0); PG8_STAGE(PG8_SA(0, 1), a2 + hstep, voffA);
            PG8_WAIT_L(8); PG8_BAR; PG8_WAIT_L(0); PG8_MMA(0, 0, At, B0); PG8_BAR; PG8_SCHED;
            PG8_LDB(B1, 1, 1); PG8_STAGE(PG8_SB(1, 0), b3, voffB);
            PG8_BAR; PG8_WAIT_L(0); PG8_MMA(0, 1, At, B1); PG8_BAR;
            PG8_LDA(At, 1, 1); PG8_STAGE(PG8_SA(1, 0), a3, voffA);
            PG8_BAR; PG8_WAIT_L(0); PG8_MMA(1, 0, At, B0); PG8_BAR; PG8_SCHED;
            PG8_STAGE(PG8_SB(1, 1), b3 + hstep, voffB);
            PG8_WAIT_V(6); PG8_BAR; PG8_MMA(1, 1, At, B1); PG8_BAR;
        }
        E(acc, cur, wr, wc, fr, fq, ssv);
        if (!has_next) break;
        if (!E.keep(cur)) {
#pragma unroll
            for (int a = 0; a < 2; ++a)
#pragma unroll
                for (int b = 0; b < 2; ++b)
#pragma unroll
                    for (int m = 0; m < 4; ++m)
#pragma unroll
                        for (int n = 0; n < 2; ++n) acc[a][b][m][n] = (f32x4){0.f, 0.f, 0.f, 0.f};
        }
        cur = nxt; cA = nA; cB = nB; ++ui;
        E.pre(cur, wr, fr, ssv);
    }
    PG8_WAIT_V(0);
    if (wr == 0) PG8_BAR;
    PG8_BAR;
#undef PG8_SA
#undef PG8_SB
#undef PG8_STAGE
#undef PG8_LDA
#undef PG8_LDB
#undef PG8_MMA
#undef PG8_WAIT_V
#undef PG8_WAIT_L
#undef PG8_BAR
#undef PG8_SCHED
}
}
using pg8::Unit;
typedef f32x4 Acc[2][2][4][2];

struct EpiGU {
    static constexpr bool PERM = true;
    bf16_t* O; const float* ss;
    __device__ __forceinline__ void pre(const Unit& u, int wr, int fr, float (&ssv)[8]) const {
#pragma unroll
        for (int ai = 0; ai < 2; ++ai)
#pragma unroll
            for (int m = 0; m < 4; ++m) ssv[ai * 4 + m] = ss[u.pm * 256 + ai * 128 + wr * 64 + m * 16 + fr];
    }
    __device__ __forceinline__ bool keep(const Unit&) const { return false; }
    __device__ __forceinline__ void operator()(Acc& acc, const Unit& u, int wr, int wc, int fr, int fq, const float (&ssv)[8]) const {
        const int row0 = u.pm * 256 + wr * 64 + fr, col0 = u.pn * 128 + wc * 32 + 8 * fq;
#pragma unroll
        for (int ai = 0; ai < 2; ++ai)
#pragma unroll
            for (int m = 0; m < 4; ++m) {
                const int row = row0 + ai * 128 + m * 16;
                const float rs = rsqrtf(ssv[ai * 4 + m] * (1.f / D) + EPS);
                const float rs2 = rs * rs, nrl = -1.4426950408889634f * rs;
                float o[8];
#pragma unroll
                for (int n = 0; n < 2; ++n)
#pragma unroll
                    for (int j = 0; j < 4; j += 2) {
                        typedef float f32x2v __attribute__((ext_vector_type(2)));
                        const f32x2v g = {acc[ai][0][m][n][j], acc[ai][0][m][n][j + 1]}, uu = {acc[ai][1][m][n][j], acc[ai][1][m][n][j + 1]};
                        const f32x2v t = g * nrl, p = (g * uu) * rs2;
                        f32x2v d; d.x = __builtin_amdgcn_exp2f(t.x); d.y = __builtin_amdgcn_exp2f(t.y); d = d + 1.0f;
                        f32x2v r; r.x = __builtin_amdgcn_rcpf(d.x); r.y = __builtin_amdgcn_rcpf(d.y);
                        const f32x2v q = p * r; o[n * 4 + j] = q.x; o[n * 4 + j + 1] = q.y;
                    }
                *(u32x4*)(O + (size_t)row * FF + col0) = pack8f(o);
            }
    }
};
struct EpiRes {
    static constexpr bool PERM = false;
    const float* base; float* out; bf16_t* ob; float* ssn; float scale;
    __device__ __forceinline__ void pre(const Unit&, int, int, float (&ssv)[8]) const {
#pragma unroll
        for (int i = 0; i < 8; ++i) ssv[i] = 0.f; }
    __device__ __forceinline__ bool keep(const Unit&) const { return false; }
    __device__ __forceinline__ void operator()(Acc& acc, const Unit& u, int wr, int wc, int fr, int fq, const float (&ssv)[8]) const {
        const int row0 = u.pm * 256 + wr * 64 + fr, col0 = u.pn * 256 + wc * 32 + 4 * fq;
#pragma unroll
        for (int ai = 0; ai < 2; ++ai) {
            f32x4 b[4][2][2];
#pragma unroll
            for (int m = 0; m < 4; ++m)
#pragma unroll
                for (int bj = 0; bj < 2; ++bj)
#pragma unroll
                    for (int n = 0; n < 2; ++n) b[m][bj][n] = *(const f32x4*)(base + (size_t)(row0 + ai * 128 + m * 16) * D + col0 + bj * 128 + n * 16);
#pragma unroll
            for (int m = 0; m < 4; ++m) {
                const int row = row0 + ai * 128 + m * 16; float sq = 0.f;
#pragma unroll
                for (int bj = 0; bj < 2; ++bj)
#pragma unroll
                    for (int n = 0; n < 2; ++n) {
                        const size_t off = (size_t)row * D + col0 + bj * 128 + n * 16;
                        const f32x4 v = b[m][bj][n] + acc[ai][bj][m][n] * scale;
                        *(f32x4*)(out + off) = v;
                        sq += (v[0] * v[0] + v[1] * v[1]) + (v[2] * v[2] + v[3] * v[3]);
                        u32x2 w; w.x = pk2(v[0], v[1]); w.y = pk2(v[2], v[3]);
                        *(u32x2*)(ob + off) = w;
                    }
                sq += __shfl_xor(sq, 16); sq += __shfl_xor(sq, 32);
                if (fq == 0) unsafeAtomicAdd(ssn + row, sq);
            }
        }
    }
};
struct EpiProj {
    static constexpr bool PERM = true;
    bf16_t* O; const float* ss;
    __device__ __forceinline__ void pre(const Unit& u, int wr, int fr, float (&ssv)[8]) const {
#pragma unroll
        for (int ai = 0; ai < 2; ++ai)
#pragma unroll
            for (int m = 0; m < 4; ++m) ssv[ai * 4 + m] = ss[u.pm * 256 + ai * 128 + wr * 64 + m * 16 + fr];
    }
    __device__ __forceinline__ bool keep(const Unit&) const { return false; }
    __device__ __forceinline__ void operator()(Acc& acc, const Unit& u, int wr, int wc, int fr, int fq, const float (&ssv)[8]) const {
        const int row0 = u.pm * 256 + wr * 64 + fr, col0 = u.pn * 256 + wc * 32 + 8 * fq;
#pragma unroll
        for (int ai = 0; ai < 2; ++ai)
#pragma unroll
            for (int m = 0; m < 4; ++m) {
                const int row = row0 + ai * 128 + m * 16;
                const float rs = rsqrtf(ssv[ai * 4 + m] * (1.f / D) + EPS);
#pragma unroll
                for (int bj = 0; bj < 2; ++bj) {
                    float o[8];
#pragma unroll
                    for (int n = 0; n < 2; ++n)
#pragma unroll
                        for (int j = 0; j < 4; ++j) o[n * 4 + j] = acc[ai][bj][m][n][j] * rs;
                    *(u32x4*)(O + (size_t)row * NIN + col0 + bj * 128) = pack8f(o);
                }
            }
    }
};
struct EpiMix {
    static constexpr bool PERM = true;
    const bf16_t* proj; bf16_t* O;
    __device__ __forceinline__ void pre(const Unit&, int, int, float (&ssv)[8]) const {
#pragma unroll
        for (int i = 0; i < 8; ++i) ssv[i] = 0.f; }
    __device__ __forceinline__ bool keep(const Unit& u) const { return u.sel == 0; }
    __device__ __forceinline__ void operator()(Acc& acc, const Unit& u, int wr, int wc, int fr, int fq, const float (&ssv)[8]) const {
        const int row0 = u.pm * 256 + wr * 64 + fr, col0 = u.pn * 256 + wc * 32 + 8 * fq;
#pragma unroll
        for (int ai = 0; ai < 2; ++ai)
#pragma unroll
            for (int m = 0; m < 4; ++m) {
                const int row = row0 + ai * 128 + m * 16;
#pragma unroll
                for (int bj = 0; bj < 2; ++bj) {
                    const int col = col0 + bj * 128;
                    float ga[8], gb[8];
                    unpack8(*(const u32x4*)(proj + (size_t)row * NIN + C_GA + col), ga);
                    unpack8(*(const u32x4*)(proj + (size_t)row * NIN + C_GB + col), gb);
                    if (u.sel == 0) {
#pragma unroll
                        for (int n = 0; n < 2; ++n)
#pragma unroll
                            for (int j = 0; j < 4; ++j) acc[ai][bj][m][n][j] *= (1.f + __expf(-gb[n * 4 + j])) * __builtin_amdgcn_rcpf(1.f + __expf(-ga[n * 4 + j]));
                    } else {
                        float o[8];
#pragma unroll
                        for (int n = 0; n < 2; ++n)
#pragma unroll
                            for (int j = 0; j < 4; ++j) o[n * 4 + j] = acc[ai][bj][m][n][j] * sigmoidf_(gb[n * 4 + j]);
                        *(u32x4*)(O + (size_t)row * D + col) = pack8f(o);
                    }
                }
            }
    }
};
struct EpiF32 {
    static constexpr bool PERM = false;
    float* C;
    __device__ __forceinline__ void pre(const Unit&, int, int, float (&ssv)[8]) const {
#pragma unroll
        for (int i = 0; i < 8; ++i) ssv[i] = 0.f; }
    __device__ __forceinline__ bool keep(const Unit&) const { return false; }
    __device__ __forceinline__ void operator()(Acc& acc, const Unit& u, int wr, int wc, int fr, int fq, const float (&ssv)[8]) const {
        const int row0 = u.pm * 256 + wr * 64 + fr, col0 = u.pn * 256 + wc * 32 + 4 * fq;
#pragma unroll
        for (int ai = 0; ai < 2; ++ai)
#pragma unroll
            for (int m = 0; m < 4; ++m)
#pragma unroll
                for (int bj = 0; bj < 2; ++bj)
#pragma unroll
                    for (int n = 0; n < 2; ++n) *(f32x4*)(C + (size_t)(row0 + ai * 128 + m * 16) * D + col0 + bj * 128 + n * 16) = acc[ai][bj][m][n];
    }
};
struct EpiPle {
    static constexpr bool PERM = false;
    float* out; const float* R; const float* ss;
    __device__ __forceinline__ void pre(const Unit& u, int wr, int fr, float (&ssv)[8]) const {
#pragma unroll
        for (int ai = 0; ai < 2; ++ai)
#pragma unroll
            for (int m = 0; m < 4; ++m) ssv[ai * 4 + m] = ss[u.pm * 256 + ai * 128 + wr * 64 + m * 16 + fr];
    }
    __device__ __forceinline__ bool keep(const Unit&) const { return false; }
    __device__ __forceinline__ void operator()(Acc& acc, const Unit& u, int wr, int wc, int fr, int fq, const float (&ssv)[8]) const {
        const int row0 = u.pm * 256 + wr * 64 + fr, col0 = u.pn * 256 + wc * 32 + 4 * fq;
#pragma unroll
        for (int ai = 0; ai < 2; ++ai)
#pragma unroll
            for (int mp = 0; mp < 2; ++mp) {
                f32x4 bb[2][2][2], rr[2][2][2];
#pragma unroll
                for (int mm = 0; mm < 2; ++mm)
#pragma unroll
                    for (int bj = 0; bj < 2; ++bj)
#pragma unroll
                        for (int n = 0; n < 2; ++n) { const size_t off = (size_t)(row0 + ai * 128 + (2 * mp + mm) * 16) * D + col0 + bj * 128 + n * 16;
                            bb[mm][bj][n] = *(const f32x4*)(out + off); rr[mm][bj][n] = *(const f32x4*)(R + off); }
#pragma unroll
                for (int mm = 0; mm < 2; ++mm) {
                    const int m = 2 * mp + mm, row = row0 + ai * 128 + m * 16;
                    const float rs = rsqrtf(ssv[ai * 4 + m] * (1.f / D) + EPS);
#pragma unroll
                    for (int bj = 0; bj < 2; ++bj)
#pragma unroll
                        for (int n = 0; n < 2; ++n) {
                            const size_t off = (size_t)row * D + col0 + bj * 128 + n * 16;
                            f32x4 v;
#pragma unroll
                            for (int j = 0; j < 4; ++j) v[j] = bb[mm][bj][n][j] + sigmoidf_(acc[ai][bj][m][n][j] * rs) * rr[mm][bj][n][j];
                            *(f32x4*)(out + off) = v;
                        }
                }
            }
    }
};

struct Params {
    const float *x, *p, *ffn1_norm, *ffn1_w_gu, *ffn1_w_down, *mix_norm, *w_in, *conv_w, *a_log, *dt_bias, *gdn_norm, *q_norm, *k_norm, *rel_bias,
                *w_a, *w_b, *w_out, *ffn2_norm, *ffn2_w_gu, *ffn2_w_down, *ple_norm, *ple_gate, *ple_proj;
    float* out; unsigned char* ws; int ph_lo, ph_hi;
};

template <int MAP> __device__ __forceinline__ int src_col(int n) {
    if (MAP == 1) return ((n >> 7) & 1) * FF + (n >> 8) * 128 + (n & 127);
    if (MAP == 2) return n < 4096 ? n : (n < 11264 ? n + 16 : (n < 11280 ? n - 11264 + 4096 : -1));
    return n;
}
template <int MAP> __device__ __forceinline__ void transpose_item(const float* W, const float* nw, int K, int Nsrc, int Nd, bf16_t* WT, LAS float* scr, int item, int lane) {
    const int nblk = Nd / 64, kb = item / nblk, nb = item % nblk, k0 = 64 * kb, n0 = 64 * nb;
    const int r = lane >> 4, c4 = lane & 15;
    const int sc = src_col<MAP>(n0 + 4 * c4);
    f32x4 v[16];
#pragma unroll
    for (int i = 0; i < 16; ++i) v[i] = sc >= 0 ? __builtin_nontemporal_load((const f32x4*)(W + (size_t)(k0 + 4 * i + r) * Nsrc + sc)) : (f32x4){0.f, 0.f, 0.f, 0.f};
    if (nw) {
#pragma unroll
        for (int i = 0; i < 16; ++i) v[i] = v[i] * nw[k0 + 4 * i + r];
    }
#pragma unroll
    for (int i = 0; i < 16; ++i) { LAS float* p = scr + (4 * i + r) * 65 + 4 * c4; p[0] = v[i][0]; p[1] = v[i][1]; p[2] = v[i][2]; p[3] = v[i][3]; }
    asm volatile("s_waitcnt lgkmcnt(0)" ::: "memory"); __builtin_amdgcn_wave_barrier();
    const int ns = lane >> 3, kc = lane & 7;
#pragma unroll
    for (int j = 0; j < 8; ++j) { const LAS float* sp = scr + (8 * kc) * 65 + 8 * j + ns;
        u32x4 o; o.x = pk2(sp[0 * 65], sp[1 * 65]); o.y = pk2(sp[2 * 65], sp[3 * 65]); o.z = pk2(sp[4 * 65], sp[5 * 65]); o.w = pk2(sp[6 * 65], sp[7 * 65]);
        *(u32x4*)(WT + (size_t)(n0 + 8 * j + ns) * K + k0 + 8 * kc) = o; }
    asm volatile("s_waitcnt lgkmcnt(0)" ::: "memory"); __builtin_amdgcn_wave_barrier();
}
constexpr int I_GU = (D / 64) * (NGU / 64), I_DN = (FF / 64) * (D / 64), I_IN = (D / 64) * (NIN / 64), I_AB = (1024 / 64) * (D / 64), I_SQ = (D / 64) * (D / 64), I_PP = (PLE / 64) * (D / 64);
constexpr int N_EARLY = I_GU + I_DN + I_IN, N_LATE = I_GU + I_DN + 2 * I_AB + 2 * I_SQ + I_PP;
__device__ __forceinline__ void convert_early(const Params& P, LAS float* scr, int gw, int NGW, int lane, bool with_d1) {
    unsigned char* ws = P.ws;
    for (int it = gw; it < I_GU + I_IN + (with_d1 ? I_DN : 0); it += NGW) {
        int r = it;
        if (r < I_GU) { transpose_item<1>(P.ffn1_w_gu, P.ffn1_norm, D, NGU, NGU, (bf16_t*)(ws + WS_WGU1), scr, r, lane); continue; } r -= I_GU;
        if (r < I_IN) { transpose_item<2>(P.w_in, P.mix_norm, D, NINSRC, NIN, (bf16_t*)(ws + WS_WIN), scr, r, lane); continue; } r -= I_IN;
        transpose_item<0>(P.ffn1_w_down, nullptr, FF, D, D, (bf16_t*)(ws + WS_WD1), scr, r, lane);
    }
}
__device__ __forceinline__ void convert_d1(const Params& P, LAS float* scr, int gw, int NGW, int lane) {
    for (int it = gw; it < I_DN; it += NGW) transpose_item<0>(P.ffn1_w_down, nullptr, FF, D, D, (bf16_t*)(P.ws + WS_WD1), scr, it, lane);
}
__device__ __forceinline__ void convert_late(const Params& P, LAS float* scr, int lo_it, int hi_it, int gw, int NGW, int lane) {
    unsigned char* ws = P.ws;
    for (int it = lo_it + gw; it < hi_it; it += NGW) {
        int r = it;
        if (r < I_AB) { transpose_item<0>(P.w_a, nullptr, 1024, D, D, (bf16_t*)(ws + WS_WA), scr, r, lane); continue; } r -= I_AB;
        if (r < I_AB) { transpose_item<0>(P.w_b, nullptr, 1024, D, D, (bf16_t*)(ws + WS_WB), scr, r, lane); continue; } r -= I_AB;
        if (r < I_SQ) { transpose_item<0>(P.w_out, nullptr, D, D, D, (bf16_t*)(ws + WS_WOUT), scr, r, lane); continue; } r -= I_SQ;
        if (r < I_GU) { transpose_item<1>(P.ffn2_w_gu, P.ffn2_norm, D, NGU, NGU, (bf16_t*)(ws + WS_WGU2), scr, r, lane); continue; } r -= I_GU;
        if (r < I_DN) { transpose_item<0>(P.ffn2_w_down, nullptr, FF, D, D, (bf16_t*)(ws + WS_WD2), scr, r, lane); continue; } r -= I_DN;
        if (r < I_SQ) { transpose_item<0>(P.ple_gate, P.ple_norm, D, D, D, (bf16_t*)(ws + WS_WPG), scr, r, lane); continue; } r -= I_SQ;
        transpose_item<0>(P.ple_proj, nullptr, PLE, D, D, (bf16_t*)(ws + WS_WPP), scr, r, lane);
    }
}
constexpr int LATE_A = 2800, LATE_C = 2 * I_AB + I_SQ + I_GU;
__device__ __forceinline__ void idle_convert(const Params& P, LAS unsigned char* lds, int nwg, int G, int lo_it, int hi_it) {
    const int extra = nwg % G, c = blockIdx.x;
    if (extra == 0 || c < extra) return;
    const int tid = opaque_tid(), wave = tid >> 6;
    if (lo_it < 0) convert_d1(P, (LAS float*)(lds + wave * 17408), (c - extra) * 8 + wave, (G - extra) * 8, tid & 63);
    else convert_late(P, (LAS float*)(lds + wave * 17408), lo_it, hi_it, (c - extra) * 8 + wave, (G - extra) * 8, tid & 63);
}
__device__ __forceinline__ void phase_convert(const Params& P, LAS unsigned char* lds, int G) {
    const int tid = opaque_tid(), lane = tid & 63, wave = tid >> 6;
    LAS float* scr = (LAS float*)(lds + wave * 17408);
    const int gw = blockIdx.x * 8 + wave, NGW = G * 8;
    unsigned char* ws = P.ws;
    convert_early(P, scr, gw, NGW, lane, (((M / 256) * (NGU / 256)) % G) == 0);
    float* ss = (float*)(ws + WS_SS);
    bf16_t* xb = (bf16_t*)(ws + WS_XB); bf16_t* pb = (bf16_t*)(ws + WS_PB);
    for (int m = gw; m < M; m += NGW) {
        const f32x4* xr = (const f32x4*)(P.x + (size_t)m * D) + lane; u32x2* o8 = (u32x2*)(xb + (size_t)m * D) + lane; float s = 0.f;
#pragma unroll
        for (int j = 0; j < 8; ++j) { const f32x4 v = __builtin_nontemporal_load(xr + 64 * j); s += (v[0] * v[0] + v[1] * v[1]) + (v[2] * v[2] + v[3] * v[3]); u32x2 w; w.x = pk2(v[0], v[1]); w.y = pk2(v[2], v[3]); o8[64 * j] = w; }
        s = wave_sum(s); if (lane == 0) ss[m] = s;
        const f32x4 pv = *((const f32x4*)(P.p + (size_t)m * PLE) + lane); u32x2 w; w.x = pk2(pv[0], pv[1]); w.y = pk2(pv[2], pv[3]); *((u32x2*)(pb + (size_t)m * PLE) + lane) = w;
    }
    for (int i = blockIdx.x * 512 + tid; i < 3 * M; i += G * 512) ss[M + i] = 0.f;
    if (blockIdx.x == 0 && tid < 8) ((unsigned*)(ws + WS_PROG))[tid * 32] = 0u;
}

constexpr int L_LM = 0, L_GC = L_LM + 64 * 68 * 4, L_R = L_GC + 512, L_KBF = L_R + 65536, L_QBF = L_KBF + 64 * 136 * 2, L_VST = L_QBF + 64 * 136 * 2, L_END4 = L_VST + 64 * 136 * 2;
static_assert(L_END4 <= LDS_BYTES, "lds");
__device__ __forceinline__ void prep_item(const Params& P, LAS unsigned char* lds, int item, const int pflags) {
    const int tid = opaque_tid(), lane = tid & 63, wave = tid >> 6;
    const int n = item >> 3, h = item & 7;
    unsigned char* ws = P.ws;
    bf16_t* proj = (bf16_t*)(ws + WS_PROJ);
    LAS float* Rr = (LAS float*)(lds + L_R); LAS float* Lm = (LAS float*)(lds + L_LM);
    LAS bf16_t* kbf = (LAS bf16_t*)(lds + L_KBF); LAS bf16_t* qbf = (LAS bf16_t*)(lds + L_QBF); LAS bf16_t* vst = (LAS bf16_t*)(lds + L_VST);
    LAS float* gcs = (LAS float*)(lds + L_GC);
    if (wave == 0) {
        const size_t row = (size_t)n * 64 + lane;
        const float a = bf2f(proj[row * NIN + C_AR + h]), b = bf2f(proj[row * NIN + C_BR + h]);
        const float xx = a + P.dt_bias[h];
        const float sp = xx > 20.f ? xx : log1pf(expf(xx));
        float g = -expf(P.a_log[h]) * sp;
#pragma unroll
        for (int o = 1; o < 64; o <<= 1) { const float t = __shfl_up(g, o); if (lane >= o) g += t; }
        gcs[lane] = g; gcs[64 + lane] = 1.f / (1.f + expf(-b));
    }
    const int l16 = tid & 15, rg = tid >> 4;
    float qv[2][8], kv[2][8], vv[2][8];
#pragma unroll
    for (int X = 0; X < 3; ++X) {
        const int col = (X == 0 ? C_QA : (X == 1 ? C_KA : C_VA)) + h * DH + 8 * l16;
        const int ccol = X * 1024 + h * DH + 8 * l16;
        float xin[5][8];
#pragma unroll
        for (int i = 0; i < 5; ++i) { const int gr = n * 64 + 2 * rg - 3 + i;
            if (gr >= 0) unpack8(__builtin_nontemporal_load((const u32x4*)(proj + (size_t)gr * NIN + col)), xin[i]);
            else {
#pragma unroll
                for (int e = 0; e < 8; ++e) xin[i][e] = 0.f; } }
        float y[2][8];
#pragma unroll
        for (int r = 0; r < 2; ++r)
#pragma unroll
            for (int e = 0; e < 8; ++e) y[r][e] = 0.f;
#pragma unroll
        for (int j = 0; j < 4; ++j) {
            const f32x4 c0 = *(const f32x4*)(P.conv_w + j * 3072 + ccol), c1 = *(const f32x4*)(P.conv_w + j * 3072 + ccol + 4);
#pragma unroll
            for (int r = 0; r < 2; ++r)
#pragma unroll
                for (int e = 0; e < 8; ++e) y[r][e] += (e < 4 ? c0[e] : c1[e - 4]) * xin[r + j][e];
        }
#pragma unroll
        for (int r = 0; r < 2; ++r) {
            float sq = 0.f;
#pragma unroll
            for (int e = 0; e < 8; ++e) { y[r][e] = siluf_(y[r][e]); sq += y[r][e] * y[r][e]; }
            if (X < 2) {
                sq += __shfl_xor(sq, 1); sq += __shfl_xor(sq, 2); sq += __shfl_xor(sq, 4); sq += __shfl_xor(sq, 8);
                const float rn = rsqrtf(sq + EPS) * (X == 0 ? 0.08838834764831845f : 1.f);
#pragma unroll
                for (int e = 0; e < 8; ++e) y[r][e] *= rn;
            }
#pragma unroll
            for (int e = 0; e < 8; ++e) { if (X == 0) qv[r][e] = y[r][e]; else if (X == 1) kv[r][e] = y[r][e]; else vv[r][e] = y[r][e]; }
        }
    }
#pragma unroll
    for (int r = 0; r < 2; ++r) {
        const size_t grow = (size_t)n * 64 + 2 * rg + r;
#pragma unroll
        for (int X = 0; X < 2; ++X) {
            bf16_t* ptr = proj + grow * NIN + (X == 0 ? C_QB : C_KB) + h * DH + 8 * l16;
            float f[8]; unpack8(__builtin_nontemporal_load((const u32x4*)ptr), f);
            float sq = 0.f;
#pragma unroll
            for (int e = 0; e < 8; ++e) sq += f[e] * f[e];
            sq += __shfl_xor(sq, 1); sq += __shfl_xor(sq, 2); sq += __shfl_xor(sq, 4); sq += __shfl_xor(sq, 8);
            const float rn = rsqrtf(sq * (1.f / DH) + EPS);
            const float* nwp = (X == 0 ? P.q_norm : P.k_norm) + 8 * l16;
            const f32x4 w0 = *(const f32x4*)nwp, w1 = *(const f32x4*)(nwp + 4);
#pragma unroll
            for (int e = 0; e < 8; ++e) f[e] = f[e] * rn * (e < 4 ? w0[e] : w1[e - 4]);
            *(u32x4*)ptr = pack8f(f);
        }
        const u32x4 vraw = __builtin_nontemporal_load((const u32x4*)(proj + grow * NIN + C_VB + h * DH + 8 * l16));
        *(LAS u32x4*)(vst + (2 * rg + r) * 136 + 8 * l16) = vraw;
    }
    __syncthreads();
    {
        bf16_t* qd = (bf16_t*)(ws + WS_QD) + (size_t)item * 64 * 128;
        bf16_t* ktT = (bf16_t*)(ws + WS_KTT) + (size_t)item * 128 * 64;
        const float gl = gcs[63];
        float ktl[2][8];
#pragma unroll
        for (int r = 0; r < 2; ++r) {
            const int t = 2 * rg + r; const float gc = gcs[t], bt = gcs[64 + t];
            const float eg = __expf(gc), egl = __expf(gl - gc);
            float f[8];
#pragma unroll
            for (int e = 0; e < 8; ++e) f[e] = qv[r][e] * eg;
            *(u32x4*)(qd + ((((t >> 4) * 4 + (l16 >> 2)) * 64) + (l16 & 3) * 16 + (t & 15)) * 8) = pack8f(f);
#pragma unroll
            for (int e = 0; e < 8; ++e) ktl[r][e] = kv[r][e] * egl;
            *(LAS u32x4*)(qbf + t * 136 + 8 * l16) = pack8f(qv[r]);
            *(LAS u32x4*)(kbf + t * 136 + 8 * l16) = pack8f(kv[r]);
            LAS float* rr = Rr + t * 256 + 8 * l16;
            *(LAS f32x4*)(rr) = (f32x4){vv[r][0] * bt, vv[r][1] * bt, vv[r][2] * bt, vv[r][3] * bt};
            *(LAS f32x4*)(rr + 4) = (f32x4){vv[r][4] * bt, vv[r][5] * bt, vv[r][6] * bt, vv[r][7] * bt};
            const float be = bt * eg;
            *(LAS f32x4*)(rr + 128) = (f32x4){kv[r][0] * be, kv[r][1] * be, kv[r][2] * be, kv[r][3] * be};
            *(LAS f32x4*)(rr + 132) = (f32x4){kv[r][4] * be, kv[r][5] * be, kv[r][6] * be, kv[r][7] * be};
        }
#pragma unroll
        for (int e = 0; e < 8; ++e) { const int t0 = 2 * rg; *(unsigned*)(ktT + (((((l16 >> 1) * 2 + (t0 >> 5)) * 64) + ((t0 >> 3) & 3) * 16 + 8 * (l16 & 1) + e) * 8 + (t0 & 7))) = pk2(ktl[0][e], ktl[1][e]); }
        if (tid == 0) ((float*)(ws + WS_TAIL))[item] = __expf(gl);
        bf16_t* vt = (bf16_t*)(ws + WS_VT);
        const int d = tid & 127, tg = tid >> 7;
        unsigned pw[8];
#pragma unroll
        for (int i = 0; i < 8; ++i) { const unsigned lo = vst[(16 * tg + 2 * i) * 136 + d], hi = vst[(16 * tg + 2 * i + 1) * 136 + d]; pw[i] = lo | (hi << 16); }
        bf16_t* dst = vt + (size_t)(h * DH + d) * M + n * 64 + 16 * tg;
        *(u32x4*)dst = (u32x4){pw[0], pw[1], pw[2], pw[3]}; *(u32x4*)(dst + 8) = (u32x4){pw[4], pw[5], pw[6], pw[7]};
    }
    __syncthreads();
    {
        const int fr = lane & 15, fq = lane >> 4, which = wave >> 2, ti = wave & 3;
        LAS bf16_t* X = which ? qbf : kbf;
        bf16x8 a[4];
#pragma unroll
        for (int s = 0; s < 4; ++s) a[s] = *(const LAS bf16x8*)(X + (16 * ti + fr) * 136 + 32 * s + 8 * fq);
        bf16_t* aqk = (bf16_t*)(ws + WS_AQK) + (size_t)item * 64 * 64;
        for (int tj = 0; tj < 4; ++tj) {
            f32x4 c = {0.f, 0.f, 0.f, 0.f};
            if (tj <= ti) {
#pragma unroll
                for (int s = 0; s < 4; ++s) { const bf16x8 b = *(const LAS bf16x8*)(kbf + (16 * tj + fr) * 136 + 32 * s + 8 * fq); c = MFMA16(a[s], b, c); }
            }
            const int j = 16 * tj + fr; const float gj = gcs[j];
#pragma unroll
            for (int r = 0; r < 4; ++r) {
                const int i = 16 * ti + 4 * fq + r;
                const float dec = (i >= j) ? __expf(gcs[i] - gj) : 0.f;
                if (which == 0) { Lm[i * 68 + j] = (i > j) ? gcs[64 + i] * c[r] * dec : 0.f; }
                else { const float v = (i >= j) ? c[r] * dec : 0.f; aqk[((((i >> 4) * 2 + (j >> 5)) * 64) + ((j >> 3) & 3) * 16 + (i & 15)) * 8 + (j & 7)] = (bf16_t)(pk2(v, 0.f) & 0xffffu); }
            }
        }
    }
    __syncthreads();
    if (tid < 256) {
        int Lrow[64];
#pragma unroll
        for (int i = 0; i < 64; ++i) Lrow[i] = __float_as_int(Lm[i * 68 + lane]);
        float s[64];
#define LRD(i, j) __int_as_float(__builtin_amdgcn_readlane(Lrow[i], j))
#pragma unroll
        for (int g = 0; g < 16; ++g) {
            const int i0 = 4 * g;
            float a0 = Rr[(i0 + 0) * 256 + tid], a1 = Rr[(i0 + 1) * 256 + tid], a2 = Rr[(i0 + 2) * 256 + tid], a3 = Rr[(i0 + 3) * 256 + tid];
            if (!(pflags & 8)) {
#pragma unroll
            for (int j = 0; j < i0; ++j) { const float sj = s[j]; a0 -= LRD(i0, j) * sj; a1 -= LRD(i0 + 1, j) * sj; a2 -= LRD(i0 + 2, j) * sj; a3 -= LRD(i0 + 3, j) * sj; }
            a1 -= LRD(i0 + 1, i0) * a0;
            a2 -= LRD(i0 + 2, i0) * a0; a2 -= LRD(i0 + 2, i0 + 1) * a1;
            a3 -= LRD(i0 + 3, i0) * a0; a3 -= LRD(i0 + 3, i0 + 1) * a1; a3 -= LRD(i0 + 3, i0 + 2) * a2;
            }
            s[i0] = a0; s[i0 + 1] = a1; s[i0 + 2] = a2; s[i0 + 3] = a3;
        }
#undef LRD
        if (pflags & 32) { if (s[63] == 1.2345f) ((float*)(ws + WS_U))[tid] = s[5]; } else
        if (tid < 128) { float* u = (float*)(ws + WS_U) + (size_t)item * 64 * 128 + ((tid >> 4) * 256 + (tid & 15)) * 4;
#pragma unroll
            for (int i4 = 0; i4 < 16; ++i4) *(f32x4*)(u + ((i4 >> 2) * 64 + (i4 & 3) * 16) * 4) = (f32x4){s[4 * i4], s[4 * i4 + 1], s[4 * i4 + 2], s[4 * i4 + 3]}; }
        else { const int dk = tid - 128; bf16_t* w = (bf16_t*)(ws + WS_W) + (size_t)item * 64 * 128 + (((dk >> 5) * 64) + ((dk >> 3) & 3) * 16) * 8 + (dk & 7);
#pragma unroll
            for (int i = 0; i < 64; ++i) w[((i >> 4) * 256 + (i & 15)) * 8] = (bf16_t)(pk2(s[i], 0.f) & 0xffffu); }
    }
    __syncthreads();
}

struct ScanA { bf16x8 W[4], K0[2], K1[2]; f32x4 u; float tl; };
struct ScanB { bf16x8 Q[4], A[2]; };
struct ScanOff { unsigned w, aq, kt, u; };
__device__ __forceinline__ void scan_loadA(ScanA& o, const unsigned char* ws, int c, int h, const ScanOff& f) {
    const int item = c * 8 + h;
    const unsigned char* w = ws + WS_W + (size_t)item * 16384; const unsigned char* kt = ws + WS_KTT + (size_t)item * 16384; const unsigned char* u = ws + WS_U + (size_t)item * 32768;
#pragma unroll
    for (int s = 0; s < 4; ++s) o.W[s] = __builtin_bit_cast(bf16x8, *(const u32x4*)(w + f.w + 1024 * s));
#pragma unroll
    for (int s = 0; s < 2; ++s) { o.K0[s] = __builtin_bit_cast(bf16x8, *(const u32x4*)(kt + f.kt + 1024 * s)); o.K1[s] = __builtin_bit_cast(bf16x8, *(const u32x4*)(kt + f.kt + 2048 + 1024 * s)); }
    o.u = *(const f32x4*)(u + f.u);
    o.tl = ((const float*)(ws + WS_TAIL))[item];
}
__device__ __forceinline__ void scan_loadB(ScanB& o, const unsigned char* ws, int c, int h, const ScanOff& f) {
    const int item = c * 8 + h;
    const unsigned char* qd = ws + WS_QD + (size_t)item * 16384; const unsigned char* aq = ws + WS_AQK + (size_t)item * 8192;
#pragma unroll
    for (int s = 0; s < 4; ++s) o.Q[s] = __builtin_bit_cast(bf16x8, *(const u32x4*)(qd + f.w + 1024 * s));
#pragma unroll
    for (int s = 0; s < 2; ++s) o.A[s] = __builtin_bit_cast(bf16x8, *(const u32x4*)(aq + f.aq + 1024 * s));
}
__device__ __forceinline__ void scan_stepA(const ScanA& cur, f32x4& S0, f32x4& S1, LAS bf16_t* Sl, LAS bf16_t* Vl, int fr, int fq, int mt) {
    f32x4 wsv = {0.f, 0.f, 0.f, 0.f};
#pragma unroll
    for (int s = 0; s < 4; ++s) wsv = MFMA16(cur.W[s], *(const LAS bf16x8*)(Sl + fr * 136 + 32 * s + 8 * fq), wsv);
    const f32x4 vn = cur.u - wsv;
    { u32x2 pv; pv.x = pk2(vn[0], vn[1]); pv.y = pk2(vn[2], vn[3]); *(LAS u32x2*)(Vl + fr * 72 + 16 * mt + 4 * fq) = pv; }
    __syncthreads();
    S0 = S0 * cur.tl; S1 = S1 * cur.tl;
#pragma unroll
    for (int s = 0; s < 2; ++s) { const bf16x8 Vb = *(const LAS bf16x8*)(Vl + fr * 72 + 32 * s + 8 * fq); S0 = MFMA16(cur.K0[s], Vb, S0); S1 = MFMA16(cur.K1[s], Vb, S1); }
    { u32x2 p0, p1; p0.x = pk2(S0[0], S0[1]); p0.y = pk2(S0[2], S0[3]); p1.x = pk2(S1[0], S1[1]); p1.y = pk2(S1[2], S1[3]);
      *(LAS u32x2*)(Sl + fr * 136 + 32 * mt + 4 * fq) = p0; *(LAS u32x2*)(Sl + fr * 136 + 32 * mt + 16 + 4 * fq) = p1; }
    __syncthreads();
}
__device__ __forceinline__ void scan_stepB(const ScanB& cur, const LAS bf16_t* Sl, const LAS bf16_t* Vl, bf16_t* og, int fr, int fq) {
    f32x4 qs = {0.f, 0.f, 0.f, 0.f};
#pragma unroll
    for (int s = 0; s < 4; ++s) qs = MFMA16(*(const LAS bf16x8*)(Sl + fr * 136 + 32 * s + 8 * fq), cur.Q[s], qs);
    __syncthreads();
#pragma unroll
    for (int s = 0; s < 2; ++s) qs = MFMA16(*(const LAS bf16x8*)(Vl + fr * 72 + 32 * s + 8 * fq), cur.A[s], qs);
    { u32x2 w; w.x = pk2(qs[0], qs[1]); w.y = pk2(qs[2], qs[3]); *(u32x2*)og = w; }
    __syncthreads();
}
__device__ __forceinline__ void scan_wg(const Params& P, LAS unsigned char* lds, int h, int pair, const int VAR) {
    const int tid = opaque_tid(), lane = tid & 63, wave = tid >> 6, fr = lane & 15, fq = lane >> 4, mt = wave & 3, e0 = 16 * pair;
    const unsigned char* ws = P.ws;
    LAS bf16_t* Sl = (LAS bf16_t*)(lds);
    LAS bf16_t* Vl = (LAS bf16_t*)(lds + 4352);
    for (int i = tid; i < 4352 / 4; i += 512) ((LAS unsigned*)Sl)[i] = 0u;
    ScanOff f; f.w = (unsigned)(mt * 4096 + lane * 16); f.aq = (unsigned)(mt * 2048 + lane * 16); f.kt = (unsigned)(mt * 4096 + lane * 16); f.u = (unsigned)((((e0 >> 4) * 4 + mt) * 64 + lane) * 16);
    if (wave < 4) {
        f32x4 S0 = {0.f, 0.f, 0.f, 0.f}, S1 = {0.f, 0.f, 0.f, 0.f};
        ScanA a, b, c3; scan_loadA(a, ws, 0, h, f); scan_loadA(b, ws, 1, h, f);
        __syncthreads();
#pragma unroll 1
        for (int c = 0; c < NCH - 2; c += 3) {
            if (VAR != 3) scan_loadA(c3, ws, c + 2, h, f); scan_stepA(a, S0, S1, Sl, Vl, fr, fq, mt);
            if (VAR != 3) scan_loadA(a, ws, c + 3, h, f); scan_stepA(b, S0, S1, Sl, Vl, fr, fq, mt);
            if (VAR != 3) scan_loadA(b, ws, c + 4, h, f); scan_stepA(VAR == 3 ? a : c3, S0, S1, Sl, Vl, fr, fq, mt);
        }
        scan_stepA(a, S0, S1, Sl, Vl, fr, fq, mt); scan_stepA(b, S0, S1, Sl, Vl, fr, fq, mt);
    } else {
        bf16_t* Og = (bf16_t*)(P.ws + (VAR ? WS_END : WS_YA)) + (size_t)(16 * mt + fr) * 1024 + h * DH + e0 + 4 * fq;
        ScanB a, b, c3; scan_loadB(a, ws, 0, h, f); scan_loadB(b, ws, 1, h, f);
        __syncthreads();
#pragma unroll 1
        for (int c = 0; c < NCH - 2; c += 3) {
            if (VAR != 3) scan_loadB(c3, ws, c + 2, h, f); scan_stepB(a, Sl, Vl, Og + (size_t)c * 65536, fr, fq);
            if (VAR != 3) scan_loadB(a, ws, c + 3, h, f); scan_stepB(b, Sl, Vl, Og + (size_t)(c + 1) * 65536, fr, fq);
            if (VAR != 3) scan_loadB(b, ws, c + 4, h, f); scan_stepB(VAR == 3 ? a : c3, Sl, Vl, Og + (size_t)(c + 2) * 65536, fr, fq);
        }
        scan_stepB(a, Sl, Vl, Og + (size_t)(NCH - 2) * 65536, fr, fq); scan_stepB(b, Sl, Vl, Og + (size_t)(NCH - 1) * 65536, fr, fq);
    }
}

__device__ __forceinline__ void scan_helper(const Params& P, int h, int j, int NHp) {
    const int tid = threadIdx.x;
    const unsigned char* ws = P.ws;
    unsigned* prog = (unsigned*)(P.ws + WS_PROG) + h * 32;
    for (int c = j; c < NCH; c += NHp) {
        for (;;) { const unsigned pr = __hip_atomic_load(prog, __ATOMIC_RELAXED, __HIP_MEMORY_SCOPE_AGENT); if ((int)pr + 16 >= c) break; __builtin_amdgcn_s_sleep(16); }
        const int item = c * 8 + h;
        const u32x4* w16 = (const u32x4*)(ws + WS_W + (size_t)item * 16384); const u32x4* q16 = (const u32x4*)(ws + WS_QD + (size_t)item * 16384);
        const u32x4* k16 = (const u32x4*)(ws + WS_KTT + (size_t)item * 16384); const u32x4* a16 = (const u32x4*)(ws + WS_AQK + (size_t)item * 8192);
        const u32x4* u16 = (const u32x4*)(ws + WS_U + (size_t)item * 32768);
        u32x4 v[11];
        v[0] = w16[tid]; v[1] = w16[512 + tid]; v[2] = q16[tid]; v[3] = q16[512 + tid]; v[4] = k16[tid]; v[5] = k16[512 + tid]; v[6] = a16[tid];
        v[7] = u16[tid]; v[8] = u16[512 + tid]; v[9] = u16[1024 + tid]; v[10] = u16[1536 + tid];
#pragma unroll
        for (int i = 0; i < 11; ++i) asm volatile("" :: "v"(v[i]));
    }
}

constexpr int AL_K = 0, AL_V = 2 * 64 * 272, AL_B = AL_V + 2 * 128 * 144;
__device__ __forceinline__ void attn_compute(const LAS unsigned char* Kl, const LAS unsigned char* Vl, const LAS float* biasl, const bf16x8 (&Qb)[4], f32x4 (&Ot)[8], float& mrun, float& lrun,
                                             int c, int qi, int fr, int fq) {
    const float scale = 0.08838834764831845f;
    f32x4 st[4]; float mx = -1e30f;
#pragma unroll
    for (int kt = 0; kt < 4; ++kt) {
        f32x4 a = {0.f, 0.f, 0.f, 0.f};
#pragma unroll
        for (int s = 0; s < 4; ++s) a = MFMA16(*(const LAS bf16x8*)(Kl + (16 * kt + fr) * 272 + 64 * s + 16 * fq), Qb[s], a);
#pragma unroll
        for (int r = 0; r < 4; ++r) {
            const int ki = c * 64 + 16 * kt + 4 * fq + r; int dd = qi - ki; dd = dd < -63 ? -63 : (dd > 128 ? 128 : dd);
            a[r] = a[r] * scale + biasl[dd + 63]; mx = fmaxf(mx, a[r]);
        }
        st[kt] = a;
    }
    mx = fmaxf(mx, __shfl_xor(mx, 16)); mx = fmaxf(mx, __shfl_xor(mx, 32));
    const float mnew = fmaxf(mrun, mx), alpha = __expf(mrun - mnew); mrun = mnew;
    float rsum = 0.f;
#pragma unroll
    for (int kt = 0; kt < 4; ++kt)
#pragma unroll
        for (int r = 0; r < 4; ++r) { const float p = __expf(st[kt][r] - mnew); st[kt][r] = p; rsum += p; }
    lrun = lrun * alpha + rsum;
    bf16x8 Pb[2];
#pragma unroll
    for (int s = 0; s < 2; ++s) Pb[s] = pack_acc(st[2 * s], st[2 * s + 1]);
#pragma unroll
    for (int dt = 0; dt < 8; ++dt) {
        f32x4 o = Ot[dt] * alpha;
#pragma unroll
        for (int s = 0; s < 2; ++s) { const LAS unsigned char* pv = Vl + (16 * dt + fr) * 144 + 64 * s + 8 * fq;
            const u32x2 lo = *(const LAS u32x2*)pv, hi = *(const LAS u32x2*)(pv + 32); u32x4 av; av.x = lo.x; av.y = lo.y; av.z = hi.x; av.w = hi.y;
            o = MFMA16(__builtin_bit_cast(bf16x8, av), Pb[s], o); }
        Ot[dt] = o;
    }
}
__device__ __forceinline__ void attn_item(const Params& P, LAS unsigned char* lds, int m, int h) {
    const int tid = opaque_tid(), lane = tid & 63, wave = tid >> 6, fr = lane & 15, fq = lane >> 4;
    unsigned char* ws = P.ws;
    const bf16_t* proj = (const bf16_t*)(ws + WS_PROJ); const bf16_t* vt = (const bf16_t*)(ws + WS_VT); bf16_t* yb = (bf16_t*)(ws + WS_YB);
    LAS float* biasl = (LAS float*)(lds + AL_B);
    const int nq = 2 * m + (wave >> 2), w4 = wave & 3;
    const int qi = nq * 64 + 16 * w4 + fr;
    const int cbeg = 2 * m - 8 < 0 ? 0 : 2 * m - 8, cend = 2 * m + 1;
    const bf16_t* kg[2]; const bf16_t* vg[2]; int kl[2], vl[2];
#pragma unroll
    for (int i = 0; i < 2; ++i) { const int p = tid + 512 * i;
        kg[i] = proj + (size_t)(p >> 4) * NIN + C_KB + h * DH + 8 * (p & 15); kl[i] = (p >> 4) * 272 + 16 * (p & 15);
        vg[i] = vt + (size_t)(h * DH + (p >> 3)) * M + 8 * (p & 7); vl[i] = (p >> 3) * 144 + 16 * (p & 7); }
#define ATT_LOAD(KR, VR, C) do { _Pragma("unroll") for (int i = 0; i < 2; ++i) { KR[i] = *(const u32x4*)(kg[i] + (size_t)(C) * 64 * NIN); VR[i] = *(const u32x4*)(vg[i] + (C) * 64); } } while (0)
#define ATT_WRITE(KR, VR, BUF) do { _Pragma("unroll") for (int i = 0; i < 2; ++i) { *(LAS u32x4*)(lds + AL_K + (BUF) * (64 * 272) + kl[i]) = KR[i]; *(LAS u32x4*)(lds + AL_V + (BUF) * (128 * 144) + vl[i]) = VR[i]; } } while (0)
    u32x4 kA[2], vA[2], kB[2], vB[2];
    ATT_LOAD(kA, vA, cbeg);
    ATT_LOAD(kB, vB, cbeg + 1);
    if (tid < 192) biasl[tid] = P.rel_bias[h * 192 + tid];
    bf16x8 Qb[4];
#pragma unroll
    for (int s = 0; s < 4; ++s) Qb[s] = ld8(proj + (size_t)qi * NIN + C_QB + h * DH + 32 * s + 8 * fq);
    ATT_WRITE(kA, vA, 0);
    __syncthreads();
    float mrun = -1e30f, lrun = 0.f;
    f32x4 Ot[8];
#pragma unroll
    for (int i = 0; i < 8; ++i) Ot[i] = (f32x4){0.f, 0.f, 0.f, 0.f};
#pragma unroll 1
    for (int c = cbeg; c <= cend; c += 2) {
        if (c + 2 <= cend) ATT_LOAD(kA, vA, c + 2);
        if (c >= nq - 8 && c <= nq) attn_compute(lds + AL_K, lds + AL_V, biasl, Qb, Ot, mrun, lrun, c, qi, fr, fq);
        if (c + 1 <= cend) ATT_WRITE(kB, vB, 1);
        __syncthreads();
        if (c + 1 > cend) break;
        if (c + 3 <= cend) ATT_LOAD(kB, vB, c + 3);
        if (c + 1 >= nq - 8 && c + 1 <= nq) attn_compute(lds + AL_K + 64 * 272, lds + AL_V + 128 * 144, biasl, Qb, Ot, mrun, lrun, c + 1, qi, fr, fq);
        if (c + 2 <= cend) ATT_WRITE(kA, vA, 0);
        __syncthreads();
    }
#undef ATT_LOAD
#undef ATT_WRITE
    lrun += __shfl_xor(lrun, 16); lrun += __shfl_xor(lrun, 32);
    const float inv = 1.f / lrun;
#pragma unroll
    for (int dt = 0; dt < 8; ++dt) { u32x2 w; w.x = pk2(Ot[dt][0] * inv, Ot[dt][1] * inv); w.y = pk2(Ot[dt][2] * inv, Ot[dt][3] * inv);
        *(u32x2*)(yb + (size_t)qi * 1024 + h * DH + 16 * dt + 4 * fq) = w; }
}

__device__ __forceinline__ void phase_gnorm(const Params& P, int G) {
    unsigned char* ws = P.ws;
    bf16_t* ya = (bf16_t*)(ws + WS_YA); const bf16_t* proj = (const bf16_t*)(ws + WS_PROJ);
    const int gt = blockIdx.x * 512 + opaque_tid(), l16 = gt & 15;
    const f32x4 w0 = *(const f32x4*)(P.gdn_norm + 8 * l16), w1 = *(const f32x4*)(P.gdn_norm + 8 * l16 + 4);
    for (int g = gt >> 4; g < M * NH; g += (G * 512) >> 4) {
        const int row = g >> 3, h = g & 7;
        bf16_t* po = ya + (size_t)row * 1024 + h * DH + 8 * l16;
        float o[8], z[8]; unpack8(*(const u32x4*)po, o); unpack8(__builtin_nontemporal_load((const u32x4*)(proj + (size_t)row * NIN + C_Z + h * DH + 8 * l16)), z);
        float sq = 0.f;
#pragma unroll
        for (int e = 0; e < 8; ++e) sq += o[e] * o[e];
        sq += __shfl_xor(sq, 1); sq += __shfl_xor(sq, 2); sq += __shfl_xor(sq, 4); sq += __shfl_xor(sq, 8);
        const float rn = rsqrtf(sq * (1.f / DH) + EPS);
#pragma unroll
        for (int e = 0; e < 8; ++e) o[e] = o[e] * rn * (e < 4 ? w0[e] : w1[e - 4]) * siluf_(z[e]);
        *(u32x4*)po = pack8f(o);
    }
}


#define XB_TMO      128
#define XB_XCNT(j)  (256  + 64 * (j))
#define XB_XSUB(j)  (1280 + 64 * (j))
#define XB_XGEN(j)  (2304 + 64 * (j))
#define XB_TOP      3328
#define XB_TOPGEN   3392
#define XCD_BAR_WORDS 3456
#define XB_SPIN_CAP (1u << 18)
__device__ __forceinline__ unsigned xb_ld(unsigned* p)              { return __hip_atomic_load(p, __ATOMIC_RELAXED, __HIP_MEMORY_SCOPE_AGENT); }
__device__ __forceinline__ unsigned xb_add(unsigned* p, unsigned v) { return __hip_atomic_fetch_add(p, v, __ATOMIC_RELAXED, __HIP_MEMORY_SCOPE_AGENT); }
__device__ __forceinline__ unsigned xb_xcc_id() { return (unsigned)__builtin_amdgcn_s_getreg((3 << 11) | 20) & 0xFu; }
#define XB_SPIN(cond, bar) do { unsigned _sp = 0; while (cond) { __builtin_amdgcn_s_sleep(1); \
    if ((++_sp & 255u) == 0u) { if (xb_ld(&(bar)[XB_TMO])) break; if (_sp > XB_SPIN_CAP) { atomicAdd(&(bar)[XB_TMO], 1u); break; } } } } while (0)
struct XcdBarrier { unsigned* bar; unsigned x; volatile LAS unsigned* st; };
__device__ __forceinline__ XcdBarrier xcd_barrier_post(unsigned* bar, volatile LAS unsigned* st) {
    XcdBarrier b; b.bar = bar; b.x = xb_xcc_id(); b.st = st;
    if (threadIdx.x == 0) (void)xb_add(&bar[XB_XCNT(b.x)], 1u);
    return b;
}
__device__ __forceinline__ void xcd_barrier_complete(unsigned* bar, unsigned x, unsigned& nloc, unsigned& nx) {
    const unsigned G = gridDim.x * gridDim.y * gridDim.z;
    unsigned sum, cnt, mine, sp = 0u;
    for (;;) {
        sum = 0u; cnt = 0u; mine = 0u;
#pragma unroll
        for (unsigned j = 0; j < 16; ++j) { const unsigned c = xb_ld(&bar[XB_XCNT(j)]); sum += c; cnt += (c > 0u) ? 1u : 0u; mine = (j == x) ? c : mine; }
        if (sum == G) break;
        __builtin_amdgcn_s_sleep(1);
        if ((++sp & 255u) == 0u) { if (xb_ld(&bar[XB_TMO])) break; if (sp > XB_SPIN_CAP) { atomicAdd(&bar[XB_TMO], 1u); break; } }
    }
    nloc = mine > 0u ? mine : 1u; nx = cnt > 0u ? cnt : 1u;
}
__device__ __forceinline__ void xcd_barrier(const XcdBarrier& b) {
    asm volatile("s_waitcnt vmcnt(0)" ::: "memory");
    __syncthreads();
    if (threadIdx.x == 0) {
        unsigned* bar = b.bar;
        __builtin_amdgcn_s_waitcnt(0);
        unsigned nloc = b.st[0], nx = b.st[1];
        if (nloc == 0u) { xcd_barrier_complete(bar, b.x, nloc, nx); b.st[0] = nloc; b.st[1] = nx; }
        const unsigned old = xb_add(&bar[XB_XSUB(b.x)], 1u);
        const unsigned gen = old / nloc;
        if (old + 1u == (gen + 1u) * nloc) {
            __builtin_amdgcn_fence(__ATOMIC_RELEASE, "agent");
            asm volatile("s_waitcnt vmcnt(0)" ::: "memory");
            const unsigned og = xb_add(&bar[XB_TOP], 1u);
            const unsigned tg = og / nx;
            if (og + 1u == (tg + 1u) * nx) xb_add(&bar[XB_TOPGEN], 1u);
            else XB_SPIN(xb_ld(&bar[XB_TOPGEN]) == tg, bar);
            __builtin_amdgcn_fence(__ATOMIC_ACQUIRE, "agent");
            xb_add(&bar[XB_XGEN(b.x)], 1u);
            asm volatile("s_waitcnt vmcnt(0)" ::: "memory");
        } else {
            XB_SPIN(xb_ld(&bar[XB_XGEN(b.x)]) == gen, bar);
            __builtin_amdgcn_fence(__ATOMIC_ACQUIRE, "agent");
            asm volatile("s_waitcnt vmcnt(0)" ::: "memory");
        }
    }
    __syncthreads();
}

constexpr int NPHASE = 11;
__global__ void __launch_bounds__(512, 2) fwd_megakernel(Params P) {
    extern __shared__ __attribute__((aligned(16))) unsigned char smem[];
    LAS unsigned char* lds = (LAS unsigned char*)smem;
    cg::grid_group grid = cg::this_grid();
    const int G = gridDim.x, lo = P.ph_lo, hi = P.ph_hi & 255, pflags = P.ph_hi >> 8;
    unsigned char* ws = P.ws;
    float* ss = (float*)(ws + WS_SS);
    bf16_t* xb = (bf16_t*)(ws + WS_XB); bf16_t* act = (bf16_t*)(ws + WS_ACT); bf16_t* proj = (bf16_t*)(ws + WS_PROJ);
#ifndef NREP5
#define NREP5 1
#endif
#ifndef REP_PHASE
#define REP_PHASE -1
#endif
#define IN(k) (lo <= (k) && (k) < hi)
    volatile LAS unsigned* xst = (volatile LAS unsigned*)(lds + LDS_BYTES - 16);
    if (threadIdx.x == 0) { xst[0] = 0u; xst[1] = 0u; }
    __syncthreads();
    XcdBarrier xbar = xcd_barrier_post((unsigned*)(ws + WS_BAR), xst);
    if (lo < 0) grid.sync();
#define SEAM(k) do { if (IN(k) && IN((k) + 1)) xcd_barrier(xbar); } while (0)
    for (int rep = 0; rep < (REP_PHASE == 0 ? 2 : 1); ++rep) { if (IN(0)) phase_convert(P, lds, G);
    SEAM(0); }
    for (int rep = 0; rep < (REP_PHASE == 1 ? 2 : 1); ++rep) {
    if (IN(1)) { pg8::Sched S; S.init(xb, (const bf16_t*)(ws + WS_WGU1), nullptr, nullptr, M, NGU, G, blockIdx.x, 0); EpiGU E{act, ss}; pg8::gemm_phase(lds, D, S, E);
        idle_convert(P, lds, (M / 256) * (NGU / 256), G, -1, 0); }
    SEAM(1); }
    if (IN(2)) { pg8::Sched S; S.init(act, (const bf16_t*)(ws + WS_WD1), nullptr, nullptr, M, D, G, blockIdx.x, 0); EpiRes E{P.x, P.out, xb, ss + M, 0.5f}; pg8::gemm_phase(lds, FF, S, E); }
    SEAM(2);
    if (IN(3)) { pg8::Sched S; S.init(xb, (const bf16_t*)(ws + WS_WIN), nullptr, nullptr, M, NIN, G, blockIdx.x, 0); EpiProj E{proj, ss + M}; pg8::gemm_phase(lds, D, S, E);
        idle_convert(P, lds, (M / 256) * (NIN / 256), G, 0, LATE_A); }
    SEAM(3);
    if (IN(4)) { const int nit = (NCH * NH - 1 - (int)blockIdx.x) / G; for (int k = nit; k >= 0; --k) prep_item(P, lds, blockIdx.x + k * G, pflags); }
    SEAM(4);
_Pragma("unroll 1")
    for (int rep = 0; rep < NREP5; ++rep) {
    if (IN(5)) {
        const int tid5 = opaque_tid(), wave = tid5 >> 6, b = blockIdx.x;
        if (b < 64) { if (!(pflags & 4)) scan_wg(P, lds, b & 7, b >> 3, 0); }
        else { if (!(pflags & 2)) for (int it = b - 64; it < (NCH / 2) * NH; it += G - 64) attn_item(P, lds, it >> 3, it & 7);
            if (!(pflags & 1)) convert_late(P, (LAS float*)(lds + wave * 17408), ((((M / 256) * (NIN / 256)) % G) ? LATE_A : 0), ((((M / 256) * (NGU / 256)) % G) ? LATE_C : N_LATE), (b - 64) * 8 + wave, (G - 64) * 8, tid5 & 63); }
    }
    SEAM(5); }
    if (IN(6)) phase_gnorm(P, G);
    SEAM(6);
    if (IN(7)) { pg8::Sched S; S.init((const bf16_t*)(ws + WS_YA), (const bf16_t*)(ws + WS_WA), (const bf16_t*)(ws + WS_YB), (const bf16_t*)(ws + WS_WB), M, D, G, blockIdx.x, 1);
        EpiMix E{proj, (bf16_t*)(ws + WS_MIX)}; pg8::gemm_phase(lds, 1024, S, E); }
    SEAM(7);
    if (IN(8)) { pg8::Sched S; S.init((const bf16_t*)(ws + WS_MIX), (const bf16_t*)(ws + WS_WOUT), nullptr, nullptr, M, D, G, blockIdx.x, 0); EpiRes E{P.out, P.out, xb, ss + 2 * M, 1.0f}; pg8::gemm_phase(lds, D, S, E); }
    SEAM(8);
    if (IN(9)) { pg8::Sched S; S.init(xb, (const bf16_t*)(ws + WS_WGU2), nullptr, nullptr, M, NGU, G, blockIdx.x, 0); EpiGU E{act, ss + 2 * M}; pg8::gemm_phase(lds, D, S, E);
        idle_convert(P, lds, (M / 256) * (NGU / 256), G, LATE_C, N_LATE); }
    SEAM(9);
    if (IN(10)) { pg8::Sched S; S.init(act, (const bf16_t*)(ws + WS_WD2), nullptr, nullptr, M, D, G, blockIdx.x, 0); EpiRes E{P.out, P.out, xb, ss + 3 * M, 0.5f}; pg8::gemm_phase(lds, FF, S, E); }
    SEAM(10);
    if (IN(11)) {
        { pg8::Sched S; S.init((const bf16_t*)(ws + WS_PB), (const bf16_t*)(ws + WS_WPP), nullptr, nullptr, M, D, G, blockIdx.x, 0); EpiF32 E{(float*)(ws + WS_RBUF)}; pg8::gemm_phase(lds, PLE, S, E); }
        { pg8::Sched S; S.init(xb, (const bf16_t*)(ws + WS_WPG), nullptr, nullptr, M, D, G, blockIdx.x, 0); EpiPle E{P.out, (const float*)(ws + WS_RBUF), ss + 3 * M}; pg8::gemm_phase(lds, D, S, E); }
    }
#undef IN
#undef SEAM
}


#ifdef PROBE_VAR
__global__ void __launch_bounds__(512, 2) probe_scan(Params P) {
    extern __shared__ __attribute__((aligned(16))) unsigned char smem[];
    scan_wg(P, (LAS unsigned char*)smem, blockIdx.x & 7, blockIdx.x >> 3, PROBE_VAR);
}
#endif
#ifndef N_LAUNCH_MODE
#define N_LAUNCH_MODE 0
#endif
extern "C" void kernel_launch(void* const* d_in, const int* in_sizes, int n_in, void* d_out, int out_size, void* d_ws, size_t ws_size, hipStream_t stream) {
    static int grid = 0;
    if (grid == 0) {
        if (n_in != 23 || out_size != M * D || ws_size < WS_END) { fprintf(stderr, "kernel_launch: unexpected problem (n_in %d out %d ws %zu need %zu)\n", n_in, out_size, ws_size, (size_t)WS_END); grid = -1; return; }
        int dev = 0, cus = 0, per_cu = 0;
        hipGetDevice(&dev); hipDeviceGetAttribute(&cus, hipDeviceAttributeMultiprocessorCount, dev);
        if (hipFuncSetAttribute((const void*)fwd_megakernel, hipFuncAttributeMaxDynamicSharedMemorySize, LDS_BYTES) != hipSuccess) { fprintf(stderr, "kernel_launch: hipFuncSetAttribute failed\n"); grid = -1; return; }
        if (hipOccupancyMaxActiveBlocksPerMultiprocessor(&per_cu, (const void*)fwd_megakernel, 512, LDS_BYTES) != hipSuccess || per_cu < 1) { fprintf(stderr, "kernel_launch: occupancy query failed (%d)\n", per_cu); (void)hipGetLastError(); per_cu = 1; }
        grid = cus * 1;
        if (grid < 192) { fprintf(stderr, "kernel_launch: grid too small\n"); grid = -1; return; }
    }
    if (grid < 0) return;
    if (hipMemsetAsync((char*)d_ws + WS_BAR, 0, 16384, stream) != hipSuccess) { fprintf(stderr, "kernel_launch: memset of the barrier words failed\n"); return; }
    Params p{};
    const float** pp = (const float**)&p;
    for (int i = 0; i < 23; ++i) pp[i] = (const float*)d_in[i];
    p.out = (float*)d_out; p.ws = (unsigned char*)d_ws;
#if N_LAUNCH_MODE == 0
    p.ph_lo = 0; p.ph_hi = NPHASE + 1;
    void* args[] = {&p};
    hipError_t e = hipLaunchCooperativeKernel((const void*)fwd_megakernel, dim3(grid), dim3(512), args, LDS_BYTES, stream);
    if (e != hipSuccess) fprintf(stderr, "cooperative launch failed: %s (grid %d)\n", hipGetErrorString(e), grid);
#ifdef PROBE_VAR
    hipLaunchKernelGGL(probe_scan, dim3(64), dim3(512), 16384, stream, p);
#endif
#ifdef PROBE_PHASE
    p.ph_lo = PROBE_PHASE; p.ph_hi = (PROBE_PHASE + 1) | (PROBE_FLAGS << 8); hipLaunchKernelGGL(fwd_megakernel, dim3(grid), dim3(512), LDS_BYTES, stream, p);
#endif
#else
    for (int ph = 0; ph <= NPHASE; ++ph) { p.ph_lo = ph; p.ph_hi = ph + 1; hipLaunchKernelGGL(fwd_megakernel, dim3(grid), dim3(512), LDS_BYTES, stream, p); }
#endif
}
```

```cpp
#include <hip/hip_runtime.h>
#include <hip/hip_cooperative_groups.h>
#include <cstdio>
namespace cg = cooperative_groups;

#define LAS __attribute__((address_space(3)))
typedef unsigned short bf16_t;
typedef short bf16x8 __attribute__((ext_vector_type(8)));
typedef float f32x4 __attribute__((ext_vector_type(4)));
typedef unsigned u32x4 __attribute__((ext_vector_type(4)));
typedef unsigned u32x2 __attribute__((ext_vector_type(2)));
typedef __bf16 bf16v2 __attribute__((ext_vector_type(2)));

constexpr int M = 8192, D = 2048, FF = 5632, NGU = 11264, NIN = 11520, NINSRC = 11280, PLE = 256;
constexpr int NH = 8, DH = 128, NCH = 128;
constexpr int C_QA = 0, C_KA = 1024, C_VA = 2048, C_Z = 3072, C_QB = 4096, C_KB = 5120, C_VB = 6144, C_GA = 7168, C_GB = 9216, C_AR = 11264, C_BR = 11272;
constexpr float EPS = 1e-6f;
constexpr size_t WS_WGU1 = 0;
constexpr size_t WS_WD1  = WS_WGU1 + (size_t)NGU * D * 2;
constexpr size_t WS_WIN  = WS_WD1 + (size_t)D * FF * 2;
constexpr size_t WS_WA   = WS_WIN + (size_t)NIN * D * 2;
constexpr size_t WS_WB   = WS_WA + (size_t)D * 1024 * 2;
constexpr size_t WS_WOUT = WS_WB + (size_t)D * 1024 * 2;
constexpr size_t WS_WGU2 = WS_WOUT + (size_t)D * D * 2;
constexpr size_t WS_WD2  = WS_WGU2 + (size_t)NGU * D * 2;
constexpr size_t WS_WPG  = WS_WD2 + (size_t)D * FF * 2;
constexpr size_t WS_WPP  = WS_WPG + (size_t)D * D * 2;
constexpr size_t WS_XB   = WS_WPP + (size_t)D * PLE * 2;
constexpr size_t WS_PROJ = WS_XB + (size_t)M * D * 2;
constexpr size_t WS_AQK  = WS_PROJ + (size_t)M * NIN * 2;
constexpr size_t WS_KTT  = WS_AQK + (size_t)1024 * 64 * 64 * 2;
constexpr size_t WS_PB   = WS_KTT + (size_t)M * 1024 * 2;
constexpr size_t WS_VT   = WS_PB + (size_t)M * PLE * 2;
constexpr size_t WS_SS   = WS_VT + (size_t)M * 1024 * 2;
constexpr size_t WS_TAIL = WS_SS + (size_t)4 * M * 4;
constexpr size_t WS_PROG = WS_TAIL + 4096;
constexpr size_t WS_BAR  = WS_PROG + 4096;
constexpr size_t WS_END  = WS_BAR + 16384;
constexpr size_t WS_ACT  = WS_PROJ;
constexpr size_t WS_RBUF = WS_PROJ;
constexpr size_t WS_U    = 0;
constexpr size_t WS_W    = WS_U + (size_t)M * 1024 * 4;
constexpr size_t WS_QD   = WS_W + (size_t)M * 1024 * 2;
constexpr size_t WS_MIX  = 0;
constexpr size_t WS_YB   = WS_XB;
constexpr size_t WS_YA   = WS_XB + (size_t)M * 1024 * 2;
static_assert(WS_QD + (size_t)M * 1024 * 2 <= WS_WIN, "gdn scratch overlaps live weights");

constexpr int LDS_BYTES = 147456;

__device__ __forceinline__ unsigned pk2(float lo, float hi) { bf16v2 v = {(__bf16)lo, (__bf16)hi}; return __builtin_bit_cast(unsigned, v); }
__device__ __forceinline__ float bf2f(bf16_t b) { return __uint_as_float(((unsigned)b) << 16); }
__device__ __forceinline__ float bflo(unsigned w) { return __uint_as_float(w << 16); }
__device__ __forceinline__ float bfhi(unsigned w) { return __uint_as_float(w & 0xffff0000u); }
__device__ __forceinline__ void unpack8(u32x4 w, float (&f)[8]) { f[0] = bflo(w.x); f[1] = bfhi(w.x); f[2] = bflo(w.y); f[3] = bfhi(w.y); f[4] = bflo(w.z); f[5] = bfhi(w.z); f[6] = bflo(w.w); f[7] = bfhi(w.w); }
__device__ __forceinline__ u32x4 pack8f(const float (&f)[8]) { u32x4 w; w.x = pk2(f[0], f[1]); w.y = pk2(f[2], f[3]); w.z = pk2(f[4], f[5]); w.w = pk2(f[6], f[7]); return w; }
__device__ __forceinline__ bf16x8 pack_acc(f32x4 a, f32x4 b) { u32x4 p; p.x = pk2(a[0], a[1]); p.y = pk2(a[2], a[3]); p.z = pk2(b[0], b[1]); p.w = pk2(b[2], b[3]); return __builtin_bit_cast(bf16x8, p); }
__device__ __forceinline__ bf16x8 ld2x8(const bf16_t* p0, const bf16_t* p1) { const u32x2 a = *(const u32x2*)p0, b = *(const u32x2*)p1; u32x4 v; v.x = a.x; v.y = a.y; v.z = b.x; v.w = b.y; return __builtin_bit_cast(bf16x8, v); }
__device__ __forceinline__ bf16x8 ld8(const bf16_t* p) { return __builtin_bit_cast(bf16x8, *(const u32x4*)p); }
__device__ __forceinline__ float sigmoidf_(float x) { return __builtin_amdgcn_rcpf(1.f + __expf(-x)); }
__device__ __forceinline__ float siluf_(float x) { return x * __builtin_amdgcn_rcpf(1.f + __expf(-x)); }
__device__ __forceinline__ float wave_sum(float v) {
#pragma unroll
    for (int o = 1; o < 64; o <<= 1) v += __shfl_xor(v, o);
    return v;
}
__device__ __forceinline__ int opaque_tid() { int t = threadIdx.x; asm volatile("" : "+v"(t)); return t; }
#define MFMA16(a, b, c) __builtin_amdgcn_mfma_f32_16x16x32_bf16((a), (b), (c), 0, 0, 0)

namespace pg8 {
constexpr int BM = 256, BK = 64, HALF = 128, HTB = HALF * BK * 2, STAGE_BYTES = 8 * HTB, NXCD = 8, WGM = 8;
__device__ __forceinline__ int lds_byte(int r, int c) { const int st = (r >> 4) * 2 + (c >> 5), rr = r & 15, cc = c & 31, ob = rr * 64 + cc * 2; return st * 1024 + (ob ^ (((ob >> 9) & 1) << 5)); }
__device__ __forceinline__ void stage_rc(int b, int& R, int& C) { const int st = b / 1024, sb = b % 1024, swz = sb ^ (((sb >> 9) & 1) << 5); R = (st >> 1) * 16 + swz / 64; C = (st & 1) * 32 + (swz % 64) / 2; }
__device__ __forceinline__ int perm32(int rho) { const int n = rho >> 4, i = rho & 15; return 8 * (i >> 2) + 4 * n + (i & 3); }

struct Unit { int pm, pn, sel; };
struct Sched {
    const bf16_t *A0, *B0, *A1, *B1;
    int nM, nN, nwg, G, c, dual;
    __device__ __forceinline__ void init(const bf16_t* a0, const bf16_t* b0, const bf16_t* a1, const bf16_t* b1, int Mr, int Nc, int G_, int c_, int dual_) {
        A0 = a0; B0 = b0; A1 = a1; B1 = b1; nM = Mr / BM; nN = Nc / BM; nwg = nM * nN; G = G_; c = c_; dual = dual_; }
    __device__ __forceinline__ bool next(int i, Unit& u) const {
        const int tile = dual ? (i >> 1) : i;
        const long L = (long)tile * G + c; if (L >= nwg) return false;
        int wgid = (int)L; { const int q = nwg / NXCD, r = nwg % NXCD, xcd = wgid % NXCD, off = wgid / NXCD; wgid = (xcd < r ? xcd * (q + 1) : r * (q + 1) + (xcd - r) * q) + off; }
        const int nig = WGM * nN, gid = wgid / nig, fm = gid * WGM, gsz = (nM - fm) < WGM ? (nM - fm) : WGM;
        u.pm = fm + ((wgid % nig) % gsz); u.pn = (wgid % nig) / gsz; u.sel = dual ? (i & 1) : 0; return true;
    }
};

template <class Epi>
__device__ __forceinline__ void gemm_phase(LAS unsigned char* lds, const int K, const Sched& S, const Epi& E) {
    const int tid = opaque_tid(), wid = __builtin_amdgcn_readfirstlane(tid >> 6), lane = tid & 63, wr = wid >> 2, wc = wid & 3, fr = lane & 15, fq = lane >> 4;
    const int nt = K / BK;
    unsigned voffA[2], voffB[2];
#pragma unroll
    for (int i = 0; i < 2; ++i) { int R, C; stage_rc(tid * 16 + i * 8192, R, C); const int Rb = Epi::PERM ? ((R & ~31) + perm32(R & 31)) : R;
        voffA[i] = (unsigned)(R * K + C) * 2u; voffB[i] = (unsigned)(Rb * K + C) * 2u; }
    const size_t kstep = (size_t)(BK * 2);
    const size_t hstep = (size_t)HALF * K * 2;
    const size_t tstep = 2 * hstep;
    const unsigned ldsw = (unsigned)wid * 1024u;
    const int aoff = lds_byte(wr * 64 + fr, fq * 8), boff = lds_byte(wc * 32 + fr, fq * 8);
#define PG8_SA(b, h) (((b) * 2 + (h)) * HTB)
#define PG8_SB(b, h) ((4 + (b) * 2 + (h)) * HTB)
#define PG8_STAGE(bufoff, gbase, voff) do { _Pragma("unroll") for (int _i = 0; _i < 2; ++_i) \
        __builtin_amdgcn_global_load_lds((const unsigned*)((const char*)(gbase) + (voff)[_i]), (LAS unsigned*)(lds + (bufoff) + ldsw + _i * 8192), 16, 0, 0); } while (0)
#define PG8_LDA(dst, b, h) do { _Pragma("unroll") for (int m = 0; m < 4; ++m) _Pragma("unroll") for (int k = 0; k < 2; ++k) dst[m][k] = *(const LAS bf16x8*)(lds + PG8_SA(b, h) + aoff + m * 2048 + k * 1024); } while (0)
#define PG8_LDB(dst, b, h) do { _Pragma("unroll") for (int n = 0; n < 2; ++n) _Pragma("unroll") for (int k = 0; k < 2; ++k) dst[n][k] = *(const LAS bf16x8*)(lds + PG8_SB(b, h) + boff + n * 2048 + k * 1024); } while (0)
#define PG8_MMA(ai, bj, At, Bt) do { __builtin_amdgcn_s_setprio(1); _Pragma("unroll") for (int m = 0; m < 4; ++m) _Pragma("unroll") for (int n = 0; n < 2; ++n) _Pragma("unroll") for (int k = 0; k < 2; ++k) \
        acc[ai][bj][m][n] = __builtin_amdgcn_mfma_f32_16x16x32_bf16(Bt[n][k], At[m][k], acc[ai][bj][m][n], 0, 0, 0); __builtin_amdgcn_s_setprio(0); } while (0)
#define PG8_WAIT_V(n) asm volatile("s_waitcnt vmcnt(" #n ")" ::: "memory")
#define PG8_WAIT_L(n) asm volatile("s_waitcnt lgkmcnt(" #n ")" ::: "memory")
#define PG8_BAR __builtin_amdgcn_s_barrier()
#define PG8_SCHED __builtin_amdgcn_sched_barrier(0)
    Unit cur, nxt; int ui = 0;
    if (!S.next(0, cur)) return;
    float ssv[8]; E.pre(cur, wr, fr, ssv);
    f32x4 acc[2][2][4][2];
#pragma unroll
    for (int a = 0; a < 2; ++a)
#pragma unroll
        for (int b = 0; b < 2; ++b)
#pragma unroll
            for (int m = 0; m < 4; ++m)
#pragma unroll
                for (int n = 0; n < 2; ++n) acc[a][b][m][n] = (f32x4){0.f, 0.f, 0.f, 0.f};
    bf16x8 At[4][2], B0[2][2], B1[2][2];
    const char* cA = (const char*)(cur.sel ? S.A1 : S.A0) + (size_t)cur.pm * tstep; const char* cB = (const char*)(cur.sel ? S.B1 : S.B0) + (size_t)cur.pn * tstep;
    PG8_STAGE(PG8_SB(0, 0), cB, voffB); PG8_STAGE(PG8_SA(0, 0), cA, voffA); PG8_STAGE(PG8_SB(0, 1), cB + hstep, voffB); PG8_STAGE(PG8_SA(0, 1), cA + hstep, voffA);
    if (wr == 1) PG8_BAR;
    PG8_WAIT_V(4); PG8_BAR;
    PG8_STAGE(PG8_SB(1, 0), cB + kstep, voffB); PG8_STAGE(PG8_SA(1, 0), cA + kstep, voffA); PG8_STAGE(PG8_SB(1, 1), cB + hstep + kstep, voffB);
    PG8_WAIT_V(6); PG8_BAR;
    for (;;) {
        const bool has_next = S.next(ui + 1, nxt);
        const char* nA = has_next ? (const char*)(nxt.sel ? S.A1 : S.A0) + (size_t)nxt.pm * tstep : cA; const char* nB = has_next ? (const char*)(nxt.sel ? S.B1 : S.B0) + (size_t)nxt.pn * tstep : cB;
        for (int t = 0; t < nt; t += 2) {
            const bool last = (t == nt - 2);
            const char* a1 = cA + (size_t)(t + 1) * kstep;
            const char* a2 = last ? nA : cA + (size_t)(t + 2) * kstep; const char* b2 = last ? nB : cB + (size_t)(t + 2) * kstep;
            const char* a3 = a2 + kstep; const char* b3 = b2 + kstep;
            PG8_LDB(B0, 0, 0); PG8_SCHED; PG8_LDA(At, 0, 0); PG8_STAGE(PG8_SA(1, 1), a1 + hstep, voffA);
            PG8_WAIT_L(8); PG8_BAR; PG8_WAIT_L(0); PG8_MMA(0, 0, At, B0); PG8_BAR; PG8_SCHED;
            PG8_LDB(B1, 0, 1); PG8_STAGE(PG8_SB(0, 0), b2, voffB);
            PG8_BAR; PG8_WAIT_L(0); PG8_MMA(0, 1, At, B1); PG8_BAR;
            PG8_LDA(At, 0, 1); PG8_STAGE(PG8_SA(0, 0), a2, voffA);
            PG8_BAR; PG8_WAIT_L(0); PG8_MMA(1, 0, At, B0); PG8_BAR; PG8_SCHED;
            PG8_STAGE(PG8_SB(0, 1), b2 + hstep, voffB);
            PG8_WAIT_V(6); PG8_BAR; PG8_MMA(1, 1, At, B1); PG8_BAR;
            PG8_LDB(B0, 1, 0); PG8_SCHED; PG8_LDA(At, 1, 0); PG8_STAGE(PG8_SA(0, 1), a2 + hstep, voffA);
            PG8_WAIT_L(8); PG8_BAR; PG8_WAIT_L(0); PG8_MMA(0, 0, At, B0); PG8_BAR; PG8_SCHED;
            PG8_LDB(B1, 1, 1); PG8_STAGE(PG8_SB(1, 0), b3, voffB);
            PG8_BAR; PG8_WAIT_L(0); PG8_MMA(0, 1, At, B1); PG8_BAR;
            PG8_LDA(At, 1, 1); PG8_STAGE(PG8_SA(1, 0), a3, voffA);
            PG8_BAR; PG8_WAIT_L(0); PG8_MMA(1, 0, At, B0); PG8_BAR; PG8_SCHED;
            PG8_STAGE(PG8_SB(1, 1), b3 + hstep, voffB);
            PG8_WAIT_V(6); PG8_BAR; PG8_MMA(1, 1, At, B1); PG8_BAR;
        }
        E(acc, cur, wr, wc, fr, fq, ssv);
        if (!has_next) break;
        if (!E.keep(cur)) {
#pragma unroll
            for (int a = 0; a < 2; ++a)
#pragma unroll
                for (int b = 0; b < 2; ++b)
#pragma unroll
                    for (int m = 0; m < 4; ++m)
#pragma unroll
                        for (int n = 0; n < 2; ++n) acc[a][b][m][n] = (f32x4){0.f, 0.f, 0.f, 0.f};
        }
        cur = nxt; cA = nA; cB = nB; ++ui;
        E.pre(cur, wr, fr, ssv);
    }
    PG8_WAIT_V(0);
    if (wr == 0) PG8_BAR;
    PG8_BAR;
#undef PG8_SA
#undef PG8_SB
#undef PG8_STAGE
#undef PG8_LDA
#undef PG8_LDB
#undef PG8_MMA
#undef PG8_WAIT_V
#undef PG8_WAIT_L
#undef PG8_BAR
#undef PG8_SCHED
}
}
using pg8::Unit;
typedef f32x4 Acc[2][2][4][2];

struct EpiGU {
    static constexpr bool PERM = true;
    bf16_t* O; const float* ss;
    __device__ __forceinline__ void pre(const Unit& u, int wr, int fr, float (&ssv)[8]) const {
#pragma unroll
        for (int ai = 0; ai < 2; ++ai)
#pragma unroll
            for (int m = 0; m < 4; ++m) ssv[ai * 4 + m] = ss[u.pm * 256 + ai * 128 + wr * 64 + m * 16 + fr];
    }
    __device__ __forceinline__ bool keep(const Unit&) const { return false; }
    __device__ __forceinline__ void operator()(Acc& acc, const Unit& u, int wr, int wc, int fr, int fq, const float (&ssv)[8]) const {
        const int row0 = u.pm * 256 + wr * 64 + fr, col0 = u.pn * 128 + wc * 32 + 8 * fq;
#pragma unroll
        for (int ai = 0; ai < 2; ++ai)
#pragma unroll
            for (int m = 0; m < 4; ++m) {
                const int row = row0 + ai * 128 + m * 16;
                const float rs = rsqrtf(ssv[ai * 4 + m] * (1.f / D) + EPS);
                const float rs2 = rs * rs, nrl = -1.4426950408889634f * rs;
                float o[8];
#pragma unroll
                for (int n = 0; n < 2; ++n)
#pragma unroll
                    for (int j = 0; j < 4; j += 2) {
                        typedef float f32x2v __attribute__((ext_vector_type(2)));
                        const f32x2v g = {acc[ai][0][m][n][j], acc[ai][0][m][n][j + 1]}, uu = {acc[ai][1][m][n][j], acc[ai][1][m][n][j + 1]};
                        const f32x2v t = g * nrl, p = (g * uu) * rs2;
                        f32x2v d; d.x = __builtin_amdgcn_exp2f(t.x); d.y = __builtin_amdgcn_exp2f(t.y); d = d + 1.0f;
                        f32x2v r; r.x = __builtin_amdgcn_rcpf(d.x); r.y = __builtin_amdgcn_rcpf(d.y);
                        const f32x2v q = p * r; o[n * 4 + j] = q.x; o[n * 4 + j + 1] = q.y;
                    }
                *(u32x4*)(O + (size_t)row * FF + col0) = pack8f(o);
            }
    }
};
struct EpiRes {
    static constexpr bool PERM = false;
    const float* base; float* out; bf16_t* ob; float* ssn; float scale;
    __device__ __forceinline__ void pre(const Unit&, int, int, float (&ssv)[8]) const {
#pragma unroll
        for (int i = 0; i < 8; ++i) ssv[i] = 0.f; }
    __device__ __forceinline__ bool keep(const Unit&) const { return false; }
    __device__ __forceinline__ void operator()(Acc& acc, const Unit& u, int wr, int wc, int fr, int fq, const float (&ssv)[8]) const {
        const int row0 = u.pm * 256 + wr * 64 + fr, col0 = u.pn * 256 + wc * 32 + 4 * fq;
#pragma unroll
        for (int ai = 0; ai < 2; ++ai) {
            f32x4 b[4][2][2];
#pragma unroll
            for (int m = 0; m < 4; ++m)
#pragma unroll
                for (int bj = 0; bj < 2; ++bj)
#pragma unroll
                    for (int n = 0; n < 2; ++n) b[m][bj][n] = *(const f32x4*)(base + (size_t)(row0 + ai * 128 + m * 16) * D + col0 + bj * 128 + n * 16);
#pragma unroll
            for (int m = 0; m < 4; ++m) {
                const int row = row0 + ai * 128 + m * 16; float sq = 0.f;
#pragma unroll
                for (int bj = 0; bj < 2; ++bj)
#pragma unroll
                    for (int n = 0; n < 2; ++n) {
                        const size_t off = (size_t)row * D + col0 + bj * 128 + n * 16;
                        const f32x4 v = b[m][bj][n] + acc[ai][bj][m][n] * scale;
                        *(f32x4*)(out + off) = v;
                        sq += (v[0] * v[0] + v[1] * v[1]) + (v[2] * v[2] + v[3] * v[3]);
                        u32x2 w; w.x = pk2(v[0], v[1]); w.y = pk2(v[2], v[3]);
                        *(u32x2*)(ob + off) = w;
                    }
                sq += __shfl_xor(sq, 16); sq += __shfl_xor(sq, 32);
                if (fq == 0) unsafeAtomicAdd(ssn + row, sq);
            }
        }
    }
};
struct EpiProj {
    static constexpr bool PERM = true;
    bf16_t* O; const float* ss;
    __device__ __forceinline__ void pre(const Unit& u, int wr, int fr, float (&ssv)[8]) const {
#pragma unroll
        for (int ai = 0; ai < 2; ++ai)
#pragma unroll
            for (int m = 0; m < 4; ++m) ssv[ai * 4 + m] = ss[u.pm * 256 + ai * 128 + wr * 64 + m * 16 + fr];
    }
    __device__ __forceinline__ bool keep(const Unit&) const { return false; }
    __device__ __forceinline__ void operator()(Acc& acc, const Unit& u, int wr, int wc, int fr, int fq, const float (&ssv)[8]) const {
        const int row0 = u.pm * 256 + wr * 64 + fr, col0 = u.pn * 256 + wc * 32 + 8 * fq;
#pragma unroll
        for (int ai = 0; ai < 2; ++ai)
#pragma unroll
            for (int m = 0; m < 4; ++m) {
                const int row = row0 + ai * 128 + m * 16;
                const float rs = rsqrtf(ssv[ai * 4 + m] * (1.f / D) + EPS);
#pragma unroll
                for (int bj = 0; bj < 2; ++bj) {
                    float o[8];
#pragma unroll
                    for (int n = 0; n < 2; ++n)
#pragma unroll
                        for (int j = 0; j < 4; ++j) o[n * 4 + j] = acc[ai][bj][m][n][j] * rs;
                    *(u32x4*)(O + (size_t)row * NIN + col0 + bj * 128) = pack8f(o);
                }
            }
    }
};
struct EpiMix {
    static constexpr bool PERM = true;
    const bf16_t* proj; bf16_t* O;
    __device__ __forceinline__ void pre(const Unit&, int, int, float (&ssv)[8]) const {
#pragma unroll
        for (int i = 0; i < 8; ++i) ssv[i] = 0.f; }
    __device__ __forceinline__ bool keep(const Unit& u) const { return u.sel == 0; }
    __device__ __forceinline__ void operator()(Acc& acc, const Unit& u, int wr, int wc, int fr, int fq, const float (&ssv)[8]) const {
        const int row0 = u.pm * 256 + wr * 64 + fr, col0 = u.pn * 256 + wc * 32 + 8 * fq;
#pragma unroll
        for (int ai = 0; ai < 2; ++ai)
#pragma unroll
            for (int m = 0; m < 4; ++m) {
                const int row = row0 + ai * 128 + m * 16;
#pragma unroll
                for (int bj = 0; bj < 2; ++bj) {
                    const int col = col0 + bj * 128;
                    float ga[8], gb[8];
                    unpack8(*(const u32x4*)(proj + (size_t)row * NIN + C_GA + col), ga);
                    unpack8(*(const u32x4*)(proj + (size_t)row * NIN + C_GB + col), gb);
                    if (u.sel == 0) {
#pragma unroll
                        for (int n = 0; n < 2; ++n)
#pragma unroll
                            for (int j = 0; j < 4; ++j) acc[ai][bj][m][n][j] *= (1.f + __expf(-gb[n * 4 + j])) * __builtin_amdgcn_rcpf(1.f + __expf(-ga[n * 4 + j]));
                    } else {
                        float o[8];
#pragma unroll
                        for (int n = 0; n < 2; ++n)
#pragma unroll
                            for (int j = 0; j < 4; ++j) o[n * 4 + j] = acc[ai][bj][m][n][j] * sigmoidf_(gb[n * 4 + j]);
                        *(u32x4*)(O + (size_t)row * D + col) = pack8f(o);
                    }
                }
            }
    }
};
struct EpiF32 {
    static constexpr bool PERM = false;
    float* C;
    __device__ __forceinline__ void pre(const Unit&, int, int, float (&ssv)[8]) const {
#pragma unroll
        for (int i = 0; i < 8; ++i) ssv[i] = 0.f; }
    __device__ __forceinline__ bool keep(const Unit&) const { return false; }
    __device__ __forceinline__ void operator()(Acc& acc, const Unit& u, int wr, int wc, int fr, int fq, const float (&ssv)[8]) const {
        const int row0 = u.pm * 256 + wr * 64 + fr, col0 = u.pn * 256 + wc * 32 + 4 * fq;
#pragma unroll
        for (int ai = 0; ai < 2; ++ai)
#pragma unroll
            for (int m = 0; m < 4; ++m)
#pragma unroll
                for (int bj = 0; bj < 2; ++bj)
#pragma unroll
                    for (int n = 0; n < 2; ++n) *(f32x4*)(C + (size_t)(row0 + ai * 128 + m * 16) * D + col0 + bj * 128 + n * 16) = acc[ai][bj][m][n];
    }
};
struct EpiPle {
    static constexpr bool PERM = false;
    float* out; const float* R; const float* ss;
    __device__ __forceinline__ void pre(const Unit& u, int wr, int fr, float (&ssv)[8]) const {
#pragma unroll
        for (int ai = 0; ai < 2; ++ai)
#pragma unroll
            for (int m = 0; m < 4; ++m) ssv[ai * 4 + m] = ss[u.pm * 256 + ai * 128 + wr * 64 + m * 16 + fr];
    }
    __device__ __forceinline__ bool keep(const Unit&) const { return false; }
    __device__ __forceinline__ void operator()(Acc& acc, const Unit& u, int wr, int wc, int fr, int fq, const float (&ssv)[8]) const {
        const int row0 = u.pm * 256 + wr * 64 + fr, col0 = u.pn * 256 + wc * 32 + 4 * fq;
#pragma unroll
        for (int ai = 0; ai < 2; ++ai)
#pragma unroll
            for (int mp = 0; mp < 2; ++mp) {
                f32x4 bb[2][2][2], rr[2][2][2];
#pragma unroll
                for (int mm = 0; mm < 2; ++mm)
#pragma unroll
                    for (int bj = 0; bj < 2; ++bj)
#pragma unroll
                        for (int n = 0; n < 2; ++n) { const size_t off = (size_t)(row0 + ai * 128 + (2 * mp + mm) * 16) * D + col0 + bj * 128 + n * 16;
                            bb[mm][bj][n] = *(const f32x4*)(out + off); rr[mm][bj][n] = *(const f32x4*)(R + off); }
#pragma unroll
                for (int mm = 0; mm < 2; ++mm) {
                    const int m = 2 * mp + mm, row = row0 + ai * 128 + m * 16;
                    const float rs = rsqrtf(ssv[ai * 4 + m] * (1.f / D) + EPS);
#pragma unroll
                    for (int bj = 0; bj < 2; ++bj)
#pragma unroll
                        for (int n = 0; n < 2; ++n) {
                            const size_t off = (size_t)row * D + col0 + bj * 128 + n * 16;
                            f32x4 v;
#pragma unroll
                            for (int j = 0; j < 4; ++j) v[j] = bb[mm][bj][n][j] + sigmoidf_(acc[ai][bj][m][n][j] * rs) * rr[mm][bj][n][j];
                            *(f32x4*)(out + off) = v;
                        }
                }
            }
    }
};

struct Params {
    const float *x, *p, *ffn1_norm, *ffn1_w_gu, *ffn1_w_down, *mix_norm, *w_in, *conv_w, *a_log, *dt_bias, *gdn_norm, *q_norm, *k_norm, *rel_bias,
                *w_a, *w_b, *w_out, *ffn2_norm, *ffn2_w_gu, *ffn2_w_down, *ple_norm, *ple_gate, *ple_proj;
    float* out; unsigned char* ws; int ph_lo, ph_hi;
};

template <int MAP> __device__ __forceinline__ int src_col(int n) {
    if (MAP == 1) return ((n >> 7) & 1) * FF + (n >> 8) * 128 + (n & 127);
    if (MAP == 2) return n < 4096 ? n : (n < 11264 ? n + 16 : (n < 11280 ? n - 11264 + 4096 : -1));
    return n;
}
template <int MAP> __device__ __forceinline__ void transpose_item(const float* W, const float* nw, int K, int Nsrc, int Nd, bf16_t* WT, LAS float* scr, int item, int lane) {
    const int nblk = Nd / 64, kb = item / nblk, nb = item % nblk, k0 = 64 * kb, n0 = 64 * nb;
    const int r = lane >> 4, c4 = lane & 15;
    const int sc = src_col<MAP>(n0 + 4 * c4);
    f32x4 v[16];
#pragma unroll
    for (int i = 0; i < 16; ++i) v[i] = sc >= 0 ? __builtin_nontemporal_load((const f32x4*)(W + (size_t)(k0 + 4 * i + r) * Nsrc + sc)) : (f32x4){0.f, 0.f, 0.f, 0.f};
    if (nw) {
#pragma unroll
        for (int i = 0; i < 16; ++i) v[i] = v[i] * nw[k0 + 4 * i + r];
    }
#pragma unroll
    for (int i = 0; i < 16; ++i) { LAS float* p = scr + (4 * i + r) * 65 + 4 * c4; p[0] = v[i][0]; p[1] = v[i][1]; p[2] = v[i][2]; p[3] = v[i][3]; }
    asm volatile("s_waitcnt lgkmcnt(0)" ::: "memory"); __builtin_amdgcn_wave_barrier();
    const int ns = lane >> 3, kc = lane & 7;
#pragma unroll
    for (int j = 0; j < 8; ++j) { const LAS float* sp = scr + (8 * kc) * 65 + 8 * j + ns;
        u32x4 o; o.x = pk2(sp[0 * 65], sp[1 * 65]); o.y = pk2(sp[2 * 65], sp[3 * 65]); o.z = pk2(sp[4 * 65], sp[5 * 65]); o.w = pk2(sp[6 * 65], sp[7 * 65]);
        *(u32x4*)(WT + (size_t)(n0 + 8 * j + ns) * K + k0 + 8 * kc) = o; }
    asm volatile("s_waitcnt lgkmcnt(0)" ::: "memory"); __builtin_amdgcn_wave_barrier();
}
constexpr int I_GU = (D / 64) * (NGU / 64), I_DN = (FF / 64) * (D / 64), I_IN = (D / 64) * (NIN / 64), I_AB = (1024 / 64) * (D / 64), I_SQ = (D / 64) * (D / 64), I_PP = (PLE / 64) * (D / 64);
constexpr int N_EARLY = I_GU + I_DN + I_IN, N_LATE = I_GU + I_DN + 2 * I_AB + 2 * I_SQ + I_PP;
__device__ __forceinline__ void convert_early(const Params& P, LAS float* scr, int gw, int NGW, int lane, bool with_d1) {
    unsigned char* ws = P.ws;
    for (int it = gw; it < I_GU + I_IN + (with_d1 ? I_DN : 0); it += NGW) {
        int r = it;
        if (r < I_GU) { transpose_item<1>(P.ffn1_w_gu, P.ffn1_norm, D, NGU, NGU, (bf16_t*)(ws + WS_WGU1), scr, r, lane); continue; } r -= I_GU;
        if (r < I_IN) { transpose_item<2>(P.w_in, P.mix_norm, D, NINSRC, NIN, (bf16_t*)(ws + WS_WIN), scr, r, lane); continue; } r -= I_IN;
        transpose_item<0>(P.ffn1_w_down, nullptr, FF, D, D, (bf16_t*)(ws + WS_WD1), scr, r, lane);
    }
}
__device__ __forceinline__ void convert_d1(const Params& P, LAS float* scr, int gw, int NGW, int lane) {
    for (int it = gw; it < I_DN; it += NGW) transpose_item<0>(P.ffn1_w_down, nullptr, FF, D, D, (bf16_t*)(P.ws + WS_WD1), scr, it, lane);
}
__device__ __forceinline__ void convert_late(const Params& P, LAS float* scr, int lo_it, int hi_it, int gw, int NGW, int lane) {
    unsigned char* ws = P.ws;
    for (int it = lo_it + gw; it < hi_it; it += NGW) {
        int r = it;
        if (r < I_AB) { transpose_item<0>(P.w_a, nullptr, 1024, D, D, (bf16_t*)(ws + WS_WA), scr, r, lane); continue; } r -= I_AB;
        if (r < I_AB) { transpose_item<0>(P.w_b, nullptr, 1024, D, D, (bf16_t*)(ws + WS_WB), scr, r, lane); continue; } r -= I_AB;
        if (r < I_SQ) { transpose_item<0>(P.w_out, nullptr, D, D, D, (bf16_t*)(ws + WS_WOUT), scr, r, lane); continue; } r -= I_SQ;
        if (r < I_GU) { transpose_item<1>(P.ffn2_w_gu, P.ffn2_norm, D, NGU, NGU, (bf16_t*)(ws + WS_WGU2), scr, r, lane); continue; } r -= I_GU;
        if (r < I_DN) { transpose_item<0>(P.ffn2_w_down, nullptr, FF, D, D, (bf16_t*)(ws + WS_WD2), scr, r, lane); continue; } r -= I_DN;
        if (r < I_SQ) { transpose_item<0>(P.ple_gate, P.ple_norm, D, D, D, (bf16_t*)(ws + WS_WPG), scr, r, lane); continue; } r -= I_SQ;
        transpose_item<0>(P.ple_proj, nullptr, PLE, D, D, (bf16_t*)(ws + WS_WPP), scr, r, lane);
    }
}
constexpr int LATE_A = 2800, LATE_C = 2 * I_AB + I_SQ + I_GU;
__device__ __forceinline__ void idle_convert(const Params& P, LAS unsigned char* lds, int nwg, int G, int lo_it, int hi_it) {
    const int extra = nwg % G, c = blockIdx.x;
    if (extra == 0 || c < extra) return;
    const int tid = opaque_tid(), wave = tid >> 6;
    if (lo_it < 0) convert_d1(P, (LAS float*)(lds + wave * 17408), (c - extra) * 8 + wave, (G - extra) * 8, tid & 63);
    else convert_late(P, (LAS float*)(lds + wave * 17408), lo_it, hi_it, (c - extra) * 8 + wave, (G - extra) * 8, tid & 63);
}
__device__ __forceinline__ void phase_convert(const Params& P, LAS unsigned char* lds, int G) {
    const int tid = opaque_tid(), lane = tid & 63, wave = tid >> 6;
    LAS float* scr = (LAS float*)(lds + wave * 17408);
    const int gw = blockIdx.x * 8 + wave, NGW = G * 8;
    unsigned char* ws = P.ws;
    convert_early(P, scr, gw, NGW, lane, (((M / 256) * (NGU / 256)) % G) == 0);
    float* ss = (float*)(ws + WS_SS);
    bf16_t* xb = (bf16_t*)(ws + WS_XB); bf16_t* pb = (bf16_t*)(ws + WS_PB);
    for (int m = gw; m < M; m += NGW) {
        const f32x4* xr = (const f32x4*)(P.x + (size_t)m * D) + lane; u32x2* o8 = (u32x2*)(xb + (size_t)m * D) + lane; float s = 0.f;
#pragma unroll
        for (int j = 0; j < 8; ++j) { const f32x4 v = __builtin_nontemporal_load(xr + 64 * j); s += (v[0] * v[0] + v[1] * v[1]) + (v[2] * v[2] + v[3] * v[3]); u32x2 w; w.x = pk2(v[0], v[1]); w.y = pk2(v[2], v[3]); o8[64 * j] = w; }
        s = wave_sum(s); if (lane == 0) ss[m] = s;
        const f32x4 pv = *((const f32x4*)(P.p + (size_t)m * PLE) + lane); u32x2 w; w.x = pk2(pv[0], pv[1]); w.y = pk2(pv[2], pv[3]); *((u32x2*)(pb + (size_t)m * PLE) + lane) = w;
    }
    for (int i = blockIdx.x * 512 + tid; i < 3 * M; i += G * 512) ss[M + i] = 0.f;
    if (blockIdx.x == 0 && tid < 8) ((unsigned*)(ws + WS_PROG))[tid * 32] = 0u;
}

constexpr int L_LM = 0, L_GC = L_LM + 64 * 68 * 4, L_R = L_GC + 512, L_KBF = L_R + 65536, L_QBF = L_KBF + 64 * 136 * 2, L_VST = L_QBF + 64 * 136 * 2, L_END4 = L_VST + 64 * 136 * 2;
static_assert(L_END4 <= LDS_BYTES, "lds");
__device__ __forceinline__ void prep_item(const Params& P, LAS unsigned char* lds, int item, const int pflags) {
    const int tid = opaque_tid(), lane = tid & 63, wave = tid >> 6;
    const int n = item >> 3, h = item & 7;
    unsigned char* ws = P.ws;
    bf16_t* proj = (bf16_t*)(ws + WS_PROJ);
    LAS float* Rr = (LAS float*)(lds + L_R); LAS float* Lm = (LAS float*)(lds + L_LM);
    LAS bf16_t* kbf = (LAS bf16_t*)(lds + L_KBF); LAS bf16_t* qbf = (LAS bf16_t*)(lds + L_QBF); LAS bf16_t* vst = (LAS bf16_t*)(lds + L_VST);
    LAS float* gcs = (LAS float*)(lds + L_GC);
    if (wave == 0) {
        const size_t row = (size_t)n * 64 + lane;
        const float a = bf2f(proj[row * NIN + C_AR + h]), b = bf2f(proj[row * NIN + C_BR + h]);
        const float xx = a + P.dt_bias[h];
        const float sp = xx > 20.f ? xx : log1pf(expf(xx));
        float g = -expf(P.a_log[h]) * sp;
#pragma unroll
        for (int o = 1; o < 64; o <<= 1) { const float t = __shfl_up(g, o); if (lane >= o) g += t; }
        gcs[lane] = g; gcs[64 + lane] = 1.f / (1.f + expf(-b));
    }
    const int l16 = tid & 15, rg = tid >> 4;
    float qv[2][8], kv[2][8], vv[2][8];
#pragma unroll
    for (int X = 0; X < 3; ++X) {
        const int col = (X == 0 ? C_QA : (X == 1 ? C_KA : C_VA)) + h * DH + 8 * l16;
        const int ccol = X * 1024 + h * DH + 8 * l16;
        float xin[5][8];
#pragma unroll
        for (int i = 0; i < 5; ++i) { const int gr = n * 64 + 2 * rg - 3 + i;
            if (gr >= 0) unpack8(__builtin_nontemporal_load((const u32x4*)(proj + (size_t)gr * NIN + col)), xin[i]);
            else {
#pragma unroll
                for (int e = 0; e < 8; ++e) xin[i][e] = 0.f; } }
        float y[2][8];
#pragma unroll
        for (int r = 0; r < 2; ++r)
#pragma unroll
            for (int e = 0; e < 8; ++e) y[r][e] = 0.f;
#pragma unroll
        for (int j = 0; j < 4; ++j) {
            const f32x4 c0 = *(const f32x4*)(P.conv_w + j * 3072 + ccol), c1 = *(const f32x4*)(P.conv_w + j * 3072 + ccol + 4);
#pragma unroll
            for (int r = 0; r < 2; ++r)
#pragma unroll
                for (int e = 0; e < 8; ++e) y[r][e] += (e < 4 ? c0[e] : c1[e - 4]) * xin[r + j][e];
        }
#pragma unroll
        for (int r = 0; r < 2; ++r) {
            float sq = 0.f;
#pragma unroll
            for (int e = 0; e < 8; ++e) { y[r][e] = siluf_(y[r][e]); sq += y[r][e] * y[r][e]; }
            if (X < 2) {
                sq += __shfl_xor(sq, 1); sq += __shfl_xor(sq, 2); sq += __shfl_xor(sq, 4); sq += __shfl_xor(sq, 8);
                const float rn = rsqrtf(sq + EPS) * (X == 0 ? 0.08838834764831845f : 1.f);
#pragma unroll
                for (int e = 0; e < 8; ++e) y[r][e] *= rn;
            }
#pragma unroll
            for (int e = 0; e < 8; ++e) { if (X == 0) qv[r][e] = y[r][e]; else if (X == 1) kv[r][e] = y[r][e]; else vv[r][e] = y[r][e]; }
        }
    }
#pragma unroll
    for (int r = 0; r < 2; ++r) {
        const size_t grow = (size_t)n * 64 + 2 * rg + r;
#pragma unroll
        for (int X = 0; X < 2; ++X) {
            bf16_t* ptr = proj + grow * NIN + (X == 0 ? C_QB : C_KB) + h * DH + 8 * l16;
            float f[8]; unpack8(__builtin_nontemporal_load((const u32x4*)ptr), f);
            float sq = 0.f;
#pragma unroll
            for (int e = 0; e < 8; ++e) sq += f[e] * f[e];
            sq += __shfl_xor(sq, 1); sq += __shfl_xor(sq, 2); sq += __shfl_xor(sq, 4); sq += __shfl_xor(sq, 8);
            const float rn = rsqrtf(sq * (1.f / DH) + EPS);
            const float* nwp = (X == 0 ? P.q_norm : P.k_norm) + 8 * l16;
            const f32x4 w0 = *(const f32x4*)nwp, w1 = *(const f32x4*)(nwp + 4);
#pragma unroll
            for (int e = 0; e < 8; ++e) f[e] = f[e] * rn * (e < 4 ? w0[e] : w1[e - 4]);
            *(u32x4*)ptr = pack8f(f);
        }
        const u32x4 vraw = __builtin_nontemporal_load((const u32x4*)(proj + grow * NIN + C_VB + h * DH + 8 * l16));
        *(LAS u32x4*)(vst + (2 * rg + r) * 136 + 8 * l16) = vraw;
    }
    __syncthreads();
    {
        bf16_t* qd = (bf16_t*)(ws + WS_QD) + (size_t)item * 64 * 128;
        bf16_t* ktT = (bf16_t*)(ws + WS_KTT) + (size_t)item * 128 * 64;
        const float gl = gcs[63];
        float ktl[2][8];
#pragma unroll
        for (int r = 0; r < 2; ++r) {
            const int t = 2 * rg + r; const float gc = gcs[t], bt = gcs[64 + t];
            const float eg = __expf(gc), egl = __expf(gl - gc);
            float f[8];
#pragma unroll
            for (int e = 0; e < 8; ++e) f[e] = qv[r][e] * eg;
            *(u32x4*)(qd + ((((t >> 4) * 4 + (l16 >> 2)) * 64) + (l16 & 3) * 16 + (t & 15)) * 8) = pack8f(f);
#pragma unroll
            for (int e = 0; e < 8; ++e) ktl[r][e] = kv[r][e] * egl;
            *(LAS u32x4*)(qbf + t * 136 + 8 * l16) = pack8f(qv[r]);
            *(LAS u32x4*)(kbf + t * 136 + 8 * l16) = pack8f(kv[r]);
            LAS float* rr = Rr + t * 256 + 8 * l16;
            *(LAS f32x4*)(rr) = (f32x4){vv[r][0] * bt, vv[r][1] * bt, vv[r][2] * bt, vv[r][3] * bt};
            *(LAS f32x4*)(rr + 4) = (f32x4){vv[r][4] * bt, vv[r][5] * bt, vv[r][6] * bt, vv[r][7] * bt};
            const float be = bt * eg;
            *(LAS f32x4*)(rr + 128) = (f32x4){kv[r][0] * be, kv[r][1] * be, kv[r][2] * be, kv[r][3] * be};
            *(LAS f32x4*)(rr + 132) = (f32x4){kv[r][4] * be, kv[r][5] * be, kv[r][6] * be, kv[r][7] * be};
        }
#pragma unroll
        for (int e = 0; e < 8; ++e) { const int t0 = 2 * rg; *(unsigned*)(ktT + (((((l16 >> 1) * 2 + (t0 >> 5)) * 64) + ((t0 >> 3) & 3) * 16 + 8 * (l16 & 1) + e) * 8 + (t0 & 7))) = pk2(ktl[0][e], ktl[1][e]); }
        if (tid == 0) ((float*)(ws + WS_TAIL))[item] = __expf(gl);
        bf16_t* vt = (bf16_t*)(ws + WS_VT);
        const int d = tid & 127, tg = tid >> 7;
        unsigned pw[8];
#pragma unroll
        for (int i = 0; i < 8; ++i) { const unsigned lo = vst[(16 * tg + 2 * i) * 136 + d], hi = vst[(16 * tg + 2 * i + 1) * 136 + d]; pw[i] = lo | (hi << 16); }
        bf16_t* dst = vt + (size_t)(h * DH + d) * M + n * 64 + 16 * tg;
        *(u32x4*)dst = (u32x4){pw[0], pw[1], pw[2], pw[3]}; *(u32x4*)(dst + 8) = (u32x4){pw[4], pw[5], pw[6], pw[7]};
    }
    __syncthreads();
    {
        const int fr = lane & 15, fq = lane >> 4, which = wave >> 2, ti = wave & 3;
        LAS bf16_t* X = which ? qbf : kbf;
        bf16x8 a[4];
#pragma unroll
        for (int s = 0; s < 4; ++s) a[s] = *(const LAS bf16x8*)(X + (16 * ti + fr) * 136 + 32 * s + 8 * fq);
        bf16_t* aqk = (bf16_t*)(ws + WS_AQK) + (size_t)item * 64 * 64;
        for (int tj = 0; tj < 4; ++tj) {
            f32x4 c = {0.f, 0.f, 0.f, 0.f};
            if (tj <= ti) {
#pragma unroll
                for (int s = 0; s < 4; ++s) { const bf16x8 b = *(const LAS bf16x8*)(kbf + (16 * tj + fr) * 136 + 32 * s + 8 * fq); c = MFMA16(a[s], b, c); }
            }
            const int j = 16 * tj + fr; const float gj = gcs[j];
#pragma unroll
            for (int r = 0; r < 4; ++r) {
                const int i = 16 * ti + 4 * fq + r;
                const float dec = (i >= j) ? __expf(gcs[i] - gj) : 0.f;
                if (which == 0) { Lm[i * 68 + j] = (i > j) ? gcs[64 + i] * c[r] * dec : 0.f; }
                else { const float v = (i >= j) ? c[r] * dec : 0.f; aqk[((((i >> 4) * 2 + (j >> 5)) * 64) + ((j >> 3) & 3) * 16 + (i & 15)) * 8 + (j & 7)] = (bf16_t)(pk2(v, 0.f) & 0xffffu); }
            }
        }
    }
    __syncthreads();
    if (tid < 256) {
        int Lrow[64];
#pragma unroll
        for (int i = 0; i < 64; ++i) Lrow[i] = __float_as_int(Lm[i * 68 + lane]);
        float s[64];
#define LRD(i, j) __int_as_float(__builtin_amdgcn_readlane(Lrow[i], j))
#pragma unroll
        for (int g = 0; g < 16; ++g) {
            const int i0 = 4 * g;
            float a0 = Rr[(i0 + 0) * 256 + tid], a1 = Rr[(i0 + 1) * 256 + tid], a2 = Rr[(i0 + 2) * 256 + tid], a3 = Rr[(i0 + 3) * 256 + tid];
            if (!(pflags & 8)) {
#pragma unroll
            for (int j = 0; j < i0; ++j) { const float sj = s[j]; a0 -= LRD(i0, j) * sj; a1 -= LRD(i0 + 1, j) * sj; a2 -= LRD(i0 + 2, j) * sj; a3 -= LRD(i0 + 3, j) * sj; }
            a1 -= LRD(i0 + 1, i0) * a0;
            a2 -= LRD(i0 + 2, i0) * a0; a2 -= LRD(i0 + 2, i0 + 1) * a1;
            a3 -= LRD(i0 + 3, i0) * a0; a3 -= LRD(i0 + 3, i0 + 1) * a1; a3 -= LRD(i0 + 3, i0 + 2) * a2;
            }
            s[i0] = a0; s[i0 + 1] = a1; s[i0 + 2] = a2; s[i0 + 3] = a3;
        }
#undef LRD
        if (pflags & 32) { if (s[63] == 1.2345f) ((float*)(ws + WS_U))[tid] = s[5]; } else
        if (tid < 128) { float* u = (float*)(ws + WS_U) + (size_t)item * 64 * 128 + ((tid >> 4) * 256 + (tid & 15)) * 4;
#pragma unroll
            for (int i4 = 0; i4 < 16; ++i4) *(f32x4*)(u + ((i4 >> 2) * 64 + (i4 & 3) * 16) * 4) = (f32x4){s[4 * i4], s[4 * i4 + 1], s[4 * i4 + 2], s[4 * i4 + 3]}; }
        else { const int dk = tid - 128; bf16_t* w = (bf16_t*)(ws + WS_W) + (size_t)item * 64 * 128 + (((dk >> 5) * 64) + ((dk >> 3) & 3) * 16) * 8 + (dk & 7);
#pragma unroll
            for (int i = 0; i < 64; ++i) w[((i >> 4) * 256 + (i & 15)) * 8] = (bf16_t)(pk2(s[i], 0.f) & 0xffffu); }
    }
    __syncthreads();
}

struct ScanA { bf16x8 W[4], K0[2], K1[2]; f32x4 u; float tl; };
struct ScanB { bf16x8 Q[4], A[2]; };
struct ScanOff { unsigned w, aq, kt, u; };
__device__ __forceinline__ void scan_loadA(ScanA& o, const unsigned char* ws, int c, int h, const ScanOff& f) {
    const int item = c * 8 + h;
    const unsigned char* w = ws + WS_W + (size_t)item * 16384; const unsigned char* kt = ws + WS_KTT + (size_t)item * 16384; const unsigned char* u = ws + WS_U + (size_t)item * 32768;
#pragma unroll
    for (int s = 0; s < 4; ++s) o.W[s] = __builtin_bit_cast(bf16x8, *(const u32x4*)(w + f.w + 1024 * s));
#pragma unroll
    for (int s = 0; s < 2; ++s) { o.K0[s] = __builtin_bit_cast(bf16x8, *(const u32x4*)(kt + f.kt + 1024 * s)); o.K1[s] = __builtin_bit_cast(bf16x8, *(const u32x4*)(kt + f.kt + 2048 + 1024 * s)); }
    o.u = *(const f32x4*)(u + f.u);
    o.tl = ((const float*)(ws + WS_TAIL))[item];
}
__device__ __forceinline__ void scan_loadB(ScanB& o, const unsigned char* ws, int c, int h, const ScanOff& f) {
    const int item = c * 8 + h;
    const unsigned char* qd = ws + WS_QD + (size_t)item * 16384; const unsigned char* aq = ws + WS_AQK + (size_t)item * 8192;
#pragma unroll
    for (int s = 0; s < 4; ++s) o.Q[s] = __builtin_bit_cast(bf16x8, *(const u32x4*)(qd + f.w + 1024 * s));
#pragma unroll
    for (int s = 0; s < 2; ++s) o.A[s] = __builtin_bit_cast(bf16x8, *(const u32x4*)(aq + f.aq + 1024 * s));
}
__device__ __forceinline__ void scan_stepA(const ScanA& cur, f32x4& S0, f32x4& S1, LAS bf16_t* Sl, LAS bf16_t* Vl, int fr, int fq, int mt) {
    f32x4 wsv = {0.f, 0.f, 0.f, 0.f};
#pragma unroll
    for (int s = 0; s < 4; ++s) wsv = MFMA16(cur.W[s], *(const LAS bf16x8*)(Sl + fr * 136 + 32 * s + 8 * fq), wsv);
    const f32x4 vn = cur.u - wsv;
    { u32x2 pv; pv.x = pk2(vn[0], vn[1]); pv.y = pk2(vn[2], vn[3]); *(LAS u32x2*)(Vl + fr * 72 + 16 * mt + 4 * fq) = pv; }
    __syncthreads();
    S0 = S0 * cur.tl; S1 = S1 * cur.tl;
#pragma unroll
    for (int s = 0; s < 2; ++s) { const bf16x8 Vb = *(const LAS bf16x8*)(Vl + fr * 72 + 32 * s + 8 * fq); S0 = MFMA16(cur.K0[s], Vb, S0); S1 = MFMA16(cur.K1[s], Vb, S1); }
    { u32x2 p0, p1; p0.x = pk2(S0[0], S0[1]); p0.y = pk2(S0[2], S0[3]); p1.x = pk2(S1[0], S1[1]); p1.y = pk2(S1[2], S1[3]);
      *(LAS u32x2*)(Sl + fr * 136 + 32 * mt + 4 * fq) = p0; *(LAS u32x2*)(Sl + fr * 136 + 32 * mt + 16 + 4 * fq) = p1; }
    __syncthreads();
}
__device__ __forceinline__ void scan_stepB(const ScanB& cur, const LAS bf16_t* Sl, const LAS bf16_t* Vl, bf16_t* og, int fr, int fq) {
    f32x4 qs = {0.f, 0.f, 0.f, 0.f};
#pragma unroll
    for (int s = 0; s < 4; ++s) qs = MFMA16(*(const LAS bf16x8*)(Sl + fr * 136 + 32 * s + 8 * fq), cur.Q[s], qs);
    __syncthreads();
#pragma unroll
    for (int s = 0; s < 2; ++s) qs = MFMA16(*(const LAS bf16x8*)(Vl + fr * 72 + 32 * s + 8 * fq), cur.A[s], qs);
    { u32x2 w; w.x = pk2(qs[0], qs[1]); w.y = pk2(qs[2], qs[3]); *(u32x2*)og = w; }
    __syncthreads();
}
__device__ __forceinline__ void scan_wg(const Params& P, LAS unsigned char* lds, int h, int pair, const int VAR) {
    const int tid = opaque_tid(), lane = tid & 63, wave = tid >> 6, fr = lane & 15, fq = lane >> 4, mt = wave & 3, e0 = 16 * pair;
    const unsigned char* ws = P.ws;
    LAS bf16_t* Sl = (LAS bf16_t*)(lds);
    LAS bf16_t* Vl = (LAS bf16_t*)(lds + 4352);
    for (int i = tid; i < 4352 / 4; i += 512) ((LAS unsigned*)Sl)[i] = 0u;
    ScanOff f; f.w = (unsigned)(mt * 4096 + lane * 16); f.aq = (unsigned)(mt * 2048 + lane * 16); f.kt = (unsigned)(mt * 4096 + lane * 16); f.u = (unsigned)((((e0 >> 4) * 4 + mt) * 64 + lane) * 16);
    if (wave < 4) {
        f32x4 S0 = {0.f, 0.f, 0.f, 0.f}, S1 = {0.f, 0.f, 0.f, 0.f};
        ScanA a, b, c3; scan_loadA(a, ws, 0, h, f); scan_loadA(b, ws, 1, h, f);
        __syncthreads();
#pragma unroll 1
        for (int c = 0; c < NCH - 2; c += 3) {
            if (VAR != 3) scan_loadA(c3, ws, c + 2, h, f); scan_stepA(a, S0, S1, Sl, Vl, fr, fq, mt);
            if (VAR != 3) scan_loadA(a, ws, c + 3, h, f); scan_stepA(b, S0, S1, Sl, Vl, fr, fq, mt);
            if (VAR != 3) scan_loadA(b, ws, c + 4, h, f); scan_stepA(VAR == 3 ? a : c3, S0, S1, Sl, Vl, fr, fq, mt);
        }
        scan_stepA(a, S0, S1, Sl, Vl, fr, fq, mt); scan_stepA(b, S0, S1, Sl, Vl, fr, fq, mt);
    } else {
        bf16_t* Og = (bf16_t*)(P.ws + (VAR ? WS_END : WS_YA)) + (size_t)(16 * mt + fr) * 1024 + h * DH + e0 + 4 * fq;
        ScanB a, b, c3; scan_loadB(a, ws, 0, h, f); scan_loadB(b, ws, 1, h, f);
        __syncthreads();
#pragma unroll 1
        for (int c = 0; c < NCH - 2; c += 3) {
            if (VAR != 3) scan_loadB(c3, ws, c + 2, h, f); scan_stepB(a, Sl, Vl, Og + (size_t)c * 65536, fr, fq);
            if (VAR != 3) scan_loadB(a, ws, c + 3, h, f); scan_stepB(b, Sl, Vl, Og + (size_t)(c + 1) * 65536, fr, fq);
            if (VAR != 3) scan_loadB(b, ws, c + 4, h, f); scan_stepB(VAR == 3 ? a : c3, Sl, Vl, Og + (size_t)(c + 2) * 65536, fr, fq);
        }
        scan_stepB(a, Sl, Vl, Og + (size_t)(NCH - 2) * 65536, fr, fq); scan_stepB(b, Sl, Vl, Og + (size_t)(NCH - 1) * 65536, fr, fq);
    }
}

__device__ __forceinline__ void scan_helper(const Params& P, int h, int j, int NHp) {
    const int tid = threadIdx.x;
    const unsigned char* ws = P.ws;
    unsigned* prog = (unsigned*)(P.ws + WS_PROG) + h * 32;
    for (int c = j; c < NCH; c += NHp) {
        for (;;) { const unsigned pr = __hip_atomic_load(prog, __ATOMIC_RELAXED, __HIP_MEMORY_SCOPE_AGENT); if ((int)pr + 16 >= c) break; __builtin_amdgcn_s_sleep(16); }
        const int item = c * 8 + h;
        const u32x4* w16 = (const u32x4*)(ws + WS_W + (size_t)item * 16384); const u32x4* q16 = (const u32x4*)(ws + WS_QD + (size_t)item * 16384);
        const u32x4* k16 = (const u32x4*)(ws + WS_KTT + (size_t)item * 16384); const u32x4* a16 = (const u32x4*)(ws + WS_AQK + (size_t)item * 8192);
        const u32x4* u16 = (const u32x4*)(ws + WS_U + (size_t)item * 32768);
        u32x4 v[11];
        v[0] = w16[tid]; v[1] = w16[512 + tid]; v[2] = q16[tid]; v[3] = q16[512 + tid]; v[4] = k16[tid]; v[5] = k16[512 + tid]; v[6] = a16[tid];
        v[7] = u16[tid]; v[8] = u16[512 + tid]; v[9] = u16[1024 + tid]; v[10] = u16[1536 + tid];
#pragma unroll
        for (int i = 0; i < 11; ++i) asm volatile("" :: "v"(v[i]));
    }
}

constexpr int AL_K = 0, AL_V = 2 * 64 * 272, AL_B = AL_V + 2 * 128 * 144;
__device__ __forceinline__ void attn_compute(const LAS unsigned char* Kl, const LAS unsigned char* Vl, const LAS float* biasl, const bf16x8 (&Qb)[4], f32x4 (&Ot)[8], float& mrun, float& lrun,
                                             int c, int qi, int fr, int fq) {
    const float scale = 0.08838834764831845f;
    f32x4 st[4]; float mx = -1e30f;
#pragma unroll
    for (int kt = 0; kt < 4; ++kt) {
        f32x4 a = {0.f, 0.f, 0.f, 0.f};
#pragma unroll
        for (int s = 0; s < 4; ++s) a = MFMA16(*(const LAS bf16x8*)(Kl + (16 * kt + fr) * 272 + 64 * s + 16 * fq), Qb[s], a);
#pragma unroll
        for (int r = 0; r < 4; ++r) {
            const int ki = c * 64 + 16 * kt + 4 * fq + r; int dd = qi - ki; dd = dd < -63 ? -63 : (dd > 128 ? 128 : dd);
            a[r] = a[r] * scale + biasl[dd + 63]; mx = fmaxf(mx, a[r]);
        }
        st[kt] = a;
    }
    mx = fmaxf(mx, __shfl_xor(mx, 16)); mx = fmaxf(mx, __shfl_xor(mx, 32));
    const float mnew = fmaxf(mrun, mx), alpha = __expf(mrun - mnew); mrun = mnew;
    float rsum = 0.f;
#pragma unroll
    for (int kt = 0; kt < 4; ++kt)
#pragma unroll
        for (int r = 0; r < 4; ++r) { const float p = __expf(st[kt][r] - mnew); st[kt][r] = p; rsum += p; }
    lrun = lrun * alpha + rsum;
    bf16x8 Pb[2];
#pragma unroll
    for (int s = 0; s < 2; ++s) Pb[s] = pack_acc(st[2 * s], st[2 * s + 1]);
#pragma unroll
    for (int dt = 0; dt < 8; ++dt) {
        f32x4 o = Ot[dt] * alpha;
#pragma unroll
        for (int s = 0; s < 2; ++s) { const LAS unsigned char* pv = Vl + (16 * dt + fr) * 144 + 64 * s + 8 * fq;
            const u32x2 lo = *(const LAS u32x2*)pv, hi = *(const LAS u32x2*)(pv + 32); u32x4 av; av.x = lo.x; av.y = lo.y; av.z = hi.x; av.w = hi.y;
            o = MFMA16(__builtin_bit_cast(bf16x8, av), Pb[s], o); }
        Ot[dt] = o;
    }
}
__device__ __forceinline__ void attn_item(const Params& P, LAS unsigned char* lds, int m, int h) {
    const int tid = opaque_tid(), lane = tid & 63, wave = tid >> 6, fr = lane & 15, fq = lane >> 4;
    unsigned char* ws = P.ws;
    const bf16_t* proj = (const bf16_t*)(ws + WS_PROJ); const bf16_t* vt = (const bf16_t*)(ws + WS_VT); bf16_t* yb = (bf16_t*)(ws + WS_YB);
    LAS float* biasl = (LAS float*)(lds + AL_B);
    const int nq = 2 * m + (wave >> 2), w4 = wave & 3;
    const int qi = nq * 64 + 16 * w4 + fr;
    const int cbeg = 2 * m - 8 < 0 ? 0 : 2 * m - 8, cend = 2 * m + 1;
    const bf16_t* kg[2]; const bf16_t* vg[2]; int kl[2], vl[2];
#pragma unroll
    for (int i = 0; i < 2; ++i) { const int p = tid + 512 * i;
        kg[i] = proj + (size_t)(p >> 4) * NIN + C_KB + h * DH + 8 * (p & 15); kl[i] = (p >> 4) * 272 + 16 * (p & 15);
        vg[i] = vt + (size_t)(h * DH + (p >> 3)) * M + 8 * (p & 7); vl[i] = (p >> 3) * 144 + 16 * (p & 7); }
#define ATT_LOAD(KR, VR, C) do { _Pragma("unroll") for (int i = 0; i < 2; ++i) { KR[i] = *(const u32x4*)(kg[i] + (size_t)(C) * 64 * NIN); VR[i] = *(const u32x4*)(vg[i] + (C) * 64); } } while (0)
#define ATT_WRITE(KR, VR, BUF) do { _Pragma("unroll") for (int i = 0; i < 2; ++i) { *(LAS u32x4*)(lds + AL_K + (BUF) * (64 * 272) + kl[i]) = KR[i]; *(LAS u32x4*)(lds + AL_V + (BUF) * (128 * 144) + vl[i]) = VR[i]; } } while (0)
    u32x4 kA[2], vA[2], kB[2], vB[2];
    ATT_LOAD(kA, vA, cbeg);
    ATT_LOAD(kB, vB, cbeg + 1);
    if (tid < 192) biasl[tid] = P.rel_bias[h * 192 + tid];
    bf16x8 Qb[4];
#pragma unroll
    for (int s = 0; s < 4; ++s) Qb[s] = ld8(proj + (size_t)qi * NIN + C_QB + h * DH + 32 * s + 8 * fq);
    ATT_WRITE(kA, vA, 0);
    __syncthreads();
    float mrun = -1e30f, lrun = 0.f;
    f32x4 Ot[8];
#pragma unroll
    for (int i = 0; i < 8; ++i) Ot[i] = (f32x4){0.f, 0.f, 0.f, 0.f};
#pragma unroll 1
    for (int c = cbeg; c <= cend; c += 2) {
        if (c + 2 <= cend) ATT_LOAD(kA, vA, c + 2);
        if (c >= nq - 8 && c <= nq) attn_compute(lds + AL_K, lds + AL_V, biasl, Qb, Ot, mrun, lrun, c, qi, fr, fq);
        if (c + 1 <= cend) ATT_WRITE(kB, vB, 1);
        __syncthreads();
        if (c + 1 > cend) break;
        if (c + 3 <= cend) ATT_LOAD(kB, vB, c + 3);
        if (c + 1 >= nq - 8 && c + 1 <= nq) attn_compute(lds + AL_K + 64 * 272, lds + AL_V + 128 * 144, biasl, Qb, Ot, mrun, lrun, c + 1, qi, fr, fq);
        if (c + 2 <= cend) ATT_WRITE(kA, vA, 0);
        __syncthreads();
    }
#undef ATT_LOAD
#undef ATT_WRITE
    lrun += __shfl_xor(lrun, 16); lrun += __shfl_xor(lrun, 32);
    const float inv = 1.f / lrun;
#pragma unroll
    for (int dt = 0; dt < 8; ++dt) { u32x2 w; w.x = pk2(Ot[dt][0] * inv, Ot[dt][1] * inv); w.y = pk2(Ot[dt][2] * inv, Ot[dt][3] * inv);
        *(u32x2*)(yb + (size_t)qi * 1024 + h * DH + 16 * dt + 4 * fq) = w; }
}

__device__ __forceinline__ void phase_gnorm(const Params& P, int G) {
    unsigned char* ws = P.ws;
    bf16_t* ya = (bf16_t*)(ws + WS_YA); const bf16_t* proj = (const bf16_t*)(ws + WS_PROJ);
    const int gt = blockIdx.x * 512 + opaque_tid(), l16 = gt & 15;
    const f32x4 w0 = *(const f32x4*)(P.gdn_norm + 8 * l16), w1 = *(const f32x4*)(P.gdn_norm + 8 * l16 + 4);
    const int stride = (G * 512) >> 4;
    for (int g0 = gt >> 4; g0 < M * NH; g0 += 4 * stride) {
        u32x4 ro[4], rz[4]; bf16_t* po[4];
#pragma unroll
        for (int q = 0; q < 4; ++q) { const int g = g0 + q * stride; const int row = g >> 3, h = g & 7;
            po[q] = ya + (size_t)row * 1024 + h * DH + 8 * l16;
            if (g < M * NH) { ro[q] = *(const u32x4*)po[q]; rz[q] = __builtin_nontemporal_load((const u32x4*)(proj + (size_t)row * NIN + C_Z + h * DH + 8 * l16)); } }
#pragma unroll
        for (int q = 0; q < 4; ++q) if (g0 + q * stride < M * NH) {
            float o[8], z[8]; unpack8(ro[q], o); unpack8(rz[q], z);
            float sq = 0.f;
#pragma unroll
            for (int e = 0; e < 8; ++e) sq += o[e] * o[e];
            sq += __shfl_xor(sq, 1); sq += __shfl_xor(sq, 2); sq += __shfl_xor(sq, 4); sq += __shfl_xor(sq, 8);
            const float rn = rsqrtf(sq * (1.f / DH) + EPS);
#pragma unroll
            for (int e = 0; e < 8; ++e) o[e] = o[e] * rn * (e < 4 ? w0[e] : w1[e - 4]) * siluf_(z[e]);
            *(u32x4*)po[q] = pack8f(o);
        }
    }
}

#define XB_TMO      128
#define XB_XCNT(j)  (256  + 64 * (j))
#define XB_XSUB(j)  (1280 + 64 * (j))
#define XB_XGEN(j)  (2304 + 64 * (j))
#define XB_TOP      3328
#define XB_TOPGEN   3392
#define XCD_BAR_WORDS 3456
#define XB_SPIN_CAP (1u << 18)
__device__ __forceinline__ unsigned xb_ld(unsigned* p)              { return __hip_atomic_load(p, __ATOMIC_RELAXED, __HIP_MEMORY_SCOPE_AGENT); }
__device__ __forceinline__ unsigned xb_add(unsigned* p, unsigned v) { return __hip_atomic_fetch_add(p, v, __ATOMIC_RELAXED, __HIP_MEMORY_SCOPE_AGENT); }
__device__ __forceinline__ unsigned xb_xcc_id() { return (unsigned)__builtin_amdgcn_s_getreg((3 << 11) | 20) & 0xFu; }
#define XB_SPIN(cond, bar) do { unsigned _sp = 0; while (cond) { __builtin_amdgcn_s_sleep(1); \
    if ((++_sp & 255u) == 0u) { if (xb_ld(&(bar)[XB_TMO])) break; if (_sp > XB_SPIN_CAP) { atomicAdd(&(bar)[XB_TMO], 1u); break; } } } } while (0)
struct XcdBarrier { unsigned* bar; unsigned x; volatile LAS unsigned* st; };
__device__ __forceinline__ XcdBarrier xcd_barrier_post(unsigned* bar, volatile LAS unsigned* st) {
    XcdBarrier b; b.bar = bar; b.x = xb_xcc_id(); b.st = st;
    if (threadIdx.x == 0) (void)xb_add(&bar[XB_XCNT(b.x)], 1u);
    return b;
}
__device__ __forceinline__ void xcd_barrier_complete(unsigned* bar, unsigned x, unsigned& nloc, unsigned& nx) {
    const unsigned G = gridDim.x * gridDim.y * gridDim.z;
    unsigned sum, cnt, mine, sp = 0u;
    for (;;) {
        sum = 0u; cnt = 0u; mine = 0u;
#pragma unroll
        for (unsigned j = 0; j < 16; ++j) { const unsigned c = xb_ld(&bar[XB_XCNT(j)]); sum += c; cnt += (c > 0u) ? 1u : 0u; mine = (j == x) ? c : mine; }
        if (sum == G) break;
        __builtin_amdgcn_s_sleep(1);
        if ((++sp & 255u) == 0u) { if (xb_ld(&bar[XB_TMO])) break; if (sp > XB_SPIN_CAP) { atomicAdd(&bar[XB_TMO], 1u); break; } }
    }
    nloc = mine > 0u ? mine : 1u; nx = cnt > 0u ? cnt : 1u;
}
__device__ __forceinline__ void xcd_barrier(const XcdBarrier& b) {
    asm volatile("s_waitcnt vmcnt(0)" ::: "memory");
    __syncthreads();
    if (threadIdx.x == 0) {
        unsigned* bar = b.bar;
        __builtin_amdgcn_s_waitcnt(0);
        unsigned nloc = b.st[0], nx = b.st[1];
        if (nloc == 0u) { xcd_barrier_complete(bar, b.x, nloc, nx); b.st[0] = nloc; b.st[1] = nx; }
        const unsigned old = xb_add(&bar[XB_XSUB(b.x)], 1u);
        const unsigned gen = old / nloc;
        if (old + 1u == (gen + 1u) * nloc) {
            __builtin_amdgcn_fence(__ATOMIC_RELEASE, "agent");
            asm volatile("s_waitcnt vmcnt(0)" ::: "memory");
            const unsigned og = xb_add(&bar[XB_TOP], 1u);
            const unsigned tg = og / nx;
            if (og + 1u == (tg + 1u) * nx) xb_add(&bar[XB_TOPGEN], 1u);
            else XB_SPIN(xb_ld(&bar[XB_TOPGEN]) == tg, bar);
            __builtin_amdgcn_fence(__ATOMIC_ACQUIRE, "agent");
            xb_add(&bar[XB_XGEN(b.x)], 1u);
            asm volatile("s_waitcnt vmcnt(0)" ::: "memory");
        } else {
            XB_SPIN(xb_ld(&bar[XB_XGEN(b.x)]) == gen, bar);
            __builtin_amdgcn_fence(__ATOMIC_ACQUIRE, "agent");
            asm volatile("s_waitcnt vmcnt(0)" ::: "memory");
        }
    }
    __syncthreads();
}

constexpr int NPHASE = 11;
__global__ void __launch_bounds__(512, 2) fwd_megakernel(Params P) {
    extern __shared__ __attribute__((aligned(16))) unsigned char smem[];
    LAS unsigned char* lds = (LAS unsigned char*)smem;
    cg::grid_group grid = cg::this_grid();
    const int G = gridDim.x, lo = P.ph_lo, hi = P.ph_hi & 255, pflags = P.ph_hi >> 8;
    unsigned char* ws = P.ws;
    float* ss = (float*)(ws + WS_SS);
    bf16_t* xb = (bf16_t*)(ws + WS_XB); bf16_t* act = (bf16_t*)(ws + WS_ACT); bf16_t* proj = (bf16_t*)(ws + WS_PROJ);
#ifndef NREP5
#define NREP5 1
#endif
#ifndef REP_PHASE
#define REP_PHASE -1
#endif
#define IN(k) (lo <= (k) && (k) < hi)
    volatile LAS unsigned* xst = (volatile LAS unsigned*)(lds + LDS_BYTES - 16);
    if (threadIdx.x == 0) { xst[0] = 0u; xst[1] = 0u; }
    __syncthreads();
    XcdBarrier xbar = xcd_barrier_post((unsigned*)(ws + WS_BAR), xst);
    if (lo < 0) grid.sync();
#define SEAM(k) do { if (IN(k) && IN((k) + 1)) xcd_barrier(xbar); } while (0)
    for (int rep = 0; rep < (REP_PHASE == 0 ? 2 : 1); ++rep) { if (IN(0)) phase_convert(P, lds, G);
    SEAM(0); }
    for (int rep = 0; rep < (REP_PHASE == 1 ? 2 : 1); ++rep) {
    if (IN(1)) { pg8::Sched S; S.init(xb, (const bf16_t*)(ws + WS_WGU1), nullptr, nullptr, M, NGU, G, blockIdx.x, 0); EpiGU E{act, ss}; pg8::gemm_phase(lds, D, S, E);
        idle_convert(P, lds, (M / 256) * (NGU / 256), G, -1, 0); }
    SEAM(1); }
    if (IN(2)) { pg8::Sched S; S.init(act, (const bf16_t*)(ws + WS_WD1), nullptr, nullptr, M, D, G, blockIdx.x, 0); EpiRes E{P.x, P.out, xb, ss + M, 0.5f}; pg8::gemm_phase(lds, FF, S, E); }
    SEAM(2);
    if (IN(3)) { pg8::Sched S; S.init(xb, (const bf16_t*)(ws + WS_WIN), nullptr, nullptr, M, NIN, G, blockIdx.x, 0); EpiProj E{proj, ss + M}; pg8::gemm_phase(lds, D, S, E);
        idle_convert(P, lds, (M / 256) * (NIN / 256), G, 0, LATE_A); }
    SEAM(3);
    if (IN(4)) { const int nit = (NCH * NH - 1 - (int)blockIdx.x) / G; for (int k = nit; k >= 0; --k) prep_item(P, lds, blockIdx.x + k * G, pflags); }
    SEAM(4);
_Pragma("unroll 1")
    for (int rep = 0; rep < NREP5; ++rep) {
    if (IN(5)) {
        const int tid5 = opaque_tid(), wave = tid5 >> 6, b = blockIdx.x;
        if (b < 64) { if (!(pflags & 4)) scan_wg(P, lds, b & 7, b >> 3, 0); }
        else { if (!(pflags & 2)) for (int it = b - 64; it < (NCH / 2) * NH; it += G - 64) attn_item(P, lds, it >> 3, it & 7);
            if (!(pflags & 1)) convert_late(P, (LAS float*)(lds + wave * 17408), ((((M / 256) * (NIN / 256)) % G) ? LATE_A : 0), ((((M / 256) * (NGU / 256)) % G) ? LATE_C : N_LATE), (b - 64) * 8 + wave, (G - 64) * 8, tid5 & 63); }
    }
    SEAM(5); }
    if (IN(6)) phase_gnorm(P, G);
    SEAM(6);
    if (IN(7)) { pg8::Sched S; S.init((const bf16_t*)(ws + WS_YA), (const bf16_t*)(ws + WS_WA), (const bf16_t*)(ws + WS_YB), (const bf16_t*)(ws + WS_WB), M, D, G, blockIdx.x, 1);
        EpiMix E{proj, (bf16_t*)(ws + WS_MIX)}; pg8::gemm_phase(lds, 1024, S, E); }
    SEAM(7);
    if (IN(8)) { pg8::Sched S; S.init((const bf16_t*)(ws + WS_MIX), (const bf16_t*)(ws + WS_WOUT), nullptr, nullptr, M, D, G, blockIdx.x, 0); EpiRes E{P.out, P.out, xb, ss + 2 * M, 1.0f}; pg8::gemm_phase(lds, D, S, E); }
    SEAM(8);
    if (IN(9)) { pg8::Sched S; S.init(xb, (const bf16_t*)(ws + WS_WGU2), nullptr, nullptr, M, NGU, G, blockIdx.x, 0); EpiGU E{act, ss + 2 * M}; pg8::gemm_phase(lds, D, S, E);
        idle_convert(P, lds, (M / 256) * (NGU / 256), G, LATE_C, N_LATE); }
    SEAM(9);
    if (IN(10)) { pg8::Sched S; S.init(act, (const bf16_t*)(ws + WS_WD2), nullptr, nullptr, M, D, G, blockIdx.x, 0); EpiRes E{P.out, P.out, xb, ss + 3 * M, 0.5f}; pg8::gemm_phase(lds, FF, S, E); }
    SEAM(10);
    if (IN(11)) {
        { pg8::Sched S; S.init((const bf16_t*)(ws + WS_PB), (const bf16_t*)(ws + WS_WPP), nullptr, nullptr, M, D, G, blockIdx.x, 0); EpiF32 E{(float*)(ws + WS_RBUF)}; pg8::gemm_phase(lds, PLE, S, E); }
        { pg8::Sched S; S.init(xb, (const bf16_t*)(ws + WS_WPG), nullptr, nullptr, M, D, G, blockIdx.x, 0); EpiPle E{P.out, (const float*)(ws + WS_RBUF), ss + 3 * M}; pg8::gemm_phase(lds, D, S, E); }
    }
#undef IN
#undef SEAM
}


#ifdef PROBE_VAR
__global__ void __launch_bounds__(512, 2) probe_scan(Params P) {
    extern __shared__ __attribute__((aligned(16))) unsigned char smem[];
    scan_wg(P, (LAS unsigned char*)smem, blockIdx.x & 7, blockIdx.x >> 3, PROBE_VAR);
}
#endif
#ifndef N_LAUNCH_MODE
#define N_LAUNCH_MODE 0
#endif
extern "C" void kernel_launch(void* const* d_in, const int* in_sizes, int n_in, void* d_out, int out_size, void* d_ws, size_t ws_size, hipStream_t stream) {
    static int grid = 0;
    if (grid == 0) {
        if (n_in != 23 || out_size != M * D || ws_size < WS_END) { fprintf(stderr, "kernel_launch: unexpected problem (n_in %d out %d ws %zu need %zu)\n", n_in, out_size, ws_size, (size_t)WS_END); grid = -1; return; }
        int dev = 0, cus = 0, per_cu = 0;
        hipGetDevice(&dev); hipDeviceGetAttribute(&cus, hipDeviceAttributeMultiprocessorCount, dev);
        if (hipFuncSetAttribute((const void*)fwd_megakernel, hipFuncAttributeMaxDynamicSharedMemorySize, LDS_BYTES) != hipSuccess) { fprintf(stderr, "kernel_launch: hipFuncSetAttribute failed\n"); grid = -1; return; }
        if (hipOccupancyMaxActiveBlocksPerMultiprocessor(&per_cu, (const void*)fwd_megakernel, 512, LDS_BYTES) != hipSuccess || per_cu < 1) { fprintf(stderr, "kernel_launch: occupancy query failed (%d)\n", per_cu); (void)hipGetLastError(); per_cu = 1; }
        grid = cus * 1;
        if (grid < 192) { fprintf(stderr, "kernel_launch: grid too small\n"); grid = -1; return; }
    }
    if (grid < 0) return;
    if (hipMemsetAsync((char*)d_ws + WS_BAR, 0, 16384, stream) != hipSuccess) { fprintf(stderr, "kernel_launch: memset of the barrier words failed\n"); return; }
    Params p{};
    const float** pp = (const float**)&p;
    for (int i = 0; i < 23; ++i) pp[i] = (const float*)d_in[i];
    p.out = (float*)d_out; p.ws = (unsigned char*)d_ws;
#if N_LAUNCH_MODE == 0
    p.ph_lo = 0; p.ph_hi = NPHASE + 1;
    void* args[] = {&p};
    hipError_t e = hipLaunchCooperativeKernel((const void*)fwd_megakernel, dim3(grid), dim3(512), args, LDS_BYTES, stream);
    if (e != hipSuccess) fprintf(stderr, "cooperative launch failed: %s (grid %d)\n", hipGetErrorString(e), grid);
#ifdef PROBE_VAR
    hipLaunchKernelGGL(probe_scan, dim3(64), dim3(512), 16384, stream, p);
#endif
#ifdef PROBE_PHASE
    p.ph_lo = PROBE_PHASE; p.ph_hi = (PROBE_PHASE + 1) | (PROBE_FLAGS << 8); hipLaunchKernelGGL(fwd_megakernel, dim3(grid), dim3(512), LDS_BYTES, stream, p);
#endif
#else
    for (int ph = 0; ph <= NPHASE; ++ph) { p.ph_lo = ph; p.ph_hi = ph + 1; hipLaunchKernelGGL(fwd_megakernel, dim3(grid), dim3(512), LDS_BYTES, stream, p); }
#endif
}
```

```cpp
#include <hip/hip_runtime.h>
#include <hip/hip_cooperative_groups.h>
#include <cstdio>
namespace cg = cooperative_groups;

#define LAS __attribute__((address_space(3)))
typedef unsigned short bf16_t;
typedef short bf16x8 __attribute__((ext_vector_type(8)));
typedef float f32x4 __attribute__((ext_vector_type(4)));
typedef unsigned u32x4 __attribute__((ext_vector_type(4)));
typedef unsigned u32x2 __attribute__((ext_vector_type(2)));
typedef __bf16 bf16v2 __attribute__((ext_vector_type(2)));

constexpr int M = 8192, D = 2048, FF = 5632, NGU = 11264, NIN = 11520, NINSRC = 11280, PLE = 256;
constexpr int NH = 8, DH = 128, NCH = 128;
constexpr int C_QA = 0, C_KA = 1024, C_VA = 2048, C_Z = 3072, C_QB = 4096, C_KB = 5120, C_VB = 6144, C_GA = 7168, C_GB = 9216, C_AR = 11264, C_BR = 11272;
constexpr float EPS = 1e-6f;
constexpr size_t WS_WGU1 = 0;
constexpr size_t WS_WD1  = WS_WGU1 + (size_t)NGU * D * 2;
constexpr size_t WS_WIN  = WS_WD1 + (size_t)D * FF * 2;
constexpr size_t WS_WA   = WS_WIN + (size_t)NIN * D * 2;
constexpr size_t WS_WB   = WS_WA + (size_t)D * 1024 * 2;
constexpr size_t WS_WOUT = WS_WB + (size_t)D * 1024 * 2;
constexpr size_t WS_WGU2 = WS_WOUT + (size_t)D * D * 2;
constexpr size_t WS_WD2  = WS_WGU2 + (size_t)NGU * D * 2;
constexpr size_t WS_WPG  = WS_WD2 + (size_t)D * FF * 2;
constexpr size_t WS_WPP  = WS_WPG + (size_t)D * D * 2;
constexpr size_t WS_XB   = WS_WPP + (size_t)D * PLE * 2;
constexpr size_t WS_PROJ = WS_XB + (size_t)M * D * 2;
constexpr size_t WS_AQK  = WS_PROJ + (size_t)M * NIN * 2;
constexpr size_t WS_KTT  = WS_AQK + (size_t)1024 * 64 * 64 * 2;
constexpr size_t WS_PB   = WS_KTT + (size_t)M * 1024 * 2;
constexpr size_t WS_VT   = WS_PB + (size_t)M * PLE * 2;
constexpr size_t WS_SS   = WS_VT + (size_t)M * 1024 * 2;
constexpr size_t WS_TAIL = WS_SS + (size_t)4 * M * 4;
constexpr size_t WS_PROG = WS_TAIL + 4096;
constexpr size_t WS_BAR  = WS_PROG + 4096;
constexpr size_t WS_END  = WS_BAR + 16384;
constexpr size_t WS_ACT  = WS_PROJ;
constexpr size_t WS_RBUF = WS_PROJ;
constexpr size_t WS_U    = 0;
constexpr size_t WS_W    = WS_U + (size_t)M * 1024 * 4;
constexpr size_t WS_QD   = WS_W + (size_t)M * 1024 * 2;
constexpr size_t WS_MIX  = 0;
constexpr size_t WS_YB   = WS_XB;
constexpr size_t WS_YA   = WS_XB + (size_t)M * 1024 * 2;
static_assert(WS_QD + (size_t)M * 1024 * 2 <= WS_WIN, "gdn scratch overlaps live weights");

constexpr int LDS_BYTES = 147456;

__device__ __forceinline__ unsigned pk2(float lo, float hi) { bf16v2 v = {(__bf16)lo, (__bf16)hi}; return __builtin_bit_cast(unsigned, v); }
__device__ __forceinline__ float bf2f(bf16_t b) { return __uint_as_float(((unsigned)b) << 16); }
__device__ __forceinline__ float bflo(unsigned w) { return __uint_as_float(w << 16); }
__device__ __forceinline__ float bfhi(unsigned w) { return __uint_as_float(w & 0xffff0000u); }
__device__ __forceinline__ void unpack8(u32x4 w, float (&f)[8]) { f[0] = bflo(w.x); f[1] = bfhi(w.x); f[2] = bflo(w.y); f[3] = bfhi(w.y); f[4] = bflo(w.z); f[5] = bfhi(w.z); f[6] = bflo(w.w); f[7] = bfhi(w.w); }
__device__ __forceinline__ u32x4 pack8f(const float (&f)[8]) { u32x4 w; w.x = pk2(f[0], f[1]); w.y = pk2(f[2], f[3]); w.z = pk2(f[4], f[5]); w.w = pk2(f[6], f[7]); return w; }
__device__ __forceinline__ bf16x8 pack_acc(f32x4 a, f32x4 b) { u32x4 p; p.x = pk2(a[0], a[1]); p.y = pk2(a[2], a[3]); p.z = pk2(b[0], b[1]); p.w = pk2(b[2], b[3]); return __builtin_bit_cast(bf16x8, p); }
__device__ __forceinline__ bf16x8 ld2x8(const bf16_t* p0, const bf16_t* p1) { const u32x2 a = *(const u32x2*)p0, b = *(const u32x2*)p1; u32x4 v; v.x = a.x; v.y = a.y; v.z = b.x; v.w = b.y; return __builtin_bit_cast(bf16x8, v); }
__device__ __forceinline__ bf16x8 ld8(const bf16_t* p) { return __builtin_bit_cast(bf16x8, *(const u32x4*)p); }
__device__ __forceinline__ float sigmoidf_(float x) { return __builtin_amdgcn_rcpf(1.f + __expf(-x)); }
__device__ __forceinline__ float siluf_(float x) { return x * __builtin_amdgcn_rcpf(1.f + __expf(-x)); }
__device__ __forceinline__ float wave_sum(float v) {
#pragma unroll
    for (int o = 1; o < 64; o <<= 1) v += __shfl_xor(v, o);
    return v;
}
__device__ __forceinline__ int opaque_tid() { int t = threadIdx.x; asm volatile("" : "+v"(t)); return t; }
#define MFMA16(a, b, c) __builtin_amdgcn_mfma_f32_16x16x32_bf16((a), (b), (c), 0, 0, 0)

namespace pg8 {
constexpr int BM = 256, BK = 64, HALF = 128, HTB = HALF * BK * 2, STAGE_BYTES = 8 * HTB, NXCD = 8, WGM = 8;
__device__ __forceinline__ int lds_byte(int r, int c) { const int st = (r >> 4) * 2 + (c >> 5), rr = r & 15, cc = c & 31, ob = rr * 64 + cc * 2; return st * 1024 + (ob ^ (((ob >> 9) & 1) << 5)); }
__device__ __forceinline__ void stage_rc(int b, int& R, int& C) { const int st = b / 1024, sb = b % 1024, swz = sb ^ (((sb >> 9) & 1) << 5); R = (st >> 1) * 16 + swz / 64; C = (st & 1) * 32 + (swz % 64) / 2; }
__device__ __forceinline__ int perm32(int rho) { const int n = rho >> 4, i = rho & 15; return 8 * (i >> 2) + 4 * n + (i & 3); }

struct Unit { int pm, pn, sel; };
struct Sched {
    const bf16_t *A0, *B0, *A1, *B1;
    int nM, nN, nwg, G, c, dual;
    __device__ __forceinline__ void init(const bf16_t* a0, const bf16_t* b0, const bf16_t* a1, const bf16_t* b1, int Mr, int Nc, int G_, int c_, int dual_) {
        A0 = a0; B0 = b0; A1 = a1; B1 = b1; nM = Mr / BM; nN = Nc / BM; nwg = nM * nN; G = G_; c = c_; dual = dual_; }
    __device__ __forceinline__ bool next(int i, Unit& u) const {
        const int tile = dual ? (i >> 1) : i;
        const long L = (long)tile * G + c; if (L >= nwg) return false;
        int wgid = (int)L; { const int q = nwg / NXCD, r = nwg % NXCD, xcd = wgid % NXCD, off = wgid / NXCD; wgid = (xcd < r ? xcd * (q + 1) : r * (q + 1) + (xcd - r) * q) + off; }
        const int nig = WGM * nN, gid = wgid / nig, fm = gid * WGM, gsz = (nM - fm) < WGM ? (nM - fm) : WGM;
        u.pm = fm + ((wgid % nig) % gsz); u.pn = (wgid % nig) / gsz; u.sel = dual ? (i & 1) : 0; return true;
    }
};

template <class Epi>
__device__ __forceinline__ void gemm_phase(LAS unsigned char* lds, const int K, const Sched& S, const Epi& E) {
    const int tid = opaque_tid(), wid = __builtin_amdgcn_readfirstlane(tid >> 6), lane = tid & 63, wr = wid >> 2, wc = wid & 3, fr = lane & 15, fq = lane >> 4;
    const int nt = K / BK;
    unsigned voffA[2], voffB[2];
#pragma unroll
    for (int i = 0; i < 2; ++i) { int R, C; stage_rc(tid * 16 + i * 8192, R, C); const int Rb = Epi::PERM ? ((R & ~31) + perm32(R & 31)) : R;
        voffA[i] = (unsigned)(R * K + C) * 2u; voffB[i] = (unsigned)(Rb * K + C) * 2u; }
    const size_t kstep = (size_t)(BK * 2);
    const size_t hstep = (size_t)HALF * K * 2;
    const size_t tstep = 2 * hstep;
    const unsigned ldsw = (unsigned)wid * 1024u;
    const int aoff = lds_byte(wr * 64 + fr, fq * 8), boff = lds_byte(wc * 32 + fr, fq * 8);
#define PG8_SA(b, h) (((b) * 2 + (h)) * HTB)
#define PG8_SB(b, h) ((4 + (b) * 2 + (h)) * HTB)
#define PG8_STAGE(bufoff, gbase, voff) do { _Pragma("unroll") for (int _i = 0; _i < 2; ++_i) \
        __builtin_amdgcn_global_load_lds((const unsigned*)((const char*)(gbase) + (voff)[_i]), (LAS unsigned*)(lds + (bufoff) + ldsw + _i * 8192), 16, 0, 0); } while (0)
#define PG8_LDA(dst, b, h) do { _Pragma("unroll") for (int m = 0; m < 4; ++m) _Pragma("unroll") for (int k = 0; k < 2; ++k) dst[m][k] = *(const LAS bf16x8*)(lds + PG8_SA(b, h) + aoff + m * 2048 + k * 1024); } while (0)
#define PG8_LDB(dst, b, h) do { _Pragma("unroll") for (int n = 0; n < 2; ++n) _Pragma("unroll") for (int k = 0; k < 2; ++k) dst[n][k] = *(const LAS bf16x8*)(lds + PG8_SB(b, h) + boff + n * 2048 + k * 1024); } while (0)
#define PG8_MMA(ai, bj, At, Bt) do { __builtin_amdgcn_s_setprio(1); _Pragma("unroll") for (int m = 0; m < 4; ++m) _Pragma("unroll") for (int n = 0; n < 2; ++n) _Pragma("unroll") for (int k = 0; k < 2; ++k) \
        acc[ai][bj][m][n] = __builtin_amdgcn_mfma_f32_16x16x32_bf16(Bt[n][k], At[m][k], acc[ai][bj][m][n], 0, 0, 0); __builtin_amdgcn_s_setprio(0); } while (0)
#define PG8_WAIT_V(n) asm volatile("s_waitcnt vmcnt(" #n ")" ::: "memory")
#define PG8_WAIT_L(n) asm volatile("s_waitcnt lgkmcnt(" #n ")" ::: "memory")
#define PG8_BAR __builtin_amdgcn_s_barrier()
#define PG8_SCHED __builtin_amdgcn_sched_barrier(0)
    Unit cur, nxt; int ui = 0;
    if (!S.next(0, cur)) return;
    float ssv[8]; E.pre(cur, wr, fr, ssv);
    f32x4 acc[2][2][4][2];
#pragma unroll
    for (int a = 0; a < 2; ++a)
#pragma unroll
        for (int b = 0; b < 2; ++b)
#pragma unroll
            for (int m = 0; m < 4; ++m)
#pragma unroll
                for (int n = 0; n < 2; ++n) acc[a][b][m][n] = (f32x4){0.f, 0.f, 0.f, 0.f};
    bf16x8 At[4][2], B0[2][2], B1[2][2];
    const char* cA = (const char*)(cur.sel ? S.A1 : S.A0) + (size_t)cur.pm * tstep; const char* cB = (const char*)(cur.sel ? S.B1 : S.B0) + (size_t)cur.pn * tstep;
    PG8_STAGE(PG8_SB(0, 0), cB, voffB); PG8_STAGE(PG8_SA(0, 0), cA, voffA); PG8_STAGE(PG8_SB(0, 1), cB + hstep, voffB); PG8_STAGE(PG8_SA(0, 1), cA + hstep, voffA);
    if (wr == 1) PG8_BAR;
    PG8_WAIT_V(4); PG8_BAR;
    PG8_STAGE(PG8_SB(1, 0), cB + kstep, voffB); PG8_STAGE(PG8_SA(1, 0), cA + kstep, voffA); PG8_STAGE(PG8_SB(1, 1), cB + hstep + kstep, voffB);
    PG8_WAIT_V(6); PG8_BAR;
    for (;;) {
        const bool has_next = S.next(ui + 1, nxt);
        const char* nA = has_next ? (const char*)(nxt.sel ? S.A1 : S.A0) + (size_t)nxt.pm * tstep : cA; const char* nB = has_next ? (const char*)(nxt.sel ? S.B1 : S.B0) + (size_t)nxt.pn * tstep : cB;
        for (int t = 0; t < nt; t += 2) {
            const bool last = (t == nt - 2);
            const char* a1 = cA + (size_t)(t + 1) * kstep;
            const char* a2 = last ? nA : cA + (size_t)(t + 2) * kstep; const char* b2 = last ? nB : cB + (size_t)(t + 2) * kstep;
            const char* a3 = a2 + kstep; const char* b3 = b2 + kstep;
            PG8_LDB(B0, 0, 0); PG8_SCHED; PG8_LDA(At, 0, 0); PG8_STAGE(PG8_SA(1, 1), a1 + hstep, voffA);
            PG8_WAIT_L(8); PG8_BAR; PG8_WAIT_L(0); PG8_MMA(0, 0, At, B0); PG8_BAR; PG8_SCHED;
            PG8_LDB(B1, 0, 1); PG8_STAGE(PG8_SB(0, 0), b2, voffB);
            PG8_BAR; PG8_WAIT_L(0); PG8_MMA(0, 1, At, B1); PG8_BAR;
            PG8_LDA(At, 0, 1); PG8_STAGE(PG8_SA(0, 0), a2, voffA);
            PG8_BAR; PG8_WAIT_L(0); PG8_MMA(1, 0, At, B0); PG8_BAR; PG8_SCHED;
            PG8_STAGE(PG8_SB(0, 1), b2 + hstep, voffB);
            PG8_WAIT_V(6); PG8_BAR; PG8_MMA(1, 1, At, B1); PG8_BAR;
            PG8_LDB(B0, 1, 0); PG8_SCHED; PG8_LDA(At, 1, 0); PG8_STAGE(PG8_SA(0, 1), a2 + hstep, voffA);
            PG8_WAIT_L(8); PG8_BAR; PG8_WAIT_L(0); PG8_MMA(0, 0, At, B0); PG8_BAR; PG8_SCHED;
            PG8_LDB(B1, 1, 1); PG8_STAGE(PG8_SB(1, 0), b3, voffB);
            PG8_BAR; PG8_WAIT_L(0); PG8_MMA(0, 1, At, B1); PG8_BAR;
            PG8_LDA(At, 1, 1); PG8_STAGE(PG8_SA(1, 0), a3, voffA);
            PG8_BAR; PG8_WAIT_L(0); PG8_MMA(1, 0, At, B0); PG8_BAR; PG8_SCHED;
            PG8_STAGE(PG8_SB(1, 1), b3 + hstep, voffB);
            PG8_WAIT_V(6); PG8_BAR; PG8_MMA(1, 1, At, B1); PG8_BAR;
        }
        E(acc, cur, wr, wc, fr, fq, ssv);
        if (!has_next) break;
        if (!E.keep(cur)) {
#pragma unroll
            for (int a = 0; a < 2; ++a)
#pragma unroll
                for (int b = 0; b < 2; ++b)
#pragma unroll
                    for (int m = 0; m < 4; ++m)
#pragma unroll
                        for (int n = 0; n < 2; ++n) acc[a][b][m][n] = (f32x4){0.f, 0.f, 0.f, 0.f};
        }
        cur = nxt; cA = nA; cB = nB; ++ui;
        E.pre(cur, wr, fr, ssv);
    }
    PG8_WAIT_V(0);
    if (wr == 0) PG8_BAR;
    PG8_BAR;
#undef PG8_SA
#undef PG8_SB
#undef PG8_STAGE
#undef PG8_LDA
#undef PG8_LDB
#undef PG8_MMA
#undef PG8_WAIT_V
#undef PG8_WAIT_L
#undef PG8_BAR
#undef PG8_SCHED
}
}
using pg8::Unit;
typedef f32x4 Acc[2][2][4][2];

struct EpiGU {
    static constexpr bool PERM = true;
    bf16_t* O; const float* ss;
    __device__ __forceinline__ void pre(const Unit& u, int wr, int fr, float (&ssv)[8]) const {
#pragma unroll
        for (int ai = 0; ai < 2; ++ai)
#pragma unroll
            for (int m = 0; m < 4; ++m) ssv[ai * 4 + m] = ss[u.pm * 256 + ai * 128 + wr * 64 + m * 16 + fr];
    }
    __device__ __forceinline__ bool keep(const Unit&) const { return false; }
    __device__ __forceinline__ void operator()(Acc& acc, const Unit& u, int wr, int wc, int fr, int fq, const float (&ssv)[8]) const {
        const int row0 = u.pm * 256 + wr * 64 + fr, col0 = u.pn * 128 + wc * 32 + 8 * fq;
#pragma unroll
        for (int ai = 0; ai < 2; ++ai)
#pragma unroll
            for (int m = 0; m < 4; ++m) {
                const int row = row0 + ai * 128 + m * 16;
                const float rs = rsqrtf(ssv[ai * 4 + m] * (1.f / D) + EPS);
                const float rs2 = rs * rs, nrl = -1.4426950408889634f * rs;
                float o[8];
#pragma unroll
                for (int n = 0; n < 2; ++n)
#pragma unroll
                    for (int j = 0; j < 4; j += 2) {
                        typedef float f32x2v __attribute__((ext_vector_type(2)));
                        const f32x2v g = {acc[ai][0][m][n][j], acc[ai][0][m][n][j + 1]}, uu = {acc[ai][1][m][n][j], acc[ai][1][m][n][j + 1]};
                        const f32x2v t = g * nrl, p = (g * uu) * rs2;
                        f32x2v d; d.x = __builtin_amdgcn_exp2f(t.x); d.y = __builtin_amdgcn_exp2f(t.y); d = d + 1.0f;
                        f32x2v r; r.x = __builtin_amdgcn_rcpf(d.x); r.y = __builtin_amdgcn_rcpf(d.y);
                        const f32x2v q = p * r; o[n * 4 + j] = q.x; o[n * 4 + j + 1] = q.y;
                    }
                *(u32x4*)(O + (size_t)row * FF + col0) = pack8f(o);
            }
    }
};
struct EpiRes {
    static constexpr bool PERM = false;
    const float* base; float* out; bf16_t* ob; float* ssn; float scale;
    __device__ __forceinline__ void pre(const Unit&, int, int, float (&ssv)[8]) const {
#pragma unroll
        for (int i = 0; i < 8; ++i) ssv[i] = 0.f; }
    __device__ __forceinline__ bool keep(const Unit&) const { return false; }
    __device__ __forceinline__ void operator()(Acc& acc, const Unit& u, int wr, int wc, int fr, int fq, const float (&ssv)[8]) const {
        const int row0 = u.pm * 256 + wr * 64 + fr, col0 = u.pn * 256 + wc * 32 + 4 * fq;
#pragma unroll
        for (int ai = 0; ai < 2; ++ai) {
            f32x4 b[4][2][2];
#pragma unroll
            for (int m = 0; m < 4; ++m)
#pragma unroll
                for (int bj = 0; bj < 2; ++bj)
#pragma unroll
                    for (int n = 0; n < 2; ++n) b[m][bj][n] = *(const f32x4*)(base + (size_t)(row0 + ai * 128 + m * 16) * D + col0 + bj * 128 + n * 16);
#pragma unroll
            for (int m = 0; m < 4; ++m) {
                const int row = row0 + ai * 128 + m * 16; float sq = 0.f;
#pragma unroll
                for (int bj = 0; bj < 2; ++bj)
#pragma unroll
                    for (int n = 0; n < 2; ++n) {
                        const size_t off = (size_t)row * D + col0 + bj * 128 + n * 16;
                        const f32x4 v = b[m][bj][n] + acc[ai][bj][m][n] * scale;
                        *(f32x4*)(out + off) = v;
                        sq += (v[0] * v[0] + v[1] * v[1]) + (v[2] * v[2] + v[3] * v[3]);
                        u32x2 w; w.x = pk2(v[0], v[1]); w.y = pk2(v[2], v[3]);
                        *(u32x2*)(ob + off) = w;
                    }
                sq += __shfl_xor(sq, 16); sq += __shfl_xor(sq, 32);
                if (fq == 0) unsafeAtomicAdd(ssn + row, sq);
            }
        }
    }
};
struct EpiProj {
    static constexpr bool PERM = true;
    bf16_t* O; const float* ss;
    __device__ __forceinline__ void pre(const Unit& u, int wr, int fr, float (&ssv)[8]) const {
#pragma unroll
        for (int ai = 0; ai < 2; ++ai)
#pragma unroll
            for (int m = 0; m < 4; ++m) ssv[ai * 4 + m] = ss[u.pm * 256 + ai * 128 + wr * 64 + m * 16 + fr];
    }
    __device__ __forceinline__ bool keep(const Unit&) const { return false; }
    __device__ __forceinline__ void operator()(Acc& acc, const Unit& u, int wr, int wc, int fr, int fq, const float (&ssv)[8]) const {
        const int row0 = u.pm * 256 + wr * 64 + fr, col0 = u.pn * 256 + wc * 32 + 8 * fq;
#pragma unroll
        for (int ai = 0; ai < 2; ++ai)
#pragma unroll
            for (int m = 0; m < 4; ++m) {
                const int row = row0 + ai * 128 + m * 16;
                const float rs = rsqrtf(ssv[ai * 4 + m] * (1.f / D) + EPS);
#pragma unroll
                for (int bj = 0; bj < 2; ++bj) {
                    float o[8];
#pragma unroll
                    for (int n = 0; n < 2; ++n)
#pragma unroll
                        for (int j = 0; j < 4; ++j) o[n * 4 + j] = acc[ai][bj][m][n][j] * rs;
                    *(u32x4*)(O + (size_t)row * NIN + col0 + bj * 128) = pack8f(o);
                }
            }
    }
};
struct EpiMix {
    static constexpr bool PERM = true;
    const bf16_t* proj; bf16_t* O;
    __device__ __forceinline__ void pre(const Unit&, int, int, float (&ssv)[8]) const {
#pragma unroll
        for (int i = 0; i < 8; ++i) ssv[i] = 0.f; }
    __device__ __forceinline__ bool keep(const Unit& u) const { return u.sel == 0; }
    __device__ __forceinline__ void operator()(Acc& acc, const Unit& u, int wr, int wc, int fr, int fq, const float (&ssv)[8]) const {
        const int row0 = u.pm * 256 + wr * 64 + fr, col0 = u.pn * 256 + wc * 32 + 8 * fq;
#pragma unroll
        for (int ai = 0; ai < 2; ++ai) {
            u32x4 rga[4][2], rgb[4][2];
#pragma unroll
            for (int m = 0; m < 4; ++m)
#pragma unroll
                for (int bj = 0; bj < 2; ++bj) { const size_t o = (size_t)(row0 + ai * 128 + m * 16) * NIN + col0 + bj * 128;
                    rga[m][bj] = *(const u32x4*)(proj + o + C_GA); rgb[m][bj] = *(const u32x4*)(proj + o + C_GB); }
#pragma unroll
            for (int m = 0; m < 4; ++m) {
                const int row = row0 + ai * 128 + m * 16;
#pragma unroll
                for (int bj = 0; bj < 2; ++bj) {
                    const int col = col0 + bj * 128;
                    float ga[8], gb[8];
                    unpack8(rga[m][bj], ga);
                    unpack8(rgb[m][bj], gb);
                    if (u.sel == 0) {
#pragma unroll
                        for (int n = 0; n < 2; ++n)
#pragma unroll
                            for (int j = 0; j < 4; ++j) acc[ai][bj][m][n][j] *= (1.f + __expf(-gb[n * 4 + j])) * __builtin_amdgcn_rcpf(1.f + __expf(-ga[n * 4 + j]));
                    } else {
                        float o[8];
#pragma unroll
                        for (int n = 0; n < 2; ++n)
#pragma unroll
                            for (int j = 0; j < 4; ++j) o[n * 4 + j] = acc[ai][bj][m][n][j] * sigmoidf_(gb[n * 4 + j]);
                        *(u32x4*)(O + (size_t)row * D + col) = pack8f(o);
                    }
                }
            }
        }
    }
};
struct EpiF32 {
    static constexpr bool PERM = false;
    float* C;
    __device__ __forceinline__ void pre(const Unit&, int, int, float (&ssv)[8]) const {
#pragma unroll
        for (int i = 0; i < 8; ++i) ssv[i] = 0.f; }
    __device__ __forceinline__ bool keep(const Unit&) const { return false; }
    __device__ __forceinline__ void operator()(Acc& acc, const Unit& u, int wr, int wc, int fr, int fq, const float (&ssv)[8]) const {
        const int row0 = u.pm * 256 + wr * 64 + fr, col0 = u.pn * 256 + wc * 32 + 4 * fq;
#pragma unroll
        for (int ai = 0; ai < 2; ++ai)
#pragma unroll
            for (int m = 0; m < 4; ++m)
#pragma unroll
                for (int bj = 0; bj < 2; ++bj)
#pragma unroll
                    for (int n = 0; n < 2; ++n) *(f32x4*)(C + (size_t)(row0 + ai * 128 + m * 16) * D + col0 + bj * 128 + n * 16) = acc[ai][bj][m][n];
    }
};
struct EpiPle {
    static constexpr bool PERM = false;
    float* out; const float* R; const float* ss;
    __device__ __forceinline__ void pre(const Unit& u, int wr, int fr, float (&ssv)[8]) const {
#pragma unroll
        for (int ai = 0; ai < 2; ++ai)
#pragma unroll
            for (int m = 0; m < 4; ++m) ssv[ai * 4 + m] = ss[u.pm * 256 + ai * 128 + wr * 64 + m * 16 + fr];
    }
    __device__ __forceinline__ bool keep(const Unit&) const { return false; }
    __device__ __forceinline__ void operator()(Acc& acc, const Unit& u, int wr, int wc, int fr, int fq, const float (&ssv)[8]) const {
        const int row0 = u.pm * 256 + wr * 64 + fr, col0 = u.pn * 256 + wc * 32 + 4 * fq;
#pragma unroll
        for (int ai = 0; ai < 2; ++ai)
#pragma unroll
            for (int mp = 0; mp < 2; ++mp) {
                f32x4 bb[2][2][2], rr[2][2][2];
#pragma unroll
                for (int mm = 0; mm < 2; ++mm)
#pragma unroll
                    for (int bj = 0; bj < 2; ++bj)
#pragma unroll
                        for (int n = 0; n < 2; ++n) { const size_t off = (size_t)(row0 + ai * 128 + (2 * mp + mm) * 16) * D + col0 + bj * 128 + n * 16;
                            bb[mm][bj][n] = *(const f32x4*)(out + off); rr[mm][bj][n] = *(const f32x4*)(R + off); }
#pragma unroll
                for (int mm = 0; mm < 2; ++mm) {
                    const int m = 2 * mp + mm, row = row0 + ai * 128 + m * 16;
                    const float rs = rsqrtf(ssv[ai * 4 + m] * (1.f / D) + EPS);
#pragma unroll
                    for (int bj = 0; bj < 2; ++bj)
#pragma unroll
                        for (int n = 0; n < 2; ++n) {
                            const size_t off = (size_t)row * D + col0 + bj * 128 + n * 16;
                            f32x4 v;
#pragma unroll
                            for (int j = 0; j < 4; ++j) v[j] = bb[mm][bj][n][j] + sigmoidf_(acc[ai][bj][m][n][j] * rs) * rr[mm][bj][n][j];
                            *(f32x4*)(out + off) = v;
                        }
                }
            }
    }
};

struct Params {
    const float *x, *p, *ffn1_norm, *ffn1_w_gu, *ffn1_w_down, *mix_norm, *w_in, *conv_w, *a_log, *dt_bias, *gdn_norm, *q_norm, *k_norm, *rel_bias,
                *w_a, *w_b, *w_out, *ffn2_norm, *ffn2_w_gu, *ffn2_w_down, *ple_norm, *ple_gate, *ple_proj;
    float* out; unsigned char* ws; int ph_lo, ph_hi;
};

template <int MAP> __device__ __forceinline__ int src_col(int n) {
    if (MAP == 1) return ((n >> 7) & 1) * FF + (n >> 8) * 128 + (n & 127);
    if (MAP == 2) return n < 4096 ? n : (n < 11264 ? n + 16 : (n < 11280 ? n - 11264 + 4096 : -1));
    return n;
}
template <int MAP> __device__ __forceinline__ void transpose_item(const float* W, const float* nw, int K, int Nsrc, int Nd, bf16_t* WT, LAS float* scr, int item, int lane) {
    const int nblk = Nd / 64, kb = item / nblk, nb = item % nblk, k0 = 64 * kb, n0 = 64 * nb;
    const int r = lane >> 4, c4 = lane & 15;
    const int sc = src_col<MAP>(n0 + 4 * c4);
    f32x4 v[16];
#pragma unroll
    for (int i = 0; i < 16; ++i) v[i] = sc >= 0 ? __builtin_nontemporal_load((const f32x4*)(W + (size_t)(k0 + 4 * i + r) * Nsrc + sc)) : (f32x4){0.f, 0.f, 0.f, 0.f};
    if (nw) {
#pragma unroll
        for (int i = 0; i < 16; ++i) v[i] = v[i] * nw[k0 + 4 * i + r];
    }
#pragma unroll
    for (int i = 0; i < 16; ++i) { LAS float* p = scr + (4 * i + r) * 65 + 4 * c4; p[0] = v[i][0]; p[1] = v[i][1]; p[2] = v[i][2]; p[3] = v[i][3]; }
    asm volatile("s_waitcnt lgkmcnt(0)" ::: "memory"); __builtin_amdgcn_wave_barrier();
    const int ns = lane >> 3, kc = lane & 7;
#pragma unroll
    for (int j = 0; j < 8; ++j) { const LAS float* sp = scr + (8 * kc) * 65 + 8 * j + ns;
        u32x4 o; o.x = pk2(sp[0 * 65], sp[1 * 65]); o.y = pk2(sp[2 * 65], sp[3 * 65]); o.z = pk2(sp[4 * 65], sp[5 * 65]); o.w = pk2(sp[6 * 65], sp[7 * 65]);
        *(u32x4*)(WT + (size_t)(n0 + 8 * j + ns) * K + k0 + 8 * kc) = o; }
    asm volatile("s_waitcnt lgkmcnt(0)" ::: "memory"); __builtin_amdgcn_wave_barrier();
}
constexpr int I_GU = (D / 64) * (NGU / 64), I_DN = (FF / 64) * (D / 64), I_IN = (D / 64) * (NIN / 64), I_AB = (1024 / 64) * (D / 64), I_SQ = (D / 64) * (D / 64), I_PP = (PLE / 64) * (D / 64);
constexpr int N_EARLY = I_GU + I_DN + I_IN, N_LATE = I_GU + I_DN + 2 * I_AB + 2 * I_SQ + I_PP;
__device__ __forceinline__ void convert_early(const Params& P, LAS float* scr, int gw, int NGW, int lane, bool with_d1) {
    unsigned char* ws = P.ws;
    for (int it = gw; it < I_GU + I_IN + (with_d1 ? I_DN : 0); it += NGW) {
        int r = it;
        if (r < I_GU) { transpose_item<1>(P.ffn1_w_gu, P.ffn1_norm, D, NGU, NGU, (bf16_t*)(ws + WS_WGU1), scr, r, lane); continue; } r -= I_GU;
        if (r < I_IN) { transpose_item<2>(P.w_in, P.mix_norm, D, NINSRC, NIN, (bf16_t*)(ws + WS_WIN), scr, r, lane); continue; } r -= I_IN;
        transpose_item<0>(P.ffn1_w_down, nullptr, FF, D, D, (bf16_t*)(ws + WS_WD1), scr, r, lane);
    }
}
__device__ __forceinline__ void convert_d1(const Params& P, LAS float* scr, int gw, int NGW, int lane) {
    for (int it = gw; it < I_DN; it += NGW) transpose_item<0>(P.ffn1_w_down, nullptr, FF, D, D, (bf16_t*)(P.ws + WS_WD1), scr, it, lane);
}
__device__ __forceinline__ void convert_late(const Params& P, LAS float* scr, int lo_it, int hi_it, int gw, int NGW, int lane) {
    unsigned char* ws = P.ws;
    for (int it = lo_it + gw; it < hi_it; it += NGW) {
        int r = it;
        if (r < I_AB) { transpose_item<0>(P.w_a, nullptr, 1024, D, D, (bf16_t*)(ws + WS_WA), scr, r, lane); continue; } r -= I_AB;
        if (r < I_AB) { transpose_item<0>(P.w_b, nullptr, 1024, D, D, (bf16_t*)(ws + WS_WB), scr, r, lane); continue; } r -= I_AB;
        if (r < I_SQ) { transpose_item<0>(P.w_out, nullptr, D, D, D, (bf16_t*)(ws + WS_WOUT), scr, r, lane); continue; } r -= I_SQ;
        if (r < I_GU) { transpose_item<1>(P.ffn2_w_gu, P.ffn2_norm, D, NGU, NGU, (bf16_t*)(ws + WS_WGU2), scr, r, lane); continue; } r -= I_GU;
        if (r < I_DN) { transpose_item<0>(P.ffn2_w_down, nullptr, FF, D, D, (bf16_t*)(ws + WS_WD2), scr, r, lane); continue; } r -= I_DN;
        if (r < I_SQ) { transpose_item<0>(P.ple_gate, P.ple_norm, D, D, D, (bf16_t*)(ws + WS_WPG), scr, r, lane); continue; } r -= I_SQ;
        transpose_item<0>(P.ple_proj, nullptr, PLE, D, D, (bf16_t*)(ws + WS_WPP), scr, r, lane);
    }
}
constexpr int LATE_A = 2800, LATE_C = 2 * I_AB + I_SQ + I_GU;
__device__ __forceinline__ void idle_convert(const Params& P, LAS unsigned char* lds, int nwg, int G, int lo_it, int hi_it) {
    const int extra = nwg % G, c = blockIdx.x;
    if (extra == 0 || c < extra) return;
    const int tid = opaque_tid(), wave = tid >> 6;
    if (lo_it < 0) convert_d1(P, (LAS float*)(lds + wave * 17408), (c - extra) * 8 + wave, (G - extra) * 8, tid & 63);
    else convert_late(P, (LAS float*)(lds + wave * 17408), lo_it, hi_it, (c - extra) * 8 + wave, (G - extra) * 8, tid & 63);
}
__device__ __forceinline__ void phase_convert(const Params& P, LAS unsigned char* lds, int G) {
    const int tid = opaque_tid(), lane = tid & 63, wave = tid >> 6;
    LAS float* scr = (LAS float*)(lds + wave * 17408);
    const int gw = blockIdx.x * 8 + wave, NGW = G * 8;
    unsigned char* ws = P.ws;
    convert_early(P, scr, gw, NGW, lane, (((M / 256) * (NGU / 256)) % G) == 0);
    float* ss = (float*)(ws + WS_SS);
    bf16_t* xb = (bf16_t*)(ws + WS_XB); bf16_t* pb = (bf16_t*)(ws + WS_PB);
    for (int m = gw; m < M; m += NGW) {
        const f32x4* xr = (const f32x4*)(P.x + (size_t)m * D) + lane; u32x2* o8 = (u32x2*)(xb + (size_t)m * D) + lane; float s = 0.f;
        f32x4 xv[8];
#pragma unroll
        for (int j = 0; j < 8; ++j) xv[j] = __builtin_nontemporal_load(xr + 64 * j);
#pragma unroll
        for (int j = 0; j < 8; ++j) { const f32x4 v = xv[j]; s += (v[0] * v[0] + v[1] * v[1]) + (v[2] * v[2] + v[3] * v[3]); u32x2 w; w.x = pk2(v[0], v[1]); w.y = pk2(v[2], v[3]); o8[64 * j] = w; }
        s = wave_sum(s); if (lane == 0) ss[m] = s;
        const f32x4 pv = *((const f32x4*)(P.p + (size_t)m * PLE) + lane); u32x2 w; w.x = pk2(pv[0], pv[1]); w.y = pk2(pv[2], pv[3]); *((u32x2*)(pb + (size_t)m * PLE) + lane) = w;
    }
    for (int i = blockIdx.x * 512 + tid; i < 3 * M; i += G * 512) ss[M + i] = 0.f;
    if (blockIdx.x == 0 && tid < 8) ((unsigned*)(ws + WS_PROG))[tid * 32] = 0u;
}

constexpr int L_LM = 0, L_GC = L_LM + 64 * 68 * 4, L_R = L_GC + 512, L_KBF = L_R + 65536, L_QBF = L_KBF + 64 * 136 * 2, L_VST = L_QBF + 64 * 136 * 2, L_END4 = L_VST + 64 * 136 * 2;
static_assert(L_END4 <= LDS_BYTES, "lds");
__device__ __forceinline__ void prep_item(const Params& P, LAS unsigned char* lds, int item, const int pflags) {
    const int tid = opaque_tid(), lane = tid & 63, wave = tid >> 6;
    const int n = item >> 3, h = item & 7;
    unsigned char* ws = P.ws;
    bf16_t* proj = (bf16_t*)(ws + WS_PROJ);
    LAS float* Rr = (LAS float*)(lds + L_R); LAS float* Lm = (LAS float*)(lds + L_LM);
    LAS bf16_t* kbf = (LAS bf16_t*)(lds + L_KBF); LAS bf16_t* qbf = (LAS bf16_t*)(lds + L_QBF); LAS bf16_t* vst = (LAS bf16_t*)(lds + L_VST);
    LAS float* gcs = (LAS float*)(lds + L_GC);
    if (wave == 0) {
        const size_t row = (size_t)n * 64 + lane;
        const float a = bf2f(proj[row * NIN + C_AR + h]), b = bf2f(proj[row * NIN + C_BR + h]);
        const float xx = a + P.dt_bias[h];
        const float sp = xx > 20.f ? xx : log1pf(expf(xx));
        float g = -expf(P.a_log[h]) * sp;
#pragma unroll
        for (int o = 1; o < 64; o <<= 1) { const float t = __shfl_up(g, o); if (lane >= o) g += t; }
        gcs[lane] = g; gcs[64 + lane] = 1.f / (1.f + expf(-b));
    }
    const int l16 = tid & 15, rg = tid >> 4;
    float qv[2][8], kv[2][8], vv[2][8];
#pragma unroll
    for (int X = 0; X < 3; ++X) {
        const int col = (X == 0 ? C_QA : (X == 1 ? C_KA : C_VA)) + h * DH + 8 * l16;
        const int ccol = X * 1024 + h * DH + 8 * l16;
        float xin[5][8];
#pragma unroll
        for (int i = 0; i < 5; ++i) { const int gr = n * 64 + 2 * rg - 3 + i;
            if (gr >= 0) unpack8(__builtin_nontemporal_load((const u32x4*)(proj + (size_t)gr * NIN + col)), xin[i]);
            else {
#pragma unroll
                for (int e = 0; e < 8; ++e) xin[i][e] = 0.f; } }
        float y[2][8];
#pragma unroll
        for (int r = 0; r < 2; ++r)
#pragma unroll
            for (int e = 0; e < 8; ++e) y[r][e] = 0.f;
#pragma unroll
        for (int j = 0; j < 4; ++j) {
            const f32x4 c0 = *(const f32x4*)(P.conv_w + j * 3072 + ccol), c1 = *(const f32x4*)(P.conv_w + j * 3072 + ccol + 4);
#pragma unroll
            for (int r = 0; r < 2; ++r)
#pragma unroll
                for (int e = 0; e < 8; ++e) y[r][e] += (e < 4 ? c0[e] : c1[e - 4]) * xin[r + j][e];
        }
#pragma unroll
        for (int r = 0; r < 2; ++r) {
            float sq = 0.f;
#pragma unroll
            for (int e = 0; e < 8; ++e) { y[r][e] = siluf_(y[r][e]); sq += y[r][e] * y[r][e]; }
            if (X < 2) {
                sq += __shfl_xor(sq, 1); sq += __shfl_xor(sq, 2); sq += __shfl_xor(sq, 4); sq += __shfl_xor(sq, 8);
                const float rn = rsqrtf(sq + EPS) * (X == 0 ? 0.08838834764831845f : 1.f);
#pragma unroll
                for (int e = 0; e < 8; ++e) y[r][e] *= rn;
            }
#pragma unroll
            for (int e = 0; e < 8; ++e) { if (X == 0) qv[r][e] = y[r][e]; else if (X == 1) kv[r][e] = y[r][e]; else vv[r][e] = y[r][e]; }
        }
    }
#pragma unroll
    for (int r = 0; r < 2; ++r) {
        const size_t grow = (size_t)n * 64 + 2 * rg + r;
#pragma unroll
        for (int X = 0; X < 2; ++X) {
            bf16_t* ptr = proj + grow * NIN + (X == 0 ? C_QB : C_KB) + h * DH + 8 * l16;
            float f[8]; unpack8(__builtin_nontemporal_load((const u32x4*)ptr), f);
            float sq = 0.f;
#pragma unroll
            for (int e = 0; e < 8; ++e) sq += f[e] * f[e];
            sq += __shfl_xor(sq, 1); sq += __shfl_xor(sq, 2); sq += __shfl_xor(sq, 4); sq += __shfl_xor(sq, 8);
            const float rn = rsqrtf(sq * (1.f / DH) + EPS);
            const float* nwp = (X == 0 ? P.q_norm : P.k_norm) + 8 * l16;
            const f32x4 w0 = *(const f32x4*)nwp, w1 = *(const f32x4*)(nwp + 4);
#pragma unroll
            for (int e = 0; e < 8; ++e) f[e] = f[e] * rn * (e < 4 ? w0[e] : w1[e - 4]);
            *(u32x4*)ptr = pack8f(f);
        }
        const u32x4 vraw = __builtin_nontemporal_load((const u32x4*)(proj + grow * NIN + C_VB + h * DH + 8 * l16));
        *(LAS u32x4*)(vst + (2 * rg + r) * 136 + 8 * l16) = vraw;
    }
    __syncthreads();
    {
        bf16_t* qd = (bf16_t*)(ws + WS_QD) + (size_t)item * 64 * 128;
        bf16_t* ktT = (bf16_t*)(ws + WS_KTT) + (size_t)item * 128 * 64;
        const float gl = gcs[63];
        float ktl[2][8];
#pragma unroll
        for (int r = 0; r < 2; ++r) {
            const int t = 2 * rg + r; const float gc = gcs[t], bt = gcs[64 + t];
            const float eg = __expf(gc), egl = __expf(gl - gc);
            float f[8];
#pragma unroll
            for (int e = 0; e < 8; ++e) f[e] = qv[r][e] * eg;
            *(u32x4*)(qd + ((((t >> 4) * 4 + (l16 >> 2)) * 64) + (l16 & 3) * 16 + (t & 15)) * 8) = pack8f(f);
#pragma unroll
            for (int e = 0; e < 8; ++e) ktl[r][e] = kv[r][e] * egl;
            *(LAS u32x4*)(qbf + t * 136 + 8 * l16) = pack8f(qv[r]);
            *(LAS u32x4*)(kbf + t * 136 + 8 * l16) = pack8f(kv[r]);
            LAS float* rr = Rr + t * 256 + 8 * l16;
            *(LAS f32x4*)(rr) = (f32x4){vv[r][0] * bt, vv[r][1] * bt, vv[r][2] * bt, vv[r][3] * bt};
            *(LAS f32x4*)(rr + 4) = (f32x4){vv[r][4] * bt, vv[r][5] * bt, vv[r][6] * bt, vv[r][7] * bt};
            const float be = bt * eg;
            *(LAS f32x4*)(rr + 128) = (f32x4){kv[r][0] * be, kv[r][1] * be, kv[r][2] * be, kv[r][3] * be};
            *(LAS f32x4*)(rr + 132) = (f32x4){kv[r][4] * be, kv[r][5] * be, kv[r][6] * be, kv[r][7] * be};
        }
#pragma unroll
        for (int e = 0; e < 8; ++e) { const int t0 = 2 * rg; *(unsigned*)(ktT + (((((l16 >> 1) * 2 + (t0 >> 5)) * 64) + ((t0 >> 3) & 3) * 16 + 8 * (l16 & 1) + e) * 8 + (t0 & 7))) = pk2(ktl[0][e], ktl[1][e]); }
        if (tid == 0) ((float*)(ws + WS_TAIL))[item] = __expf(gl);
        bf16_t* vt = (bf16_t*)(ws + WS_VT);
        const int d = tid & 127, tg = tid >> 7;
        unsigned pw[8];
#pragma unroll
        for (int i = 0; i < 8; ++i) { const unsigned lo = vst[(16 * tg + 2 * i) * 136 + d], hi = vst[(16 * tg + 2 * i + 1) * 136 + d]; pw[i] = lo | (hi << 16); }
        bf16_t* dst = vt + (size_t)(h * DH + d) * M + n * 64 + 16 * tg;
        *(u32x4*)dst = (u32x4){pw[0], pw[1], pw[2], pw[3]}; *(u32x4*)(dst + 8) = (u32x4){pw[4], pw[5], pw[6], pw[7]};
    }
    __syncthreads();
    {
        const int fr = lane & 15, fq = lane >> 4, which = wave >> 2, ti = wave & 3;
        LAS bf16_t* X = which ? qbf : kbf;
        bf16x8 a[4];
#pragma unroll
        for (int s = 0; s < 4; ++s) a[s] = *(const LAS bf16x8*)(X + (16 * ti + fr) * 136 + 32 * s + 8 * fq);
        bf16_t* aqk = (bf16_t*)(ws + WS_AQK) + (size_t)item * 64 * 64;
        for (int tj = 0; tj < 4; ++tj) {
            f32x4 c = {0.f, 0.f, 0.f, 0.f};
            if (tj <= ti) {
#pragma unroll
                for (int s = 0; s < 4; ++s) { const bf16x8 b = *(const LAS bf16x8*)(kbf + (16 * tj + fr) * 136 + 32 * s + 8 * fq); c = MFMA16(a[s], b, c); }
            }
            const int j = 16 * tj + fr; const float gj = gcs[j];
#pragma unroll
            for (int r = 0; r < 4; ++r) {
                const int i = 16 * ti + 4 * fq + r;
                const float dec = (i >= j) ? __expf(gcs[i] - gj) : 0.f;
                if (which == 0) { Lm[i * 68 + j] = (i > j) ? gcs[64 + i] * c[r] * dec : 0.f; }
                else { const float v = (i >= j) ? c[r] * dec : 0.f; aqk[((((i >> 4) * 2 + (j >> 5)) * 64) + ((j >> 3) & 3) * 16 + (i & 15)) * 8 + (j & 7)] = (bf16_t)(pk2(v, 0.f) & 0xffffu); }
            }
        }
    }
    __syncthreads();
    if (tid < 256) {
        int Lrow[64];
#pragma unroll
        for (int i = 0; i < 64; ++i) Lrow[i] = __float_as_int(Lm[i * 68 + lane]);
        float s[64];
#define LRD(i, j) __int_as_float(__builtin_amdgcn_readlane(Lrow[i], j))
#pragma unroll
        for (int g = 0; g < 16; ++g) {
            const int i0 = 4 * g;
            float a0 = Rr[(i0 + 0) * 256 + tid], a1 = Rr[(i0 + 1) * 256 + tid], a2 = Rr[(i0 + 2) * 256 + tid], a3 = Rr[(i0 + 3) * 256 + tid];
            if (!(pflags & 8)) {
#pragma unroll
            for (int j = 0; j < i0; ++j) { const float sj = s[j]; a0 -= LRD(i0, j) * sj; a1 -= LRD(i0 + 1, j) * sj; a2 -= LRD(i0 + 2, j) * sj; a3 -= LRD(i0 + 3, j) * sj; }
            a1 -= LRD(i0 + 1, i0) * a0;
            a2 -= LRD(i0 + 2, i0) * a0; a2 -= LRD(i0 + 2, i0 + 1) * a1;
            a3 -= LRD(i0 + 3, i0) * a0; a3 -= LRD(i0 + 3, i0 + 1) * a1; a3 -= LRD(i0 + 3, i0 + 2) * a2;
            }
            s[i0] = a0; s[i0 + 1] = a1; s[i0 + 2] = a2; s[i0 + 3] = a3;
        }
#undef LRD
        if (pflags & 32) { if (s[63] == 1.2345f) ((float*)(ws + WS_U))[tid] = s[5]; } else
        if (tid < 128) { float* u = (float*)(ws + WS_U) + (size_t)item * 64 * 128 + ((tid >> 4) * 256 + (tid & 15)) * 4;
#pragma unroll
            for (int i4 = 0; i4 < 16; ++i4) *(f32x4*)(u + ((i4 >> 2) * 64 + (i4 & 3) * 16) * 4) = (f32x4){s[4 * i4], s[4 * i4 + 1], s[4 * i4 + 2], s[4 * i4 + 3]}; }
        else { const int dk = tid - 128; bf16_t* w = (bf16_t*)(ws + WS_W) + (size_t)item * 64 * 128 + (((dk >> 5) * 64) + ((dk >> 3) & 3) * 16) * 8 + (dk & 7);
#pragma unroll
            for (int i = 0; i < 64; ++i) w[((i >> 4) * 256 + (i & 15)) * 8] = (bf16_t)(pk2(s[i], 0.f) & 0xffffu); }
    }
    __syncthreads();
}

struct ScanA { bf16x8 W[4], K0[2], K1[2]; f32x4 u; float tl; };
struct ScanB { bf16x8 Q[4], A[2]; };
struct ScanOff { unsigned w, aq, kt, u; };
__device__ __forceinline__ void scan_loadA(ScanA& o, const unsigned char* ws, int c, int h, const ScanOff& f) {
    const int item = c * 8 + h;
    const unsigned char* w = ws + WS_W + (size_t)item * 16384; const unsigned char* kt = ws + WS_KTT + (size_t)item * 16384; const unsigned char* u = ws + WS_U + (size_t)item * 32768;
#pragma unroll
    for (int s = 0; s < 4; ++s) o.W[s] = __builtin_bit_cast(bf16x8, *(const u32x4*)(w + f.w + 1024 * s));
#pragma unroll
    for (int s = 0; s < 2; ++s) { o.K0[s] = __builtin_bit_cast(bf16x8, *(const u32x4*)(kt + f.kt + 1024 * s)); o.K1[s] = __builtin_bit_cast(bf16x8, *(const u32x4*)(kt + f.kt + 2048 + 1024 * s)); }
    o.u = *(const f32x4*)(u + f.u);
    o.tl = ((const float*)(ws + WS_TAIL))[item];
}
__device__ __forceinline__ void scan_loadB(ScanB& o, const unsigned char* ws, int c, int h, const ScanOff& f) {
    const int item = c * 8 + h;
    const unsigned char* qd = ws + WS_QD + (size_t)item * 16384; const unsigned char* aq = ws + WS_AQK + (size_t)item * 8192;
#pragma unroll
    for (int s = 0; s < 4; ++s) o.Q[s] = __builtin_bit_cast(bf16x8, *(const u32x4*)(qd + f.w + 1024 * s));
#pragma unroll
    for (int s = 0; s < 2; ++s) o.A[s] = __builtin_bit_cast(bf16x8, *(const u32x4*)(aq + f.aq + 1024 * s));
}
__device__ __forceinline__ void scan_stepA(const ScanA& cur, f32x4& S0, f32x4& S1, LAS bf16_t* Sl, LAS bf16_t* Vl, int fr, int fq, int mt) {
    f32x4 wsv = {0.f, 0.f, 0.f, 0.f};
#pragma unroll
    for (int s = 0; s < 4; ++s) wsv = MFMA16(cur.W[s], *(const LAS bf16x8*)(Sl + fr * 136 + 32 * s + 8 * fq), wsv);
    const f32x4 vn = cur.u - wsv;
    { u32x2 pv; pv.x = pk2(vn[0], vn[1]); pv.y = pk2(vn[2], vn[3]); *(LAS u32x2*)(Vl + fr * 72 + 16 * mt + 4 * fq) = pv; }
    __syncthreads();
    S0 = S0 * cur.tl; S1 = S1 * cur.tl;
#pragma unroll
    for (int s = 0; s < 2; ++s) { const bf16x8 Vb = *(const LAS bf16x8*)(Vl + fr * 72 + 32 * s + 8 * fq); S0 = MFMA16(cur.K0[s], Vb, S0); S1 = MFMA16(cur.K1[s], Vb, S1); }
    { u32x2 p0, p1; p0.x = pk2(S0[0], S0[1]); p0.y = pk2(S0[2], S0[3]); p1.x = pk2(S1[0], S1[1]); p1.y = pk2(S1[2], S1[3]);
      *(LAS u32x2*)(Sl + fr * 136 + 32 * mt + 4 * fq) = p0; *(LAS u32x2*)(Sl + fr * 136 + 32 * mt + 16 + 4 * fq) = p1; }
    __syncthreads();
}
__device__ __forceinline__ void scan_stepB(const ScanB& cur, const LAS bf16_t* Sl, const LAS bf16_t* Vl, bf16_t* og, int fr, int fq) {
    f32x4 qs = {0.f, 0.f, 0.f, 0.f};
#pragma unroll
    for (int s = 0; s < 4; ++s) qs = MFMA16(*(const LAS bf16x8*)(Sl + fr * 136 + 32 * s + 8 * fq), cur.Q[s], qs);
    __syncthreads();
#pragma unroll
    for (int s = 0; s < 2; ++s) qs = MFMA16(*(const LAS bf16x8*)(Vl + fr * 72 + 32 * s + 8 * fq), cur.A[s], qs);
    { u32x2 w; w.x = pk2(qs[0], qs[1]); w.y = pk2(qs[2], qs[3]); *(u32x2*)og = w; }
    __syncthreads();
}
__device__ __forceinline__ void scan_wg(const Params& P, LAS unsigned char* lds, int h, int pair, const int VAR) {
    const int tid = opaque_tid(), lane = tid & 63, wave = tid >> 6, fr = lane & 15, fq = lane >> 4, mt = wave & 3, e0 = 16 * pair;
    const unsigned char* ws = P.ws;
    LAS bf16_t* Sl = (LAS bf16_t*)(lds);
    LAS bf16_t* Vl = (LAS bf16_t*)(lds + 4352);
    for (int i = tid; i < 4352 / 4; i += 512) ((LAS unsigned*)Sl)[i] = 0u;
    ScanOff f; f.w = (unsigned)(mt * 4096 + lane * 16); f.aq = (unsigned)(mt * 2048 + lane * 16); f.kt = (unsigned)(mt * 4096 + lane * 16); f.u = (unsigned)((((e0 >> 4) * 4 + mt) * 64 + lane) * 16);
    if (wave < 4) {
        f32x4 S0 = {0.f, 0.f, 0.f, 0.f}, S1 = {0.f, 0.f, 0.f, 0.f};
        ScanA a, b, c3; scan_loadA(a, ws, 0, h, f); scan_loadA(b, ws, 1, h, f);
        __syncthreads();
#pragma unroll 1
        for (int c = 0; c < NCH - 2; c += 3) {
            if (VAR != 3) scan_loadA(c3, ws, c + 2, h, f); scan_stepA(a, S0, S1, Sl, Vl, fr, fq, mt);
            if (VAR != 3) scan_loadA(a, ws, c + 3, h, f); scan_stepA(b, S0, S1, Sl, Vl, fr, fq, mt);
            if (VAR != 3) scan_loadA(b, ws, c + 4, h, f); scan_stepA(VAR == 3 ? a : c3, S0, S1, Sl, Vl, fr, fq, mt);
        }
        scan_stepA(a, S0, S1, Sl, Vl, fr, fq, mt); scan_stepA(b, S0, S1, Sl, Vl, fr, fq, mt);
    } else {
        bf16_t* Og = (bf16_t*)(P.ws + (VAR ? WS_END : WS_YA)) + (size_t)(16 * mt + fr) * 1024 + h * DH + e0 + 4 * fq;
        ScanB a, b, c3; scan_loadB(a, ws, 0, h, f); scan_loadB(b, ws, 1, h, f);
        __syncthreads();
#pragma unroll 1
        for (int c = 0; c < NCH - 2; c += 3) {
            if (VAR != 3) scan_loadB(c3, ws, c + 2, h, f); scan_stepB(a, Sl, Vl, Og + (size_t)c * 65536, fr, fq);
            if (VAR != 3) scan_loadB(a, ws, c + 3, h, f); scan_stepB(b, Sl, Vl, Og + (size_t)(c + 1) * 65536, fr, fq);
            if (VAR != 3) scan_loadB(b, ws, c + 4, h, f); scan_stepB(VAR == 3 ? a : c3, Sl, Vl, Og + (size_t)(c + 2) * 65536, fr, fq);
        }
        scan_stepB(a, Sl, Vl, Og + (size_t)(NCH - 2) * 65536, fr, fq); scan_stepB(b, Sl, Vl, Og + (size_t)(NCH - 1) * 65536, fr, fq);
    }
}

__device__ __forceinline__ void scan_helper(const Params& P, int h, int j, int NHp) {
    const int tid = threadIdx.x;
    const unsigned char* ws = P.ws;
    unsigned* prog = (unsigned*)(P.ws + WS_PROG) + h * 32;
    for (int c = j; c < NCH; c += NHp) {
        for (;;) { const unsigned pr = __hip_atomic_load(prog, __ATOMIC_RELAXED, __HIP_MEMORY_SCOPE_AGENT); if ((int)pr + 16 >= c) break; __builtin_amdgcn_s_sleep(16); }
        const int item = c * 8 + h;
        const u32x4* w16 = (const u32x4*)(ws + WS_W + (size_t)item * 16384); const u32x4* q16 = (const u32x4*)(ws + WS_QD + (size_t)item * 16384);
        const u32x4* k16 = (const u32x4*)(ws + WS_KTT + (size_t)item * 16384); const u32x4* a16 = (const u32x4*)(ws + WS_AQK + (size_t)item * 8192);
        const u32x4* u16 = (const u32x4*)(ws + WS_U + (size_t)item * 32768);
        u32x4 v[11];
        v[0] = w16[tid]; v[1] = w16[512 + tid]; v[2] = q16[tid]; v[3] = q16[512 + tid]; v[4] = k16[tid]; v[5] = k16[512 + tid]; v[6] = a16[tid];
        v[7] = u16[tid]; v[8] = u16[512 + tid]; v[9] = u16[1024 + tid]; v[10] = u16[1536 + tid];
#pragma unroll
        for (int i = 0; i < 11; ++i) asm volatile("" :: "v"(v[i]));
    }
}

constexpr int AL_K = 0, AL_V = 2 * 64 * 272, AL_B = AL_V + 2 * 128 * 144;
__device__ __forceinline__ void attn_compute(const LAS unsigned char* Kl, const LAS unsigned char* Vl, const LAS float* biasl, const bf16x8 (&Qb)[4], f32x4 (&Ot)[8], float& mrun, float& lrun,
                                             int c, int qi, int fr, int fq) {
    const float scale = 0.08838834764831845f;
    f32x4 st[4]; float mx = -1e30f;
#pragma unroll
    for (int kt = 0; kt < 4; ++kt) {
        f32x4 a = {0.f, 0.f, 0.f, 0.f};
#pragma unroll
        for (int s = 0; s < 4; ++s) a = MFMA16(*(const LAS bf16x8*)(Kl + (16 * kt + fr) * 272 + 64 * s + 16 * fq), Qb[s], a);
#pragma unroll
        for (int r = 0; r < 4; ++r) {
            const int ki = c * 64 + 16 * kt + 4 * fq + r; int dd = qi - ki; dd = dd < -63 ? -63 : (dd > 128 ? 128 : dd);
            a[r] = a[r] * scale + biasl[dd + 63]; mx = fmaxf(mx, a[r]);
        }
        st[kt] = a;
    }
    mx = fmaxf(mx, __shfl_xor(mx, 16)); mx = fmaxf(mx, __shfl_xor(mx, 32));
    const float mnew = fmaxf(mrun, mx), alpha = __expf(mrun - mnew); mrun = mnew;
    float rsum = 0.f;
#pragma unroll
    for (int kt = 0; kt < 4; ++kt)
#pragma unroll
        for (int r = 0; r < 4; ++r) { const float p = __expf(st[kt][r] - mnew); st[kt][r] = p; rsum += p; }
    lrun = lrun * alpha + rsum;
    bf16x8 Pb[2];
#pragma unroll
    for (int s = 0; s < 2; ++s) Pb[s] = pack_acc(st[2 * s], st[2 * s + 1]);
#pragma unroll
    for (int dt = 0; dt < 8; ++dt) {
        f32x4 o = Ot[dt] * alpha;
#pragma unroll
        for (int s = 0; s < 2; ++s) { const LAS unsigned char* pv = Vl + (16 * dt + fr) * 144 + 64 * s + 8 * fq;
            const u32x2 lo = *(const LAS u32x2*)pv, hi = *(const LAS u32x2*)(pv + 32); u32x4 av; av.x = lo.x; av.y = lo.y; av.z = hi.x; av.w = hi.y;
            o = MFMA16(__builtin_bit_cast(bf16x8, av), Pb[s], o); }
        Ot[dt] = o;
    }
}
__device__ __forceinline__ void attn_item(const Params& P, LAS unsigned char* lds, int m, int h) {
    const int tid = opaque_tid(), lane = tid & 63, wave = tid >> 6, fr = lane & 15, fq = lane >> 4;
    unsigned char* ws = P.ws;
    const bf16_t* proj = (const bf16_t*)(ws + WS_PROJ); const bf16_t* vt = (const bf16_t*)(ws + WS_VT); bf16_t* yb = (bf16_t*)(ws + WS_YB);
    LAS float* biasl = (LAS float*)(lds + AL_B);
    const int nq = 2 * m + (wave >> 2), w4 = wave & 3;
    const int qi = nq * 64 + 16 * w4 + fr;
    const int cbeg = 2 * m - 8 < 0 ? 0 : 2 * m - 8, cend = 2 * m + 1;
    const bf16_t* kg[2]; const bf16_t* vg[2]; int kl[2], vl[2];
#pragma unroll
    for (int i = 0; i < 2; ++i) { const int p = tid + 512 * i;
        kg[i] = proj + (size_t)(p >> 4) * NIN + C_KB + h * DH + 8 * (p & 15); kl[i] = (p >> 4) * 272 + 16 * (p & 15);
        vg[i] = vt + (size_t)(h * DH + (p >> 3)) * M + 8 * (p & 7); vl[i] = (p >> 3) * 144 + 16 * (p & 7); }
#define ATT_LOAD(KR, VR, C) do { _Pragma("unroll") for (int i = 0; i < 2; ++i) { KR[i] = *(const u32x4*)(kg[i] + (size_t)(C) * 64 * NIN); VR[i] = *(const u32x4*)(vg[i] + (C) * 64); } } while (0)
#define ATT_WRITE(KR, VR, BUF) do { _Pragma("unroll") for (int i = 0; i < 2; ++i) { *(LAS u32x4*)(lds + AL_K + (BUF) * (64 * 272) + kl[i]) = KR[i]; *(LAS u32x4*)(lds + AL_V + (BUF) * (128 * 144) + vl[i]) = VR[i]; } } while (0)
    u32x4 kA[2], vA[2], kB[2], vB[2];
    ATT_LOAD(kA, vA, cbeg);
    ATT_LOAD(kB, vB, cbeg + 1);
    if (tid < 192) biasl[tid] = P.rel_bias[h * 192 + tid];
    bf16x8 Qb[4];
#pragma unroll
    for (int s = 0; s < 4; ++s) Qb[s] = ld8(proj + (size_t)qi * NIN + C_QB + h * DH + 32 * s + 8 * fq);
    ATT_WRITE(kA, vA, 0);
    __syncthreads();
    float mrun = -1e30f, lrun = 0.f;
    f32x4 Ot[8];
#pragma unroll
    for (int i = 0; i < 8; ++i) Ot[i] = (f32x4){0.f, 0.f, 0.f, 0.f};
#pragma unroll 1
    for (int c = cbeg; c <= cend; c += 2) {
        if (c + 2 <= cend) ATT_LOAD(kA, vA, c + 2);
        if (c >= nq - 8 && c <= nq) attn_compute(lds + AL_K, lds + AL_V, biasl, Qb, Ot, mrun, lrun, c, qi, fr, fq);
        if (c + 1 <= cend) ATT_WRITE(kB, vB, 1);
        __syncthreads();
        if (c + 1 > cend) break;
        if (c + 3 <= cend) ATT_LOAD(kB, vB, c + 3);
        if (c + 1 >= nq - 8 && c + 1 <= nq) attn_compute(lds + AL_K + 64 * 272, lds + AL_V + 128 * 144, biasl, Qb, Ot, mrun, lrun, c + 1, qi, fr, fq);
        if (c + 2 <= cend) ATT_WRITE(kA, vA, 0);
        __syncthreads();
    }
#undef ATT_LOAD
#undef ATT_WRITE
    lrun += __shfl_xor(lrun, 16); lrun += __shfl_xor(lrun, 32);
    const float inv = 1.f / lrun;
#pragma unroll
    for (int dt = 0; dt < 8; ++dt) { u32x2 w; w.x = pk2(Ot[dt][0] * inv, Ot[dt][1] * inv); w.y = pk2(Ot[dt][2] * inv, Ot[dt][3] * inv);
        *(u32x2*)(yb + (size_t)qi * 1024 + h * DH + 16 * dt + 4 * fq) = w; }
}

__device__ __forceinline__ void phase_gnorm(const Params& P, int G) {
    unsigned char* ws = P.ws;
    bf16_t* ya = (bf16_t*)(ws + WS_YA); const bf16_t* proj = (const bf16_t*)(ws + WS_PROJ);
    const int gt = blockIdx.x * 512 + opaque_tid(), l16 = gt & 15;
    const f32x4 w0 = *(const f32x4*)(P.gdn_norm + 8 * l16), w1 = *(const f32x4*)(P.gdn_norm + 8 * l16 + 4);
    const int stride = (G * 512) >> 4;
    for (int g0 = gt >> 4; g0 < M * NH; g0 += 4 * stride) {
        u32x4 ro[4], rz[4]; bf16_t* po[4];
#pragma unroll
        for (int q = 0; q < 4; ++q) { const int g = g0 + q * stride; const int row = g >> 3, h = g & 7;
            po[q] = ya + (size_t)row * 1024 + h * DH + 8 * l16;
            if (g < M * NH) { ro[q] = *(const u32x4*)po[q]; rz[q] = __builtin_nontemporal_load((const u32x4*)(proj + (size_t)row * NIN + C_Z + h * DH + 8 * l16)); } }
#pragma unroll
        for (int q = 0; q < 4; ++q) if (g0 + q * stride < M * NH) {
            float o[8], z[8]; unpack8(ro[q], o); unpack8(rz[q], z);
            float sq = 0.f;
#pragma unroll
            for (int e = 0; e < 8; ++e) sq += o[e] * o[e];
            sq += __shfl_xor(sq, 1); sq += __shfl_xor(sq, 2); sq += __shfl_xor(sq, 4); sq += __shfl_xor(sq, 8);
            const float rn = rsqrtf(sq * (1.f / DH) + EPS);
#pragma unroll
            for (int e = 0; e < 8; ++e) o[e] = o[e] * rn * (e < 4 ? w0[e] : w1[e - 4]) * siluf_(z[e]);
            *(u32x4*)po[q] = pack8f(o);
        }
    }
}

#define XB_TMO      128
#define XB_XCNT(j)  (256  + 64 * (j))
#define XB_XSUB(j)  (1280 + 64 * (j))
#define XB_XGEN(j)  (2304 + 64 * (j))
#define XB_TOP      3328
#define XB_TOPGEN   3392
#define XCD_BAR_WORDS 3456
#define XB_SPIN_CAP (1u << 18)
__device__ __forceinline__ unsigned xb_ld(unsigned* p)              { return __hip_atomic_load(p, __ATOMIC_RELAXED, __HIP_MEMORY_SCOPE_AGENT); }
__device__ __forceinline__ unsigned xb_add(unsigned* p, unsigned v) { return __hip_atomic_fetch_add(p, v, __ATOMIC_RELAXED, __HIP_MEMORY_SCOPE_AGENT); }
__device__ __forceinline__ unsigned xb_xcc_id() { return (unsigned)__builtin_amdgcn_s_getreg((3 << 11) | 20) & 0xFu; }
#define XB_SPIN(cond, bar) do { unsigned _sp = 0; while (cond) { __builtin_amdgcn_s_sleep(1); \
    if ((++_sp & 255u) == 0u) { if (xb_ld(&(bar)[XB_TMO])) break; if (_sp > XB_SPIN_CAP) { atomicAdd(&(bar)[XB_TMO], 1u); break; } } } } while (0)
struct XcdBarrier { unsigned* bar; unsigned x; volatile LAS unsigned* st; };
__device__ __forceinline__ XcdBarrier xcd_barrier_post(unsigned* bar, volatile LAS unsigned* st) {
    XcdBarrier b; b.bar = bar; b.x = xb_xcc_id(); b.st = st;
    if (threadIdx.x == 0) (void)xb_add(&bar[XB_XCNT(b.x)], 1u);
    return b;
}
__device__ __forceinline__ void xcd_barrier_complete(unsigned* bar, unsigned x, unsigned& nloc, unsigned& nx) {
    const unsigned G = gridDim.x * gridDim.y * gridDim.z;
    unsigned sum, cnt, mine, sp = 0u;
    for (;;) {
        sum = 0u; cnt = 0u; mine = 0u;
#pragma unroll
        for (unsigned j = 0; j < 16; ++j) { const unsigned c = xb_ld(&bar[XB_XCNT(j)]); sum += c; cnt += (c > 0u) ? 1u : 0u; mine = (j == x) ? c : mine; }
        if (sum == G) break;
        __builtin_amdgcn_s_sleep(1);
        if ((++sp & 255u) == 0u) { if (xb_ld(&bar[XB_TMO])) break; if (sp > XB_SPIN_CAP) { atomicAdd(&bar[XB_TMO], 1u); break; } }
    }
    nloc = mine > 0u ? mine : 1u; nx = cnt > 0u ? cnt : 1u;
}
__device__ __forceinline__ void xcd_barrier(const XcdBarrier& b) {
    asm volatile("s_waitcnt vmcnt(0)" ::: "memory");
    __syncthreads();
    if (threadIdx.x == 0) {
        unsigned* bar = b.bar;
        __builtin_amdgcn_s_waitcnt(0);
        unsigned nloc = b.st[0], nx = b.st[1];
        if (nloc == 0u) { xcd_barrier_complete(bar, b.x, nloc, nx); b.st[0] = nloc; b.st[1] = nx; }
        const unsigned old = xb_add(&bar[XB_XSUB(b.x)], 1u);
        const unsigned gen = old / nloc;
        if (old + 1u == (gen + 1u) * nloc) {
            __builtin_amdgcn_fence(__ATOMIC_RELEASE, "agent");
            asm volatile("s_waitcnt vmcnt(0)" ::: "memory");
            const unsigned og = xb_add(&bar[XB_TOP], 1u);
            const unsigned tg = og / nx;
            if (og + 1u == (tg + 1u) * nx) xb_add(&bar[XB_TOPGEN], 1u);
            else XB_SPIN(xb_ld(&bar[XB_TOPGEN]) == tg, bar);
            __builtin_amdgcn_fence(__ATOMIC_ACQUIRE, "agent");
            xb_add(&bar[XB_XGEN(b.x)], 1u);
            asm volatile("s_waitcnt vmcnt(0)" ::: "memory");
        } else {
            XB_SPIN(xb_ld(&bar[XB_XGEN(b.x)]) == gen, bar);
            __builtin_amdgcn_fence(__ATOMIC_ACQUIRE, "agent");
            asm volatile("s_waitcnt vmcnt(0)" ::: "memory");
        }
    }
    __syncthreads();
}

constexpr int NPHASE = 11;
__global__ void __launch_bounds__(512, 2) fwd_megakernel(Params P) {
    extern __shared__ __attribute__((aligned(16))) unsigned char smem[];
    LAS unsigned char* lds = (LAS unsigned char*)smem;
    cg::grid_group grid = cg::this_grid();
    const int G = gridDim.x, lo = P.ph_lo, hi = P.ph_hi & 255, pflags = P.ph_hi >> 8;
    unsigned char* ws = P.ws;
    float* ss = (float*)(ws + WS_SS);
    bf16_t* xb = (bf16_t*)(ws + WS_XB); bf16_t* act = (bf16_t*)(ws + WS_ACT); bf16_t* proj = (bf16_t*)(ws + WS_PROJ);
#ifndef NREP5
#define NREP5 1
#endif
#ifndef REP_PHASE
#define REP_PHASE -1
#endif
#define IN(k) (lo <= (k) && (k) < hi)
    volatile LAS unsigned* xst = (volatile LAS unsigned*)(lds + LDS_BYTES - 16);
    if (threadIdx.x == 0) { xst[0] = 0u; xst[1] = 0u; }
    __syncthreads();
    XcdBarrier xbar = xcd_barrier_post((unsigned*)(ws + WS_BAR), xst);
    if (lo < 0) grid.sync();
#define SEAM(k) do { if (IN(k) && IN((k) + 1)) xcd_barrier(xbar); } while (0)
    for (int rep = 0; rep < (REP_PHASE == 0 ? 2 : 1); ++rep) { if (IN(0)) phase_convert(P, lds, G);
    SEAM(0); }
    for (int rep = 0; rep < (REP_PHASE == 1 ? 2 : 1); ++rep) {
    if (IN(1)) { pg8::Sched S; S.init(xb, (const bf16_t*)(ws + WS_WGU1), nullptr, nullptr, M, NGU, G, blockIdx.x, 0); EpiGU E{act, ss}; pg8::gemm_phase(lds, D, S, E);
        idle_convert(P, lds, (M / 256) * (NGU / 256), G, -1, 0); }
    SEAM(1); }
    if (IN(2)) { pg8::Sched S; S.init(act, (const bf16_t*)(ws + WS_WD1), nullptr, nullptr, M, D, G, blockIdx.x, 0); EpiRes E{P.x, P.out, xb, ss + M, 0.5f}; pg8::gemm_phase(lds, FF, S, E); }
    SEAM(2);
    if (IN(3)) { pg8::Sched S; S.init(xb, (const bf16_t*)(ws + WS_WIN), nullptr, nullptr, M, NIN, G, blockIdx.x, 0); EpiProj E{proj, ss + M}; pg8::gemm_phase(lds, D, S, E);
        idle_convert(P, lds, (M / 256) * (NIN / 256), G, 0, LATE_A); }
    SEAM(3);
    if (IN(4)) { const int nit = (NCH * NH - 1 - (int)blockIdx.x) / G; for (int k = nit; k >= 0; --k) prep_item(P, lds, blockIdx.x + k * G, pflags); }
    SEAM(4);
_Pragma("unroll 1")
    for (int rep = 0; rep < NREP5; ++rep) {
    if (IN(5)) {
        const int tid5 = opaque_tid(), wave = tid5 >> 6, b = blockIdx.x;
        if (b < 64) { if (!(pflags & 4)) scan_wg(P, lds, b & 7, b >> 3, 0); }
        else { if (!(pflags & 2)) for (int it = b - 64; it < (NCH / 2) * NH; it += G - 64) attn_item(P, lds, it >> 3, it & 7);
            if (!(pflags & 1)) convert_late(P, (LAS float*)(lds + wave * 17408), ((((M / 256) * (NIN / 256)) % G) ? LATE_A : 0), ((((M / 256) * (NGU / 256)) % G) ? LATE_C : N_LATE), (b - 64) * 8 + wave, (G - 64) * 8, tid5 & 63); }
    }
    SEAM(5); }
    if (IN(6)) phase_gnorm(P, G);
    SEAM(6);
    if (IN(7)) { pg8::Sched S; S.init((const bf16_t*)(ws + WS_YA), (const bf16_t*)(ws + WS_WA), (const bf16_t*)(ws + WS_YB), (const bf16_t*)(ws + WS_WB), M, D, G, blockIdx.x, 1);
        EpiMix E{proj, (bf16_t*)(ws + WS_MIX)}; pg8::gemm_phase(lds, 1024, S, E); }
    SEAM(7);
    if (IN(8)) { pg8::Sched S; S.init((const bf16_t*)(ws + WS_MIX), (const bf16_t*)(ws + WS_WOUT), nullptr, nullptr, M, D, G, blockIdx.x, 0); EpiRes E{P.out, P.out, xb, ss + 2 * M, 1.0f}; pg8::gemm_phase(lds, D, S, E); }
    SEAM(8);
    if (IN(9)) { pg8::Sched S; S.init(xb, (const bf16_t*)(ws + WS_WGU2), nullptr, nullptr, M, NGU, G, blockIdx.x, 0); EpiGU E{act, ss + 2 * M}; pg8::gemm_phase(lds, D, S, E);
        idle_convert(P, lds, (M / 256) * (NGU / 256), G, LATE_C, N_LATE); }
    SEAM(9);
    if (IN(10)) { pg8::Sched S; S.init(act, (const bf16_t*)(ws + WS_WD2), nullptr, nullptr, M, D, G, blockIdx.x, 0); EpiRes E{P.out, P.out, xb, ss + 3 * M, 0.5f}; pg8::gemm_phase(lds, FF, S, E); }
    SEAM(10);
    if (IN(11)) {
        { pg8::Sched S; S.init((const bf16_t*)(ws + WS_PB), (const bf16_t*)(ws + WS_WPP), nullptr, nullptr, M, D, G, blockIdx.x, 0); EpiF32 E{(float*)(ws + WS_RBUF)}; pg8::gemm_phase(lds, PLE, S, E); }
        { pg8::Sched S; S.init(xb, (const bf16_t*)(ws + WS_WPG), nullptr, nullptr, M, D, G, blockIdx.x, 0); EpiPle E{P.out, (const float*)(ws + WS_RBUF), ss + 3 * M}; pg8::gemm_phase(lds, D, S, E); }
    }
#undef IN
#undef SEAM
}


#ifdef PROBE_VAR
__global__ void __launch_bounds__(512, 2) probe_scan(Params P) {
    extern __shared__ __attribute__((aligned(16))) unsigned char smem[];
    scan_wg(P, (LAS unsigned char*)smem, blockIdx.x & 7, blockIdx.x >> 3, PROBE_VAR);
}
#endif
#ifndef N_LAUNCH_MODE
#define N_LAUNCH_MODE 0
#endif
extern "C" void kernel_launch(void* const* d_in, const int* in_sizes, int n_in, void* d_out, int out_size, void* d_ws, size_t ws_size, hipStream_t stream) {
    static int grid = 0;
    if (grid == 0) {
        if (n_in != 23 || out_size != M * D || ws_size < WS_END) { fprintf(stderr, "kernel_launch: unexpected problem (n_in %d out %d ws %zu need %zu)\n", n_in, out_size, ws_size, (size_t)WS_END); grid = -1; return; }
        int dev = 0, cus = 0, per_cu = 0;
        hipGetDevice(&dev); hipDeviceGetAttribute(&cus, hipDeviceAttributeMultiprocessorCount, dev);
        if (hipFuncSetAttribute((const void*)fwd_megakernel, hipFuncAttributeMaxDynamicSharedMemorySize, LDS_BYTES) != hipSuccess) { fprintf(stderr, "kernel_launch: hipFuncSetAttribute failed\n"); grid = -1; return; }
        if (hipOccupancyMaxActiveBlocksPerMultiprocessor(&per_cu, (const void*)fwd_megakernel, 512, LDS_BYTES) != hipSuccess || per_cu < 1) { fprintf(stderr, "kernel_launch: occupancy query failed (%d)\n", per_cu); (void)hipGetLastError(); per_cu = 1; }
        grid = cus * 1;
        if (grid < 192) { fprintf(stderr, "kernel_launch: grid too small\n"); grid = -1; return; }
    }
    if (grid < 0) return;
    if (hipMemsetAsync((char*)d_ws + WS_BAR, 0, 16384, stream) != hipSuccess) { fprintf(stderr, "kernel_launch: memset of the barrier words failed\n"); return; }
    Params p{};
    const float** pp = (const float**)&p;
    for (int i = 0; i < 23; ++i) pp[i] = (const float*)d_in[i];
    p.out = (float*)d_out; p.ws = (unsigned char*)d_ws;
#if N_LAUNCH_MODE == 0
    p.ph_lo = 0; p.ph_hi = NPHASE + 1;
    void* args[] = {&p};
    hipError_t e = hipLaunchCooperativeKernel((const void*)fwd_megakernel, dim3(grid), dim3(512), args, LDS_BYTES, stream);
    if (e != hipSuccess) fprintf(stderr, "cooperative launch failed: %s (grid %d)\n", hipGetErrorString(e), grid);
#ifdef PROBE_VAR
    hipLaunchKernelGGL(probe_scan, dim3(64), dim3(512), 16384, stream, p);
#endif
#ifdef PROBE_PHASE
    p.ph_lo = PROBE_PHASE; p.ph_hi = (PROBE_PHASE + 1) | (PROBE_FLAGS << 8); hipLaunchKernelGGL(fwd_megakernel, dim3(grid), dim3(512), LDS_BYTES, stream, p);
#endif
#else
    for (int ph = 0; ph <= NPHASE; ++ph) { p.ph_lo = ph; p.ph_hi = ph + 1; hipLaunchKernelGGL(fwd_megakernel, dim3(grid), dim3(512), LDS_BYTES, stream, p); }
#endif
}
```

```cpp
#include <hip/hip_runtime.h>
#include <hip/hip_cooperative_groups.h>
#include <cstdio>
namespace cg = cooperative_groups;

#define LAS __attribute__((address_space(3)))
typedef unsigned short bf16_t;
typedef short bf16x8 __attribute__((ext_vector_type(8)));
typedef float f32x4 __attribute__((ext_vector_type(4)));
typedef unsigned u32x4 __attribute__((ext_vector_type(4)));
typedef unsigned u32x2 __attribute__((ext_vector_type(2)));
typedef __bf16 bf16v2 __attribute__((ext_vector_type(2)));

constexpr int M = 8192, D = 2048, FF = 5632, NGU = 11264, NIN = 11520, NINSRC = 11280, PLE = 256;
constexpr int NH = 8, DH = 128, NCH = 128;
constexpr int C_QA = 0, C_KA = 1024, C_VA = 2048, C_Z = 3072, C_QB = 4096, C_KB = 5120, C_VB = 6144, C_GA = 7168, C_GB = 9216, C_AR = 11264, C_BR = 11272;
constexpr float EPS = 1e-6f;
constexpr size_t WS_WGU1 = 0;
constexpr size_t WS_WD1  = WS_WGU1 + (size_t)NGU * D * 2;
constexpr size_t WS_WIN  = WS_WD1 + (size_t)D * FF * 2;
constexpr size_t WS_WA   = WS_WIN + (size_t)NIN * D * 2;
constexpr size_t WS_WB   = WS_WA + (size_t)D * 1024 * 2;
constexpr size_t WS_WOUT = WS_WB + (size_t)D * 1024 * 2;
constexpr size_t WS_WGU2 = WS_WOUT + (size_t)D * D * 2;
constexpr size_t WS_WD2  = WS_WGU2 + (size_t)NGU * D * 2;
constexpr size_t WS_WPG  = WS_WD2 + (size_t)D * FF * 2;
constexpr size_t WS_WPP  = WS_WPG + (size_t)D * D * 2;
constexpr size_t WS_XB   = WS_WPP + (size_t)D * PLE * 2;
constexpr size_t WS_PROJ = WS_XB + (size_t)M * D * 2;
constexpr size_t WS_AQK  = WS_PROJ + (size_t)M * NIN * 2;
constexpr size_t WS_KTT  = WS_AQK + (size_t)1024 * 64 * 64 * 2;
constexpr size_t WS_PB   = WS_KTT + (size_t)M * 1024 * 2;
constexpr size_t WS_VT   = WS_PB + (size_t)M * PLE * 2;
constexpr size_t WS_SS   = WS_VT + (size_t)M * 1024 * 2;
constexpr size_t WS_TAIL = WS_SS + (size_t)4 * M * 4;
constexpr size_t WS_PROG = WS_TAIL + 4096;
constexpr size_t WS_BAR  = WS_PROG + 4096;
constexpr size_t WS_END  = WS_BAR + 16384;
constexpr size_t WS_ACT  = WS_PROJ;
constexpr size_t WS_RBUF = WS_PROJ;
constexpr size_t WS_U    = 0;
constexpr size_t WS_W    = WS_U + (size_t)M * 1024 * 4;
constexpr size_t WS_QD   = WS_W + (size_t)M * 1024 * 2;
constexpr size_t WS_MIX  = 0;
constexpr size_t WS_YB   = WS_XB;
constexpr size_t WS_YA   = WS_XB + (size_t)M * 1024 * 2;
static_assert(WS_QD + (size_t)M * 1024 * 2 <= WS_WIN, "gdn scratch overlaps live weights");

constexpr int LDS_BYTES = 147456;

__device__ __forceinline__ unsigned pk2(float lo, float hi) { bf16v2 v = {(__bf16)lo, (__bf16)hi}; return __builtin_bit_cast(unsigned, v); }
__device__ __forceinline__ float bf2f(bf16_t b) { return __uint_as_float(((unsigned)b) << 16); }
__device__ __forceinline__ float bflo(unsigned w) { return __uint_as_float(w << 16); }
__device__ __forceinline__ float bfhi(unsigned w) { return __uint_as_float(w & 0xffff0000u); }
__device__ __forceinline__ void unpack8(u32x4 w, float (&f)[8]) { f[0] = bflo(w.x); f[1] = bfhi(w.x); f[2] = bflo(w.y); f[3] = bfhi(w.y); f[4] = bflo(w.z); f[5] = bfhi(w.z); f[6] = bflo(w.w); f[7] = bfhi(w.w); }
__device__ __forceinline__ u32x4 pack8f(const float (&f)[8]) { u32x4 w; w.x = pk2(f[0], f[1]); w.y = pk2(f[2], f[3]); w.z = pk2(f[4], f[5]); w.w = pk2(f[6], f[7]); return w; }
__device__ __forceinline__ bf16x8 pack_acc(f32x4 a, f32x4 b) { u32x4 p; p.x = pk2(a[0], a[1]); p.y = pk2(a[2], a[3]); p.z = pk2(b[0], b[1]); p.w = pk2(b[2], b[3]); return __builtin_bit_cast(bf16x8, p); }
__device__ __forceinline__ bf16x8 ld2x8(const bf16_t* p0, const bf16_t* p1) { const u32x2 a = *(const u32x2*)p0, b = *(const u32x2*)p1; u32x4 v; v.x = a.x; v.y = a.y; v.z = b.x; v.w = b.y; return __builtin_bit_cast(bf16x8, v); }
__device__ __forceinline__ bf16x8 ld8(const bf16_t* p) { return __builtin_bit_cast(bf16x8, *(const u32x4*)p); }
__device__ __forceinline__ float sigmoidf_(float x) { return __builtin_amdgcn_rcpf(1.f + __expf(-x)); }
__device__ __forceinline__ float siluf_(float x) { return x * __builtin_amdgcn_rcpf(1.f + __expf(-x)); }
__device__ __forceinline__ float wave_sum(float v) {
#pragma unroll
    for (int o = 1; o < 64; o <<= 1) v += __shfl_xor(v, o);
    return v;
}
__device__ __forceinline__ int opaque_tid() { int t = threadIdx.x; asm volatile("" : "+v"(t)); return t; }
#define MFMA16(a, b, c) __builtin_amdgcn_mfma_f32_16x16x32_bf16((a), (b), (c), 0, 0, 0)

namespace pg8 {
constexpr int BM = 256, BK = 64, HALF = 128, HTB = HALF * BK * 2, STAGE_BYTES = 8 * HTB, NXCD = 8, WGM = 8;
__device__ __forceinline__ int lds_byte(int r, int c) { const int st = (r >> 4) * 2 + (c >> 5), rr = r & 15, cc = c & 31, ob = rr * 64 + cc * 2; return st * 1024 + (ob ^ (((ob >> 9) & 1) << 5)); }
__device__ __forceinline__ void stage_rc(int b, int& R, int& C) { const int st = b / 1024, sb = b % 1024, swz = sb ^ (((sb >> 9) & 1) << 5); R = (st >> 1) * 16 + swz / 64; C = (st & 1) * 32 + (swz % 64) / 2; }
__device__ __forceinline__ int perm32(int rho) { const int n = rho >> 4, i = rho & 15; return 8 * (i >> 2) + 4 * n + (i & 3); }

struct Unit { int pm, pn, sel; };
struct Sched {
    const bf16_t *A0, *B0, *A1, *B1;
    int nM, nN, nwg, G, c, dual;
    __device__ __forceinline__ void init(const bf16_t* a0, const bf16_t* b0, const bf16_t* a1, const bf16_t* b1, int Mr, int Nc, int G_, int c_, int dual_) {
        A0 = a0; B0 = b0; A1 = a1; B1 = b1; nM = Mr / BM; nN = Nc / BM; nwg = nM * nN; G = G_; c = c_; dual = dual_; }
    __device__ __forceinline__ bool next(int i, Unit& u) const {
        const int tile = dual ? (i >> 1) : i;
        const long L = (long)tile * G + c; if (L >= nwg) return false;
        int wgid = (int)L; { const int q = nwg / NXCD, r = nwg % NXCD, xcd = wgid % NXCD, off = wgid / NXCD; wgid = (xcd < r ? xcd * (q + 1) : r * (q + 1) + (xcd - r) * q) + off; }
        const int nig = WGM * nN, gid = wgid / nig, fm = gid * WGM, gsz = (nM - fm) < WGM ? (nM - fm) : WGM;
        u.pm = fm + ((wgid % nig) % gsz); u.pn = (wgid % nig) / gsz; u.sel = dual ? (i & 1) : 0; return true;
    }
};

template <class Epi>
__device__ __forceinline__ void gemm_phase(LAS unsigned char* lds, const int K, const Sched& S, const Epi& E) {
    const int tid = opaque_tid(), wid = __builtin_amdgcn_readfirstlane(tid >> 6), lane = tid & 63, wr = wid >> 2, wc = wid & 3, fr = lane & 15, fq = lane >> 4;
    const int nt = K / BK;
    unsigned voffA[2], voffB[2];
#pragma unroll
    for (int i = 0; i < 2; ++i) { int R, C; stage_rc(tid * 16 + i * 8192, R, C); const int Rb = Epi::PERM ? ((R & ~31) + perm32(R & 31)) : R;
        voffA[i] = (unsigned)(R * K + C) * 2u; voffB[i] = (unsigned)(Rb * K + C) * 2u; }
    const size_t kstep = (size_t)(BK * 2);
    const size_t hstep = (size_t)HALF * K * 2;
    const size_t tstep = 2 * hstep;
    const unsigned ldsw = (unsigned)wid * 1024u;
    const int aoff = lds_byte(wr * 64 + fr, fq * 8), boff = lds_byte(wc * 32 + fr, fq * 8);
#define PG8_SA(b, h) (((b) * 2 + (h)) * HTB)
#define PG8_SB(b, h) ((4 + (b) * 2 + (h)) * HTB)
#define PG8_STAGE(bufoff, gbase, voff) do { _Pragma("unroll") for (int _i = 0; _i < 2; ++_i) \
        __builtin_amdgcn_global_load_lds((const unsigned*)((const char*)(gbase) + (voff)[_i]), (LAS unsigned*)(lds + (bufoff) + ldsw + _i * 8192), 16, 0, 0); } while (0)
#define PG8_LDA(dst, b, h) do { _Pragma("unroll") for (int m = 0; m < 4; ++m) _Pragma("unroll") for (int k = 0; k < 2; ++k) dst[m][k] = *(const LAS bf16x8*)(lds + PG8_SA(b, h) + aoff + m * 2048 + k * 1024); } while (0)
#define PG8_LDB(dst, b, h) do { _Pragma("unroll") for (int n = 0; n < 2; ++n) _Pragma("unroll") for (int k = 0; k < 2; ++k) dst[n][k] = *(const LAS bf16x8*)(lds + PG8_SB(b, h) + boff + n * 2048 + k * 1024); } while (0)
#define PG8_MMA(ai, bj, At, Bt) do { __builtin_amdgcn_s_setprio(1); _Pragma("unroll") for (int m = 0; m < 4; ++m) _Pragma("unroll") for (int n = 0; n < 2; ++n) _Pragma("unroll") for (int k = 0; k < 2; ++k) \
        acc[ai][bj][m][n] = __builtin_amdgcn_mfma_f32_16x16x32_bf16(Bt[n][k], At[m][k], acc[ai][bj][m][n], 0, 0, 0); __builtin_amdgcn_s_setprio(0); } while (0)
#define PG8_WAIT_V(n) asm volatile("s_waitcnt vmcnt(" #n ")" ::: "memory")
#define PG8_WAIT_L(n) asm volatile("s_waitcnt lgkmcnt(" #n ")" ::: "memory")
#define PG8_BAR __builtin_amdgcn_s_barrier()
#define PG8_SCHED __builtin_amdgcn_sched_barrier(0)
    Unit cur, nxt; int ui = 0;
    if (!S.next(0, cur)) return;
    float ssv[8]; E.pre(cur, wr, fr, ssv);
    f32x4 acc[2][2][4][2];
#pragma unroll
    for (int a = 0; a < 2; ++a)
#pragma unroll
        for (int b = 0; b < 2; ++b)
#pragma unroll
            for (int m = 0; m < 4; ++m)
#pragma unroll
                for (int n = 0; n < 2; ++n) acc[a][b][m][n] = (f32x4){0.f, 0.f, 0.f, 0.f};
    bf16x8 At[4][2], B0[2][2], B1[2][2];
    const char* cA = (const char*)(cur.sel ? S.A1 : S.A0) + (size_t)cur.pm * tstep; const char* cB = (const char*)(cur.sel ? S.B1 : S.B0) + (size_t)cur.pn * tstep;
    PG8_STAGE(PG8_SB(0, 0), cB, voffB); PG8_STAGE(PG8_SA(0, 0), cA, voffA); PG8_STAGE(PG8_SB(0, 1), cB + hstep, voffB); PG8_STAGE(PG8_SA(0, 1), cA + hstep, voffA);
    if (wr == 1) PG8_BAR;
    PG8_WAIT_V(4); PG8_BAR;
    PG8_STAGE(PG8_SB(1, 0), cB + kstep, voffB); PG8_STAGE(PG8_SA(1, 0), cA + kstep, voffA); PG8_STAGE(PG8_SB(1, 1), cB + hstep + kstep, voffB);
    PG8_WAIT_V(6); PG8_BAR;
    for (;;) {
        const bool has_next = S.next(ui + 1, nxt);
        const char* nA = has_next ? (const char*)(nxt.sel ? S.A1 : S.A0) + (size_t)nxt.pm * tstep : cA; const char* nB = has_next ? (const char*)(nxt.sel ? S.B1 : S.B0) + (size_t)nxt.pn * tstep : cB;
        for (int t = 0; t < nt; t += 2) {
            const bool last = (t == nt - 2);
            const char* a1 = cA + (size_t)(t + 1) * kstep;
            const char* a2 = last ? nA : cA + (size_t)(t + 2) * kstep; const char* b2 = last ? nB : cB + (size_t)(t + 2) * kstep;
            const char* a3 = a2 + kstep; const char* b3 = b2 + kstep;
            PG8_LDB(B0, 0, 0); PG8_SCHED; PG8_LDA(At, 0, 0); PG8_STAGE(PG8_SA(1, 1), a1 + hstep, voffA);
            PG8_WAIT_L(8); PG8_BAR; PG8_WAIT_L(0); PG8_MMA(0, 0, At, B0); PG8_BAR; PG8_SCHED;
            PG8_LDB(B1, 0, 1); PG8_STAGE(PG8_SB(0, 0), b2, voffB);
            PG8_BAR; PG8_WAIT_L(0); PG8_MMA(0, 1, At, B1); PG8_BAR;
            PG8_LDA(At, 0, 1); PG8_STAGE(PG8_SA(0, 0), a2, voffA);
            PG8_BAR; PG8_WAIT_L(0); PG8_MMA(1, 0, At, B0); PG8_BAR; PG8_SCHED;
            PG8_STAGE(PG8_SB(0, 1), b2 + hstep, voffB);
            PG8_WAIT_V(6); PG8_BAR; PG8_MMA(1, 1, At, B1); PG8_BAR;
            PG8_LDB(B0, 1, 0); PG8_SCHED; PG8_LDA(At, 1, 0); PG8_STAGE(PG8_SA(0, 1), a2 + hstep, voffA);
            PG8_WAIT_L(8); PG8_BAR; PG8_WAIT_L(0); PG8_MMA(0, 0, At, B0); PG8_BAR; PG8_SCHED;
            PG8_LDB(B1, 1, 1); PG8_STAGE(PG8_SB(1, 0), b3, voffB);
            PG8_BAR; PG8_WAIT_L(0); PG8_MMA(0, 1, At, B1); PG8_BAR;
            PG8_LDA(At, 1, 1); PG8_STAGE(PG8_SA(1, 0), a3, voffA);
            PG8_BAR; PG8_WAIT_L(0); PG8_MMA(1, 0, At, B0); PG8_BAR; PG8_SCHED;
            PG8_STAGE(PG8_SB(1, 1), b3 + hstep, voffB);
            PG8_WAIT_V(6); PG8_BAR; PG8_MMA(1, 1, At, B1); PG8_BAR;
        }
        E(acc, cur, wr, wc, fr, fq, ssv);
        if (!has_next) break;
        if (!E.keep(cur)) {
#pragma unroll
            for (int a = 0; a < 2; ++a)
#pragma unroll
                for (int b = 0; b < 2; ++b)
#pragma unroll
                    for (int m = 0; m < 4; ++m)
#pragma unroll
                        for (int n = 0; n < 2; ++n) acc[a][b][m][n] = (f32x4){0.f, 0.f, 0.f, 0.f};
        }
        cur = nxt; cA = nA; cB = nB; ++ui;
        E.pre(cur, wr, fr, ssv);
    }
    PG8_WAIT_V(0);
    if (wr == 0) PG8_BAR;
    PG8_BAR;
#undef PG8_SA
#undef PG8_SB
#undef PG8_STAGE
#undef PG8_LDA
#undef PG8_LDB
#undef PG8_MMA
#undef PG8_WAIT_V
#undef PG8_WAIT_L
#undef PG8_BAR
#undef PG8_SCHED
}
}
using pg8::Unit;
typedef f32x4 Acc[2][2][4][2];

struct EpiGU {
    static constexpr bool PERM = true;
    bf16_t* O; const float* ss;
    __device__ __forceinline__ void pre(const Unit& u, int wr, int fr, float (&ssv)[8]) const {
#pragma unroll
        for (int ai = 0; ai < 2; ++ai)
#pragma unroll
            for (int m = 0; m < 4; ++m) ssv[ai * 4 + m] = ss[u.pm * 256 + ai * 128 + wr * 64 + m * 16 + fr];
    }
    __device__ __forceinline__ bool keep(const Unit&) const { return false; }
    __device__ __forceinline__ void operator()(Acc& acc, const Unit& u, int wr, int wc, int fr, int fq, const float (&ssv)[8]) const {
        const int row0 = u.pm * 256 + wr * 64 + fr, col0 = u.pn * 128 + wc * 32 + 8 * fq;
#pragma unroll
        for (int ai = 0; ai < 2; ++ai)
#pragma unroll
            for (int m = 0; m < 4; ++m) {
                const int row = row0 + ai * 128 + m * 16;
                const float rs = rsqrtf(ssv[ai * 4 + m] * (1.f / D) + EPS);
                const float rs2 = rs * rs, nrl = -1.4426950408889634f * rs;
                float o[8];
#pragma unroll
                for (int n = 0; n < 2; ++n)
#pragma unroll
                    for (int j = 0; j < 4; j += 2) {
                        typedef float f32x2v __attribute__((ext_vector_type(2)));
                        const f32x2v g = {acc[ai][0][m][n][j], acc[ai][0][m][n][j + 1]}, uu = {acc[ai][1][m][n][j], acc[ai][1][m][n][j + 1]};
                        const f32x2v t = g * nrl, p = (g * uu) * rs2;
                        f32x2v d; d.x = __builtin_amdgcn_exp2f(t.x); d.y = __builtin_amdgcn_exp2f(t.y); d = d + 1.0f;
                        f32x2v r; r.x = __builtin_amdgcn_rcpf(d.x); r.y = __builtin_amdgcn_rcpf(d.y);
                        const f32x2v q = p * r; o[n * 4 + j] = q.x; o[n * 4 + j + 1] = q.y;
                    }
                *(u32x4*)(O + (size_t)row * FF + col0) = pack8f(o);
            }
    }
};
struct EpiRes {
    static constexpr bool PERM = false;
    const float* base; float* out; bf16_t* ob; float* ssn; float scale;
    __device__ __forceinline__ void pre(const Unit&, int, int, float (&ssv)[8]) const {
#pragma unroll
        for (int i = 0; i < 8; ++i) ssv[i] = 0.f; }
    __device__ __forceinline__ bool keep(const Unit&) const { return false; }
    __device__ __forceinline__ void operator()(Acc& acc, const Unit& u, int wr, int wc, int fr, int fq, const float (&ssv)[8]) const {
        const int row0 = u.pm * 256 + wr * 64 + fr, col0 = u.pn * 256 + wc * 32 + 4 * fq;
#pragma unroll
        for (int ai = 0; ai < 2; ++ai) {
            f32x4 b[4][2][2];
#pragma unroll
            for (int m = 0; m < 4; ++m)
#pragma unroll
                for (int bj = 0; bj < 2; ++bj)
#pragma unroll
                    for (int n = 0; n < 2; ++n) b[m][bj][n] = *(const f32x4*)(base + (size_t)(row0 + ai * 128 + m * 16) * D + col0 + bj * 128 + n * 16);
#pragma unroll
            for (int m = 0; m < 4; ++m) {
                const int row = row0 + ai * 128 + m * 16; float sq = 0.f;
#pragma unroll
                for (int bj = 0; bj < 2; ++bj)
#pragma unroll
                    for (int n = 0; n < 2; ++n) {
                        const size_t off = (size_t)row * D + col0 + bj * 128 + n * 16;
                        const f32x4 v = b[m][bj][n] + acc[ai][bj][m][n] * scale;
                        *(f32x4*)(out + off) = v;
                        sq += (v[0] * v[0] + v[1] * v[1]) + (v[2] * v[2] + v[3] * v[3]);
                        u32x2 w; w.x = pk2(v[0], v[1]); w.y = pk2(v[2], v[3]);
                        *(u32x2*)(ob + off) = w;
                    }
                sq += __shfl_xor(sq, 16); sq += __shfl_xor(sq, 32);
                if (fq == 0) unsafeAtomicAdd(ssn + row, sq);
            }
        }
    }
};
struct EpiProj {
    static constexpr bool PERM = true;
    bf16_t* O; const float* ss;
    __device__ __forceinline__ void pre(const Unit& u, int wr, int fr, float (&ssv)[8]) const {
#pragma unroll
        for (int ai = 0; ai < 2; ++ai)
#pragma unroll
            for (int m = 0; m < 4; ++m) ssv[ai * 4 + m] = ss[u.pm * 256 + ai * 128 + wr * 64 + m * 16 + fr];
    }
    __device__ __forceinline__ bool keep(const Unit&) const { return false; }
    __device__ __forceinline__ void operator()(Acc& acc, const Unit& u, int wr, int wc, int fr, int fq, const float (&ssv)[8]) const {
        const int row0 = u.pm * 256 + wr * 64 + fr, col0 = u.pn * 256 + wc * 32 + 8 * fq;
#pragma unroll
        for (int ai = 0; ai < 2; ++ai)
#pragma unroll
            for (int m = 0; m < 4; ++m) {
                const int row = row0 + ai * 128 + m * 16;
                const float rs = rsqrtf(ssv[ai * 4 + m] * (1.f / D) + EPS);
#pragma unroll
                for (int bj = 0; bj < 2; ++bj) {
                    float o[8];
#pragma unroll
                    for (int n = 0; n < 2; ++n)
#pragma unroll
                        for (int j = 0; j < 4; ++j) o[n * 4 + j] = acc[ai][bj][m][n][j] * rs;
                    *(u32x4*)(O + (size_t)row * NIN + col0 + bj * 128) = pack8f(o);
                }
            }
    }
};
struct EpiMix {
    static constexpr bool PERM = true;
    const bf16_t* proj; bf16_t* O;
    __device__ __forceinline__ void pre(const Unit&, int, int, float (&ssv)[8]) const {
#pragma unroll
        for (int i = 0; i < 8; ++i) ssv[i] = 0.f; }
    __device__ __forceinline__ bool keep(const Unit& u) const { return u.sel == 0; }
    __device__ __forceinline__ void operator()(Acc& acc, const Unit& u, int wr, int wc, int fr, int fq, const float (&ssv)[8]) const {
        const int row0 = u.pm * 256 + wr * 64 + fr, col0 = u.pn * 256 + wc * 32 + 8 * fq;
#pragma unroll
        for (int ai = 0; ai < 2; ++ai) {
            u32x4 rga[4][2], rgb[4][2];
#pragma unroll
            for (int m = 0; m < 4; ++m)
#pragma unroll
                for (int bj = 0; bj < 2; ++bj) { const size_t o = (size_t)(row0 + ai * 128 + m * 16) * NIN + col0 + bj * 128;
                    rga[m][bj] = *(const u32x4*)(proj + o + C_GA); rgb[m][bj] = *(const u32x4*)(proj + o + C_GB); }
#pragma unroll
            for (int m = 0; m < 4; ++m) {
                const int row = row0 + ai * 128 + m * 16;
#pragma unroll
                for (int bj = 0; bj < 2; ++bj) {
                    const int col = col0 + bj * 128;
                    float ga[8], gb[8];
                    unpack8(rga[m][bj], ga);
                    unpack8(rgb[m][bj], gb);
                    if (u.sel == 0) {
#pragma unroll
                        for (int n = 0; n < 2; ++n)
#pragma unroll
                            for (int j = 0; j < 4; ++j) acc[ai][bj][m][n][j] *= (1.f + __expf(-gb[n * 4 + j])) * __builtin_amdgcn_rcpf(1.f + __expf(-ga[n * 4 + j]));
                    } else {
                        float o[8];
#pragma unroll
                        for (int n = 0; n < 2; ++n)
#pragma unroll
                            for (int j = 0; j < 4; ++j) o[n * 4 + j] = acc[ai][bj][m][n][j] * sigmoidf_(gb[n * 4 + j]);
                        *(u32x4*)(O + (size_t)row * D + col) = pack8f(o);
                    }
                }
            }
        }
    }
};
struct EpiF32 {
    static constexpr bool PERM = false;
    float* C;
    __device__ __forceinline__ void pre(const Unit&, int, int, float (&ssv)[8]) const {
#pragma unroll
        for (int i = 0; i < 8; ++i) ssv[i] = 0.f; }
    __device__ __forceinline__ bool keep(const Unit&) const { return false; }
    __device__ __forceinline__ void operator()(Acc& acc, const Unit& u, int wr, int wc, int fr, int fq, const float (&ssv)[8]) const {
        const int row0 = u.pm * 256 + wr * 64 + fr, col0 = u.pn * 256 + wc * 32 + 4 * fq;
#pragma unroll
        for (int ai = 0; ai < 2; ++ai)
#pragma unroll
            for (int m = 0; m < 4; ++m)
#pragma unroll
                for (int bj = 0; bj < 2; ++bj)
#pragma unroll
                    for (int n = 0; n < 2; ++n) *(f32x4*)(C + (size_t)(row0 + ai * 128 + m * 16) * D + col0 + bj * 128 + n * 16) = acc[ai][bj][m][n];
    }
};
struct EpiPle {
    static constexpr bool PERM = false;
    float* out; const float* R; const float* ss;
    __device__ __forceinline__ void pre(const Unit& u, int wr, int fr, float (&ssv)[8]) const {
#pragma unroll
        for (int ai = 0; ai < 2; ++ai)
#pragma unroll
            for (int m = 0; m < 4; ++m) ssv[ai * 4 + m] = ss[u.pm * 256 + ai * 128 + wr * 64 + m * 16 + fr];
    }
    __device__ __forceinline__ bool keep(const Unit&) const { return false; }
    __device__ __forceinline__ void operator()(Acc& acc, const Unit& u, int wr, int wc, int fr, int fq, const float (&ssv)[8]) const {
        const int row0 = u.pm * 256 + wr * 64 + fr, col0 = u.pn * 256 + wc * 32 + 4 * fq;
#pragma unroll
        for (int ai = 0; ai < 2; ++ai)
#pragma unroll
            for (int mp = 0; mp < 2; ++mp) {
                f32x4 bb[2][2][2], rr[2][2][2];
#pragma unroll
                for (int mm = 0; mm < 2; ++mm)
#pragma unroll
                    for (int bj = 0; bj < 2; ++bj)
#pragma unroll
                        for (int n = 0; n < 2; ++n) { const size_t off = (size_t)(row0 + ai * 128 + (2 * mp + mm) * 16) * D + col0 + bj * 128 + n * 16;
                            bb[mm][bj][n] = *(const f32x4*)(out + off); rr[mm][bj][n] = *(const f32x4*)(R + off); }
#pragma unroll
                for (int mm = 0; mm < 2; ++mm) {
                    const int m = 2 * mp + mm, row = row0 + ai * 128 + m * 16;
                    const float rs = rsqrtf(ssv[ai * 4 + m] * (1.f / D) + EPS);
#pragma unroll
                    for (int bj = 0; bj < 2; ++bj)
#pragma unroll
                        for (int n = 0; n < 2; ++n) {
                            const size_t off = (size_t)row * D + col0 + bj * 128 + n * 16;
                            f32x4 v;
#pragma unroll
                            for (int j = 0; j < 4; ++j) v[j] = bb[mm][bj][n][j] + sigmoidf_(acc[ai][bj][m][n][j] * rs) * rr[mm][bj][n][j];
                            *(f32x4*)(out + off) = v;
                        }
                }
            }
    }
};

struct Params {
    const float *x, *p, *ffn1_norm, *ffn1_w_gu, *ffn1_w_down, *mix_norm, *w_in, *conv_w, *a_log, *dt_bias, *gdn_norm, *q_norm, *k_norm, *rel_bias,
                *w_a, *w_b, *w_out, *ffn2_norm, *ffn2_w_gu, *ffn2_w_down, *ple_norm, *ple_gate, *ple_proj;
    float* out; unsigned char* ws; int ph_lo, ph_hi;
};

template <int MAP> __device__ __forceinline__ int src_col(int n) {
    if (MAP == 1) return ((n >> 7) & 1) * FF + (n >> 8) * 128 + (n & 127);
    if (MAP == 2) return n < 4096 ? n : (n < 11264 ? n + 16 : (n < 11280 ? n - 11264 + 4096 : -1));
    return n;
}
template <int MAP> __device__ __forceinline__ void transpose_item(const float* W, const float* nw, int K, int Nsrc, int Nd, bf16_t* WT, LAS float* scr, int item, int lane) {
    const int nblk = Nd / 64, kb = item / nblk, nb = item % nblk, k0 = 64 * kb, n0 = 64 * nb;
    const int r = lane >> 4, c4 = lane & 15;
    const int sc = src_col<MAP>(n0 + 4 * c4);
    f32x4 v[16];
#pragma unroll
    for (int i = 0; i < 16; ++i) v[i] = sc >= 0 ? __builtin_nontemporal_load((const f32x4*)(W + (size_t)(k0 + 4 * i + r) * Nsrc + sc)) : (f32x4){0.f, 0.f, 0.f, 0.f};
    if (nw) {
#pragma unroll
        for (int i = 0; i < 16; ++i) v[i] = v[i] * nw[k0 + 4 * i + r];
    }
#pragma unroll
    for (int i = 0; i < 16; ++i) { LAS float* p = scr + (4 * i + r) * 65 + 4 * c4; p[0] = v[i][0]; p[1] = v[i][1]; p[2] = v[i][2]; p[3] = v[i][3]; }
    asm volatile("s_waitcnt lgkmcnt(0)" ::: "memory"); __builtin_amdgcn_wave_barrier();
    const int ns = lane >> 3, kc = lane & 7;
#pragma unroll
    for (int j = 0; j < 8; ++j) { const LAS float* sp = scr + (8 * kc) * 65 + 8 * j + ns;
        u32x4 o; o.x = pk2(sp[0 * 65], sp[1 * 65]); o.y = pk2(sp[2 * 65], sp[3 * 65]); o.z = pk2(sp[4 * 65], sp[5 * 65]); o.w = pk2(sp[6 * 65], sp[7 * 65]);
        *(u32x4*)(WT + (size_t)(n0 + 8 * j + ns) * K + k0 + 8 * kc) = o; }
    asm volatile("s_waitcnt lgkmcnt(0)" ::: "memory"); __builtin_amdgcn_wave_barrier();
}
constexpr int I_GU = (D / 64) * (NGU / 64), I_DN = (FF / 64) * (D / 64), I_IN = (D / 64) * (NIN / 64), I_AB = (1024 / 64) * (D / 64), I_SQ = (D / 64) * (D / 64), I_PP = (PLE / 64) * (D / 64);
constexpr int N_EARLY = I_GU + I_DN + I_IN, N_LATE = I_GU + I_DN + 2 * I_AB + 2 * I_SQ + I_PP;
__device__ __forceinline__ void convert_early(const Params& P, LAS float* scr, int gw, int NGW, int lane, bool with_d1) {
    unsigned char* ws = P.ws;
    for (int it = gw; it < I_GU + I_IN + (with_d1 ? I_DN : 0); it += NGW) {
        int r = it;
        if (r < I_GU) { transpose_item<1>(P.ffn1_w_gu, P.ffn1_norm, D, NGU, NGU, (bf16_t*)(ws + WS_WGU1), scr, r, lane); continue; } r -= I_GU;
        if (r < I_IN) { transpose_item<2>(P.w_in, P.mix_norm, D, NINSRC, NIN, (bf16_t*)(ws + WS_WIN), scr, r, lane); continue; } r -= I_IN;
        transpose_item<0>(P.ffn1_w_down, nullptr, FF, D, D, (bf16_t*)(ws + WS_WD1), scr, r, lane);
    }
}
__device__ __forceinline__ void convert_d1(const Params& P, LAS float* scr, int gw, int NGW, int lane) {
    for (int it = gw; it < I_DN; it += NGW) transpose_item<0>(P.ffn1_w_down, nullptr, FF, D, D, (bf16_t*)(P.ws + WS_WD1), scr, it, lane);
}
__device__ __forceinline__ void convert_late(const Params& P, LAS float* scr, int lo_it, int hi_it, int gw, int NGW, int lane) {
    unsigned char* ws = P.ws;
    for (int it = lo_it + gw; it < hi_it; it += NGW) {
        int r = it;
        if (r < I_AB) { transpose_item<0>(P.w_a, nullptr, 1024, D, D, (bf16_t*)(ws + WS_WA), scr, r, lane); continue; } r -= I_AB;
        if (r < I_AB) { transpose_item<0>(P.w_b, nullptr, 1024, D, D, (bf16_t*)(ws + WS_WB), scr, r, lane); continue; } r -= I_AB;
        if (r < I_SQ) { transpose_item<0>(P.w_out, nullptr, D, D, D, (bf16_t*)(ws + WS_WOUT), scr, r, lane); continue; } r -= I_SQ;
        if (r < I_GU) { transpose_item<1>(P.ffn2_w_gu, P.ffn2_norm, D, NGU, NGU, (bf16_t*)(ws + WS_WGU2), scr, r, lane); continue; } r -= I_GU;
        if (r < I_DN) { transpose_item<0>(P.ffn2_w_down, nullptr, FF, D, D, (bf16_t*)(ws + WS_WD2), scr, r, lane); continue; } r -= I_DN;
        if (r < I_SQ) { transpose_item<0>(P.ple_gate, P.ple_norm, D, D, D, (bf16_t*)(ws + WS_WPG), scr, r, lane); continue; } r -= I_SQ;
        transpose_item<0>(P.ple_proj, nullptr, PLE, D, D, (bf16_t*)(ws + WS_WPP), scr, r, lane);
    }
}
constexpr int LATE_A = 2800, LATE_C = 2 * I_AB + I_SQ + I_GU;
__device__ __forceinline__ void idle_convert(const Params& P, LAS unsigned char* lds, int nwg, int G, int lo_it, int hi_it) {
    const int extra = nwg % G, c = blockIdx.x;
    if (extra == 0 || c < extra) return;
    const int tid = opaque_tid(), wave = tid >> 6;
    if (lo_it < 0) convert_d1(P, (LAS float*)(lds + wave * 17408), (c - extra) * 8 + wave, (G - extra) * 8, tid & 63);
    else convert_late(P, (LAS float*)(lds + wave * 17408), lo_it, hi_it, (c - extra) * 8 + wave, (G - extra) * 8, tid & 63);
}
__device__ __forceinline__ void phase_convert(const Params& P, LAS unsigned char* lds, int G) {
    const int tid = opaque_tid(), lane = tid & 63, wave = tid >> 6;
    LAS float* scr = (LAS float*)(lds + wave * 17408);
    const int gw = blockIdx.x * 8 + wave, NGW = G * 8;
    unsigned char* ws = P.ws;
    convert_early(P, scr, gw, NGW, lane, (((M / 256) * (NGU / 256)) % G) == 0);
    float* ss = (float*)(ws + WS_SS);
    bf16_t* xb = (bf16_t*)(ws + WS_XB); bf16_t* pb = (bf16_t*)(ws + WS_PB);
    for (int m = gw; m < M; m += NGW) {
        const f32x4* xr = (const f32x4*)(P.x + (size_t)m * D) + lane; u32x2* o8 = (u32x2*)(xb + (size_t)m * D) + lane; float s = 0.f;
        f32x4 xv[8];
#pragma unroll
        for (int j = 0; j < 8; ++j) xv[j] = __builtin_nontemporal_load(xr + 64 * j);
#pragma unroll
        for (int j = 0; j < 8; ++j) { const f32x4 v = xv[j]; s += (v[0] * v[0] + v[1] * v[1]) + (v[2] * v[2] + v[3] * v[3]); u32x2 w; w.x = pk2(v[0], v[1]); w.y = pk2(v[2], v[3]); o8[64 * j] = w; }
        s = wave_sum(s); if (lane == 0) ss[m] = s;
        const f32x4 pv = *((const f32x4*)(P.p + (size_t)m * PLE) + lane); u32x2 w; w.x = pk2(pv[0], pv[1]); w.y = pk2(pv[2], pv[3]); *((u32x2*)(pb + (size_t)m * PLE) + lane) = w;
    }
    for (int i = blockIdx.x * 512 + tid; i < 3 * M; i += G * 512) ss[M + i] = 0.f;
    if (blockIdx.x == 0 && tid < 8) ((unsigned*)(ws + WS_PROG))[tid * 32] = 0u;
}

constexpr int L_LM = 0, L_GC = L_LM + 64 * 68 * 4, L_R = L_GC + 512, L_KBF = L_R + 65536, L_QBF = L_KBF + 64 * 136 * 2, L_VST = L_QBF + 64 * 136 * 2, L_END4 = L_VST + 64 * 136 * 2;
static_assert(L_END4 <= LDS_BYTES, "lds");
__device__ __forceinline__ void prep_item(const Params& P, LAS unsigned char* lds, int item, const int pflags) {
    const int tid = opaque_tid(), lane = tid & 63, wave = tid >> 6;
    const int n = item >> 3, h = item & 7;
    unsigned char* ws = P.ws;
    bf16_t* proj = (bf16_t*)(ws + WS_PROJ);
    LAS float* Rr = (LAS float*)(lds + L_R); LAS float* Lm = (LAS float*)(lds + L_LM);
    LAS bf16_t* kbf = (LAS bf16_t*)(lds + L_KBF); LAS bf16_t* qbf = (LAS bf16_t*)(lds + L_QBF); LAS bf16_t* vst = (LAS bf16_t*)(lds + L_VST);
    LAS float* gcs = (LAS float*)(lds + L_GC);
    if (wave == 0) {
        const size_t row = (size_t)n * 64 + lane;
        const float a = bf2f(proj[row * NIN + C_AR + h]), b = bf2f(proj[row * NIN + C_BR + h]);
        const float xx = a + P.dt_bias[h];
        const float sp = xx > 20.f ? xx : log1pf(expf(xx));
        float g = -expf(P.a_log[h]) * sp;
#pragma unroll
        for (int o = 1; o < 64; o <<= 1) { const float t = __shfl_up(g, o); if (lane >= o) g += t; }
        gcs[lane] = g; gcs[64 + lane] = 1.f / (1.f + expf(-b));
    }
    const int l16 = tid & 15, rg = tid >> 4;
    float qv[2][8], kv[2][8], vv[2][8];
#pragma unroll
    for (int X = 0; X < 3; ++X) {
        const int col = (X == 0 ? C_QA : (X == 1 ? C_KA : C_VA)) + h * DH + 8 * l16;
        const int ccol = X * 1024 + h * DH + 8 * l16;
        float xin[5][8];
#pragma unroll
        for (int i = 0; i < 5; ++i) { const int gr = n * 64 + 2 * rg - 3 + i;
            if (gr >= 0) unpack8(__builtin_nontemporal_load((const u32x4*)(proj + (size_t)gr * NIN + col)), xin[i]);
            else {
#pragma unroll
                for (int e = 0; e < 8; ++e) xin[i][e] = 0.f; } }
        float y[2][8];
#pragma unroll
        for (int r = 0; r < 2; ++r)
#pragma unroll
            for (int e = 0; e < 8; ++e) y[r][e] = 0.f;
#pragma unroll
        for (int j = 0; j < 4; ++j) {
            const f32x4 c0 = *(const f32x4*)(P.conv_w + j * 3072 + ccol), c1 = *(const f32x4*)(P.conv_w + j * 3072 + ccol + 4);
#pragma unroll
            for (int r = 0; r < 2; ++r)
#pragma unroll
                for (int e = 0; e < 8; ++e) y[r][e] += (e < 4 ? c0[e] : c1[e - 4]) * xin[r + j][e];
        }
#pragma unroll
        for (int r = 0; r < 2; ++r) {
            float sq = 0.f;
#pragma unroll
            for (int e = 0; e < 8; ++e) { y[r][e] = siluf_(y[r][e]); sq += y[r][e] * y[r][e]; }
            if (X < 2) {
                sq += __shfl_xor(sq, 1); sq += __shfl_xor(sq, 2); sq += __shfl_xor(sq, 4); sq += __shfl_xor(sq, 8);
                const float rn = rsqrtf(sq + EPS) * (X == 0 ? 0.08838834764831845f : 1.f);
#pragma unroll
                for (int e = 0; e < 8; ++e) y[r][e] *= rn;
            }
#pragma unroll
            for (int e = 0; e < 8; ++e) { if (X == 0) qv[r][e] = y[r][e]; else if (X == 1) kv[r][e] = y[r][e]; else vv[r][e] = y[r][e]; }
        }
    }
    {
        u32x4 raw[2][3]; f32x4 gw[2][2];
#pragma unroll
        for (int r = 0; r < 2; ++r) { const size_t grow = (size_t)n * 64 + 2 * rg + r;
            raw[r][0] = __builtin_nontemporal_load((const u32x4*)(proj + grow * NIN + C_QB + h * DH + 8 * l16));
            raw[r][1] = __builtin_nontemporal_load((const u32x4*)(proj + grow * NIN + C_KB + h * DH + 8 * l16));
            raw[r][2] = __builtin_nontemporal_load((const u32x4*)(proj + grow * NIN + C_VB + h * DH + 8 * l16)); }
#pragma unroll
        for (int X = 0; X < 2; ++X) { const float* nwp = (X == 0 ? P.q_norm : P.k_norm) + 8 * l16; gw[X][0] = *(const f32x4*)nwp; gw[X][1] = *(const f32x4*)(nwp + 4); }
#pragma unroll
        for (int r = 0; r < 2; ++r) {
            const size_t grow = (size_t)n * 64 + 2 * rg + r;
#pragma unroll
            for (int X = 0; X < 2; ++X) {
                bf16_t* ptr = proj + grow * NIN + (X == 0 ? C_QB : C_KB) + h * DH + 8 * l16;
                float f[8]; unpack8(raw[r][X], f);
                float sq = 0.f;
#pragma unroll
                for (int e = 0; e < 8; ++e) sq += f[e] * f[e];
                sq += __shfl_xor(sq, 1); sq += __shfl_xor(sq, 2); sq += __shfl_xor(sq, 4); sq += __shfl_xor(sq, 8);
                const float rn = rsqrtf(sq * (1.f / DH) + EPS);
#pragma unroll
                for (int e = 0; e < 8; ++e) f[e] = f[e] * rn * (e < 4 ? gw[X][0][e] : gw[X][1][e - 4]);
                *(u32x4*)ptr = pack8f(f);
            }
            *(LAS u32x4*)(vst + (2 * rg + r) * 136 + 8 * l16) = raw[r][2];
        }
    }
    __syncthreads();
    {
        bf16_t* qd = (bf16_t*)(ws + WS_QD) + (size_t)item * 64 * 128;
        bf16_t* ktT = (bf16_t*)(ws + WS_KTT) + (size_t)item * 128 * 64;
        const float gl = gcs[63];
        float ktl[2][8];
#pragma unroll
        for (int r = 0; r < 2; ++r) {
            const int t = 2 * rg + r; const float gc = gcs[t], bt = gcs[64 + t];
            const float eg = __expf(gc), egl = __expf(gl - gc);
            float f[8];
#pragma unroll
            for (int e = 0; e < 8; ++e) f[e] = qv[r][e] * eg;
            *(u32x4*)(qd + ((((t >> 4) * 4 + (l16 >> 2)) * 64) + (l16 & 3) * 16 + (t & 15)) * 8) = pack8f(f);
#pragma unroll
            for (int e = 0; e < 8; ++e) ktl[r][e] = kv[r][e] * egl;
            *(LAS u32x4*)(qbf + t * 136 + 8 * l16) = pack8f(qv[r]);
            *(LAS u32x4*)(kbf + t * 136 + 8 * l16) = pack8f(kv[r]);
            LAS float* rr = Rr + t * 256 + 8 * l16;
            *(LAS f32x4*)(rr) = (f32x4){vv[r][0] * bt, vv[r][1] * bt, vv[r][2] * bt, vv[r][3] * bt};
            *(LAS f32x4*)(rr + 4) = (f32x4){vv[r][4] * bt, vv[r][5] * bt, vv[r][6] * bt, vv[r][7] * bt};
            const float be = bt * eg;
            *(LAS f32x4*)(rr + 128) = (f32x4){kv[r][0] * be, kv[r][1] * be, kv[r][2] * be, kv[r][3] * be};
            *(LAS f32x4*)(rr + 132) = (f32x4){kv[r][4] * be, kv[r][5] * be, kv[r][6] * be, kv[r][7] * be};
        }
#pragma unroll
        for (int e = 0; e < 8; ++e) { const int t0 = 2 * rg; *(unsigned*)(ktT + (((((l16 >> 1) * 2 + (t0 >> 5)) * 64) + ((t0 >> 3) & 3) * 16 + 8 * (l16 & 1) + e) * 8 + (t0 & 7))) = pk2(ktl[0][e], ktl[1][e]); }
        if (tid == 0) ((float*)(ws + WS_TAIL))[item] = __expf(gl);
        bf16_t* vt = (bf16_t*)(ws + WS_VT);
        const int d = tid & 127, tg = tid >> 7;
        unsigned pw[8];
#pragma unroll
        for (int i = 0; i < 8; ++i) { const unsigned lo = vst[(16 * tg + 2 * i) * 136 + d], hi = vst[(16 * tg + 2 * i + 1) * 136 + d]; pw[i] = lo | (hi << 16); }
        bf16_t* dst = vt + (size_t)(h * DH + d) * M + n * 64 + 16 * tg;
        *(u32x4*)dst = (u32x4){pw[0], pw[1], pw[2], pw[3]}; *(u32x4*)(dst + 8) = (u32x4){pw[4], pw[5], pw[6], pw[7]};
    }
    __syncthreads();
    {
        const int fr = lane & 15, fq = lane >> 4, which = wave >> 2, ti = wave & 3;
        LAS bf16_t* X = which ? qbf : kbf;
        bf16x8 a[4];
#pragma unroll
        for (int s = 0; s < 4; ++s) a[s] = *(const LAS bf16x8*)(X + (16 * ti + fr) * 136 + 32 * s + 8 * fq);
        bf16_t* aqk = (bf16_t*)(ws + WS_AQK) + (size_t)item * 64 * 64;
        for (int tj = 0; tj < 4; ++tj) {
            f32x4 c = {0.f, 0.f, 0.f, 0.f};
            if (tj <= ti) {
#pragma unroll
                for (int s = 0; s < 4; ++s) { const bf16x8 b = *(const LAS bf16x8*)(kbf + (16 * tj + fr) * 136 + 32 * s + 8 * fq); c = MFMA16(a[s], b, c); }
            }
            const int j = 16 * tj + fr; const float gj = gcs[j];
#pragma unroll
            for (int r = 0; r < 4; ++r) {
                const int i = 16 * ti + 4 * fq + r;
                const float dec = (i >= j) ? __expf(gcs[i] - gj) : 0.f;
                if (which == 0) { Lm[i * 68 + j] = (i > j) ? gcs[64 + i] * c[r] * dec : 0.f; }
                else { const float v = (i >= j) ? c[r] * dec : 0.f; aqk[((((i >> 4) * 2 + (j >> 5)) * 64) + ((j >> 3) & 3) * 16 + (i & 15)) * 8 + (j & 7)] = (bf16_t)(pk2(v, 0.f) & 0xffffu); }
            }
        }
    }
    __syncthreads();
    if (tid < 256) {
        int Lrow[64];
#pragma unroll
        for (int i = 0; i < 64; ++i) Lrow[i] = __float_as_int(Lm[i * 68 + lane]);
        float s[64];
#define LRD(i, j) __int_as_float(__builtin_amdgcn_readlane(Lrow[i], j))
#pragma unroll
        for (int g = 0; g < 16; ++g) {
            const int i0 = 4 * g;
            float a0 = Rr[(i0 + 0) * 256 + tid], a1 = Rr[(i0 + 1) * 256 + tid], a2 = Rr[(i0 + 2) * 256 + tid], a3 = Rr[(i0 + 3) * 256 + tid];
            if (!(pflags & 8)) {
#pragma unroll
            for (int j = 0; j < i0; ++j) { const float sj = s[j]; a0 -= LRD(i0, j) * sj; a1 -= LRD(i0 + 1, j) * sj; a2 -= LRD(i0 + 2, j) * sj; a3 -= LRD(i0 + 3, j) * sj; }
            a1 -= LRD(i0 + 1, i0) * a0;
            a2 -= LRD(i0 + 2, i0) * a0; a2 -= LRD(i0 + 2, i0 + 1) * a1;
            a3 -= LRD(i0 + 3, i0) * a0; a3 -= LRD(i0 + 3, i0 + 1) * a1; a3 -= LRD(i0 + 3, i0 + 2) * a2;
            }
            s[i0] = a0; s[i0 + 1] = a1; s[i0 + 2] = a2; s[i0 + 3] = a3;
        }
#undef LRD
        if (pflags & 32) { if (s[63] == 1.2345f) ((float*)(ws + WS_U))[tid] = s[5]; } else
        if (tid < 128) { float* u = (float*)(ws + WS_U) + (size_t)item * 64 * 128 + ((tid >> 4) * 256 + (tid & 15)) * 4;
#pragma unroll
            for (int i4 = 0; i4 < 16; ++i4) *(f32x4*)(u + ((i4 >> 2) * 64 + (i4 & 3) * 16) * 4) = (f32x4){s[4 * i4], s[4 * i4 + 1], s[4 * i4 + 2], s[4 * i4 + 3]}; }
        else { const int dk = tid - 128; bf16_t* w = (bf16_t*)(ws + WS_W) + (size_t)item * 64 * 128 + (((dk >> 5) * 64) + ((dk >> 3) & 3) * 16) * 8 + (dk & 7);
#pragma unroll
            for (int i = 0; i < 64; ++i) w[((i >> 4) * 256 + (i & 15)) * 8] = (bf16_t)(pk2(s[i], 0.f) & 0xffffu); }
    }
    __syncthreads();
}

struct ScanA { bf16x8 W[4], K0[2], K1[2]; f32x4 u; float tl; };
struct ScanB { bf16x8 Q[4], A[2]; };
struct ScanOff { unsigned w, aq, kt, u; };
__device__ __forceinline__ void scan_loadA(ScanA& o, const unsigned char* ws, int c, int h, const ScanOff& f) {
    const int item = c * 8 + h;
    const unsigned char* w = ws + WS_W + (size_t)item * 16384; const unsigned char* kt = ws + WS_KTT + (size_t)item * 16384; const unsigned char* u = ws + WS_U + (size_t)item * 32768;
#pragma unroll
    for (int s = 0; s < 4; ++s) o.W[s] = __builtin_bit_cast(bf16x8, *(const u32x4*)(w + f.w + 1024 * s));
#pragma unroll
    for (int s = 0; s < 2; ++s) { o.K0[s] = __builtin_bit_cast(bf16x8, *(const u32x4*)(kt + f.kt + 1024 * s)); o.K1[s] = __builtin_bit_cast(bf16x8, *(const u32x4*)(kt + f.kt + 2048 + 1024 * s)); }
    o.u = *(const f32x4*)(u + f.u);
    o.tl = ((const float*)(ws + WS_TAIL))[item];
}
__device__ __forceinline__ void scan_loadB(ScanB& o, const unsigned char* ws, int c, int h, const ScanOff& f) {
    const int item = c * 8 + h;
    const unsigned char* qd = ws + WS_QD + (size_t)item * 16384; const unsigned char* aq = ws + WS_AQK + (size_t)item * 8192;
#pragma unroll
    for (int s = 0; s < 4; ++s) o.Q[s] = __builtin_bit_cast(bf16x8, *(const u32x4*)(qd + f.w + 1024 * s));
#pragma unroll
    for (int s = 0; s < 2; ++s) o.A[s] = __builtin_bit_cast(bf16x8, *(const u32x4*)(aq + f.aq + 1024 * s));
}
__device__ __forceinline__ void scan_stepA(const ScanA& cur, f32x4& S0, f32x4& S1, LAS bf16_t* Sl, LAS bf16_t* Vl, int fr, int fq, int mt) {
    f32x4 wsv = {0.f, 0.f, 0.f, 0.f};
#pragma unroll
    for (int s = 0; s < 4; ++s) wsv = MFMA16(cur.W[s], *(const LAS bf16x8*)(Sl + fr * 136 + 32 * s + 8 * fq), wsv);
    const f32x4 vn = cur.u - wsv;
    { u32x2 pv; pv.x = pk2(vn[0], vn[1]); pv.y = pk2(vn[2], vn[3]); *(LAS u32x2*)(Vl + fr * 72 + 16 * mt + 4 * fq) = pv; }
    __syncthreads();
    S0 = S0 * cur.tl; S1 = S1 * cur.tl;
#pragma unroll
    for (int s = 0; s < 2; ++s) { const bf16x8 Vb = *(const LAS bf16x8*)(Vl + fr * 72 + 32 * s + 8 * fq); S0 = MFMA16(cur.K0[s], Vb, S0); S1 = MFMA16(cur.K1[s], Vb, S1); }
    { u32x2 p0, p1; p0.x = pk2(S0[0], S0[1]); p0.y = pk2(S0[2], S0[3]); p1.x = pk2(S1[0], S1[1]); p1.y = pk2(S1[2], S1[3]);
      *(LAS u32x2*)(Sl + fr * 136 + 32 * mt + 4 * fq) = p0; *(LAS u32x2*)(Sl + fr * 136 + 32 * mt + 16 + 4 * fq) = p1; }
    __syncthreads();
}
__device__ __forceinline__ void scan_stepB(const ScanB& cur, const LAS bf16_t* Sl, const LAS bf16_t* Vl, bf16_t* og, int fr, int fq) {
    f32x4 qs = {0.f, 0.f, 0.f, 0.f};
#pragma unroll
    for (int s = 0; s < 4; ++s) qs = MFMA16(*(const LAS bf16x8*)(Sl + fr * 136 + 32 * s + 8 * fq), cur.Q[s], qs);
    __syncthreads();
#pragma unroll
    for (int s = 0; s < 2; ++s) qs = MFMA16(*(const LAS bf16x8*)(Vl + fr * 72 + 32 * s + 8 * fq), cur.A[s], qs);
    { u32x2 w; w.x = pk2(qs[0], qs[1]); w.y = pk2(qs[2], qs[3]); *(u32x2*)og = w; }
    __syncthreads();
}
__device__ __forceinline__ void scan_wg(const Params& P, LAS unsigned char* lds, int h, int pair, const int VAR) {
    const int tid = opaque_tid(), lane = tid & 63, wave = tid >> 6, fr = lane & 15, fq = lane >> 4, mt = wave & 3, e0 = 16 * pair;
    const unsigned char* ws = P.ws;
    LAS bf16_t* Sl = (LAS bf16_t*)(lds);
    LAS bf16_t* Vl = (LAS bf16_t*)(lds + 4352);
    for (int i = tid; i < 4352 / 4; i += 512) ((LAS unsigned*)Sl)[i] = 0u;
    ScanOff f; f.w = (unsigned)(mt * 4096 + lane * 16); f.aq = (unsigned)(mt * 2048 + lane * 16); f.kt = (unsigned)(mt * 4096 + lane * 16); f.u = (unsigned)((((e0 >> 4) * 4 + mt) * 64 + lane) * 16);
    if (wave < 4) {
        f32x4 S0 = {0.f, 0.f, 0.f, 0.f}, S1 = {0.f, 0.f, 0.f, 0.f};
        ScanA a, b, c3; scan_loadA(a, ws, 0, h, f); scan_loadA(b, ws, 1, h, f);
        __syncthreads();
#pragma unroll 1
        for (int c = 0; c < NCH - 2; c += 3) {
            if (VAR != 3) scan_loadA(c3, ws, c + 2, h, f); scan_stepA(a, S0, S1, Sl, Vl, fr, fq, mt);
            if (VAR != 3) scan_loadA(a, ws, c + 3, h, f); scan_stepA(b, S0, S1, Sl, Vl, fr, fq, mt);
            if (VAR != 3) scan_loadA(b, ws, c + 4, h, f); scan_stepA(VAR == 3 ? a : c3, S0, S1, Sl, Vl, fr, fq, mt);
        }
        scan_stepA(a, S0, S1, Sl, Vl, fr, fq, mt); scan_stepA(b, S0, S1, Sl, Vl, fr, fq, mt);
    } else {
        bf16_t* Og = (bf16_t*)(P.ws + (VAR ? WS_END : WS_YA)) + (size_t)(16 * mt + fr) * 1024 + h * DH + e0 + 4 * fq;
        ScanB a, b, c3; scan_loadB(a, ws, 0, h, f); scan_loadB(b, ws, 1, h, f);
        __syncthreads();
#pragma unroll 1
        for (int c = 0; c < NCH - 2; c += 3) {
            if (VAR != 3) scan_loadB(c3, ws, c + 2, h, f); scan_stepB(a, Sl, Vl, Og + (size_t)c * 65536, fr, fq);
            if (VAR != 3) scan_loadB(a, ws, c + 3, h, f); scan_stepB(b, Sl, Vl, Og + (size_t)(c + 1) * 65536, fr, fq);
            if (VAR != 3) scan_loadB(b, ws, c + 4, h, f); scan_stepB(VAR == 3 ? a : c3, Sl, Vl, Og + (size_t)(c + 2) * 65536, fr, fq);
        }
        scan_stepB(a, Sl, Vl, Og + (size_t)(NCH - 2) * 65536, fr, fq); scan_stepB(b, Sl, Vl, Og + (size_t)(NCH - 1) * 65536, fr, fq);
    }
}

__device__ __forceinline__ void scan_helper(const Params& P, int h, int j, int NHp) {
    const int tid = threadIdx.x;
    const unsigned char* ws = P.ws;
    unsigned* prog = (unsigned*)(P.ws + WS_PROG) + h * 32;
    for (int c = j; c < NCH; c += NHp) {
        for (;;) { const unsigned pr = __hip_atomic_load(prog, __ATOMIC_RELAXED, __HIP_MEMORY_SCOPE_AGENT); if ((int)pr + 16 >= c) break; __builtin_amdgcn_s_sleep(16); }
        const int item = c * 8 + h;
        const u32x4* w16 = (const u32x4*)(ws + WS_W + (size_t)item * 16384); const u32x4* q16 = (const u32x4*)(ws + WS_QD + (size_t)item * 16384);
        const u32x4* k16 = (const u32x4*)(ws + WS_KTT + (size_t)item * 16384); const u32x4* a16 = (const u32x4*)(ws + WS_AQK + (size_t)item * 8192);
        const u32x4* u16 = (const u32x4*)(ws + WS_U + (size_t)item * 32768);
        u32x4 v[11];
        v[0] = w16[tid]; v[1] = w16[512 + tid]; v[2] = q16[tid]; v[3] = q16[512 + tid]; v[4] = k16[tid]; v[5] = k16[512 + tid]; v[6] = a16[tid];
        v[7] = u16[tid]; v[8] = u16[512 + tid]; v[9] = u16[1024 + tid]; v[10] = u16[1536 + tid];
#pragma unroll
        for (int i = 0; i < 11; ++i) asm volatile("" :: "v"(v[i]));
    }
}

constexpr int AL_K = 0, AL_V = 2 * 64 * 272, AL_B = AL_V + 2 * 128 * 144;
__device__ __forceinline__ void attn_compute(const LAS unsigned char* Kl, const LAS unsigned char* Vl, const LAS float* biasl, const bf16x8 (&Qb)[4], f32x4 (&Ot)[8], float& mrun, float& lrun,
                                             int c, int qi, int fr, int fq) {
    const float scale = 0.08838834764831845f;
    f32x4 st[4]; float mx = -1e30f;
#pragma unroll
    for (int kt = 0; kt < 4; ++kt) {
        f32x4 a = {0.f, 0.f, 0.f, 0.f};
#pragma unroll
        for (int s = 0; s < 4; ++s) a = MFMA16(*(const LAS bf16x8*)(Kl + (16 * kt + fr) * 272 + 64 * s + 16 * fq), Qb[s], a);
#pragma unroll
        for (int r = 0; r < 4; ++r) {
            const int ki = c * 64 + 16 * kt + 4 * fq + r; int dd = qi - ki; dd = dd < -63 ? -63 : (dd > 128 ? 128 : dd);
            a[r] = a[r] * scale + biasl[dd + 63]; mx = fmaxf(mx, a[r]);
        }
        st[kt] = a;
    }
    mx = fmaxf(mx, __shfl_xor(mx, 16)); mx = fmaxf(mx, __shfl_xor(mx, 32));
    const float mnew = fmaxf(mrun, mx), alpha = __expf(mrun - mnew); mrun = mnew;
    float rsum = 0.f;
#pragma unroll
    for (int kt = 0; kt < 4; ++kt)
#pragma unroll
        for (int r = 0; r < 4; ++r) { const float p = __expf(st[kt][r] - mnew); st[kt][r] = p; rsum += p; }
    lrun = lrun * alpha + rsum;
    bf16x8 Pb[2];
#pragma unroll
    for (int s = 0; s < 2; ++s) Pb[s] = pack_acc(st[2 * s], st[2 * s + 1]);
#pragma unroll
    for (int dt = 0; dt < 8; ++dt) {
        f32x4 o = Ot[dt] * alpha;
#pragma unroll
        for (int s = 0; s < 2; ++s) { const LAS unsigned char* pv = Vl + (16 * dt + fr) * 144 + 64 * s + 8 * fq;
            const u32x2 lo = *(const LAS u32x2*)pv, hi = *(const LAS u32x2*)(pv + 32); u32x4 av; av.x = lo.x; av.y = lo.y; av.z = hi.x; av.w = hi.y;
            o = MFMA16(__builtin_bit_cast(bf16x8, av), Pb[s], o); }
        Ot[dt] = o;
    }
}
__device__ __forceinline__ void attn_item(const Params& P, LAS unsigned char* lds, int m, int h) {
    const int tid = opaque_tid(), lane = tid & 63, wave = tid >> 6, fr = lane & 15, fq = lane >> 4;
    unsigned char* ws = P.ws;
    const bf16_t* proj = (const bf16_t*)(ws + WS_PROJ); const bf16_t* vt = (const bf16_t*)(ws + WS_VT); bf16_t* yb = (bf16_t*)(ws + WS_YB);
    LAS float* biasl = (LAS float*)(lds + AL_B);
    const int nq = 2 * m + (wave >> 2), w4 = wave & 3;
    const int qi = nq * 64 + 16 * w4 + fr;
    const int cbeg = 2 * m - 8 < 0 ? 0 : 2 * m - 8, cend = 2 * m + 1;
    const bf16_t* kg[2]; const bf16_t* vg[2]; int kl[2], vl[2];
#pragma unroll
    for (int i = 0; i < 2; ++i) { const int p = tid + 512 * i;
        kg[i] = proj + (size_t)(p >> 4) * NIN + C_KB + h * DH + 8 * (p & 15); kl[i] = (p >> 4) * 272 + 16 * (p & 15);
        vg[i] = vt + (size_t)(h * DH + (p >> 3)) * M + 8 * (p & 7); vl[i] = (p >> 3) * 144 + 16 * (p & 7); }
#define ATT_LOAD(KR, VR, C) do { _Pragma("unroll") for (int i = 0; i < 2; ++i) { KR[i] = *(const u32x4*)(kg[i] + (size_t)(C) * 64 * NIN); VR[i] = *(const u32x4*)(vg[i] + (C) * 64); } } while (0)
#define ATT_WRITE(KR, VR, BUF) do { _Pragma("unroll") for (int i = 0; i < 2; ++i) { *(LAS u32x4*)(lds + AL_K + (BUF) * (64 * 272) + kl[i]) = KR[i]; *(LAS u32x4*)(lds + AL_V + (BUF) * (128 * 144) + vl[i]) = VR[i]; } } while (0)
    u32x4 kA[2], vA[2], kB[2], vB[2];
    ATT_LOAD(kA, vA, cbeg);
    ATT_LOAD(kB, vB, cbeg + 1);
    if (tid < 192) biasl[tid] = P.rel_bias[h * 192 + tid];
    bf16x8 Qb[4];
#pragma unroll
    for (int s = 0; s < 4; ++s) Qb[s] = ld8(proj + (size_t)qi * NIN + C_QB + h * DH + 32 * s + 8 * fq);
    ATT_WRITE(kA, vA, 0);
    __syncthreads();
    float mrun = -1e30f, lrun = 0.f;
    f32x4 Ot[8];
#pragma unroll
    for (int i = 0; i < 8; ++i) Ot[i] = (f32x4){0.f, 0.f, 0.f, 0.f};
#pragma unroll 1
    for (int c = cbeg; c <= cend; c += 2) {
        if (c + 2 <= cend) ATT_LOAD(kA, vA, c + 2);
        if (c >= nq - 8 && c <= nq) attn_compute(lds + AL_K, lds + AL_V, biasl, Qb, Ot, mrun, lrun, c, qi, fr, fq);
        if (c + 1 <= cend) ATT_WRITE(kB, vB, 1);
        __syncthreads();
        if (c + 1 > cend) break;
        if (c + 3 <= cend) ATT_LOAD(kB, vB, c + 3);
        if (c + 1 >= nq - 8 && c + 1 <= nq) attn_compute(lds + AL_K + 64 * 272, lds + AL_V + 128 * 144, biasl, Qb, Ot, mrun, lrun, c + 1, qi, fr, fq);
        if (c + 2 <= cend) ATT_WRITE(kA, vA, 0);
        __syncthreads();
    }
#undef ATT_LOAD
#undef ATT_WRITE
    lrun += __shfl_xor(lrun, 16); lrun += __shfl_xor(lrun, 32);
    const float inv = 1.f / lrun;
#pragma unroll
    for (int dt = 0; dt < 8; ++dt) { u32x2 w; w.x = pk2(Ot[dt][0] * inv, Ot[dt][1] * inv); w.y = pk2(Ot[dt][2] * inv, Ot[dt][3] * inv);
        *(u32x2*)(yb + (size_t)qi * 1024 + h * DH + 16 * dt + 4 * fq) = w; }
}

__device__ __forceinline__ void phase_gnorm(const Params& P, int G) {
    unsigned char* ws = P.ws;
    bf16_t* ya = (bf16_t*)(ws + WS_YA); const bf16_t* proj = (const bf16_t*)(ws + WS_PROJ);
    const int gt = blockIdx.x * 512 + opaque_tid(), l16 = gt & 15;
    const f32x4 w0 = *(const f32x4*)(P.gdn_norm + 8 * l16), w1 = *(const f32x4*)(P.gdn_norm + 8 * l16 + 4);
    const int stride = (G * 512) >> 4;
    for (int g0 = gt >> 4; g0 < M * NH; g0 += 4 * stride) {
        u32x4 ro[4], rz[4]; bf16_t* po[4];
#pragma unroll
        for (int q = 0; q < 4; ++q) { const int g = g0 + q * stride; const int row = g >> 3, h = g & 7;
            po[q] = ya + (size_t)row * 1024 + h * DH + 8 * l16;
            if (g < M * NH) { ro[q] = *(const u32x4*)po[q]; rz[q] = __builtin_nontemporal_load((const u32x4*)(proj + (size_t)row * NIN + C_Z + h * DH + 8 * l16)); } }
#pragma unroll
        for (int q = 0; q < 4; ++q) if (g0 + q * stride < M * NH) {
            float o[8], z[8]; unpack8(ro[q], o); unpack8(rz[q], z);
            float sq = 0.f;
#pragma unroll
            for (int e = 0; e < 8; ++e) sq += o[e] * o[e];
            sq += __shfl_xor(sq, 1); sq += __shfl_xor(sq, 2); sq += __shfl_xor(sq, 4); sq += __shfl_xor(sq, 8);
            const float rn = rsqrtf(sq * (1.f / DH) + EPS);
#pragma unroll
            for (int e = 0; e < 8; ++e) o[e] = o[e] * rn * (e < 4 ? w0[e] : w1[e - 4]) * siluf_(z[e]);
            *(u32x4*)po[q] = pack8f(o);
        }
    }
}

#define XB_TMO      128
#define XB_XCNT(j)  (256  + 64 * (j))
#define XB_XSUB(j)  (1280 + 64 * (j))
#define XB_XGEN(j)  (2304 + 64 * (j))
#define XB_TOP      3328
#define XB_TOPGEN   3392
#define XCD_BAR_WORDS 3456
#define XB_SPIN_CAP (1u << 18)
__device__ __forceinline__ unsigned xb_ld(unsigned* p)              { return __hip_atomic_load(p, __ATOMIC_RELAXED, __HIP_MEMORY_SCOPE_AGENT); }
__device__ __forceinline__ unsigned xb_add(unsigned* p, unsigned v) { return __hip_atomic_fetch_add(p, v, __ATOMIC_RELAXED, __HIP_MEMORY_SCOPE_AGENT); }
__device__ __forceinline__ unsigned xb_xcc_id() { return (unsigned)__builtin_amdgcn_s_getreg((3 << 11) | 20) & 0xFu; }
#define XB_SPIN(cond, bar) do { unsigned _sp = 0; while (cond) { __builtin_amdgcn_s_sleep(1); \
    if ((++_sp & 255u) == 0u) { if (xb_ld(&(bar)[XB_TMO])) break; if (_sp > XB_SPIN_CAP) { atomicAdd(&(bar)[XB_TMO], 1u); break; } } } } while (0)
struct XcdBarrier { unsigned* bar; unsigned x; volatile LAS unsigned* st; };
__device__ __forceinline__ XcdBarrier xcd_barrier_post(unsigned* bar, volatile LAS unsigned* st) {
    XcdBarrier b; b.bar = bar; b.x = xb_xcc_id(); b.st = st;
    if (threadIdx.x == 0) (void)xb_add(&bar[XB_XCNT(b.x)], 1u);
    return b;
}
__device__ __forceinline__ void xcd_barrier_complete(unsigned* bar, unsigned x, unsigned& nloc, unsigned& nx) {
    const unsigned G = gridDim.x * gridDim.y * gridDim.z;
    unsigned sum, cnt, mine, sp = 0u;
    for (;;) {
        sum = 0u; cnt = 0u; mine = 0u;
#pragma unroll
        for (unsigned j = 0; j < 16; ++j) { const unsigned c = xb_ld(&bar[XB_XCNT(j)]); sum += c; cnt += (c > 0u) ? 1u : 0u; mine = (j == x) ? c : mine; }
        if (sum == G) break;
        __builtin_amdgcn_s_sleep(1);
        if ((++sp & 255u) == 0u) { if (xb_ld(&bar[XB_TMO])) break; if (sp > XB_SPIN_CAP) { atomicAdd(&bar[XB_TMO], 1u); break; } }
    }
    nloc = mine > 0u ? mine : 1u; nx = cnt > 0u ? cnt : 1u;
}
__device__ __forceinline__ void xcd_barrier(const XcdBarrier& b) {
    asm volatile("s_waitcnt vmcnt(0)" ::: "memory");
    __syncthreads();
    if (threadIdx.x == 0) {
        unsigned* bar = b.bar;
        __builtin_amdgcn_s_waitcnt(0);
        unsigned nloc = b.st[0], nx = b.st[1];
        if (nloc == 0u) { xcd_barrier_complete(bar, b.x, nloc, nx); b.st[0] = nloc; b.st[1] = nx; }
        const unsigned old = xb_add(&bar[XB_XSUB(b.x)], 1u);
        const unsigned gen = old / nloc;
        if (old + 1u == (gen + 1u) * nloc) {
            __builtin_amdgcn_fence(__ATOMIC_RELEASE, "agent");
            asm volatile("s_waitcnt vmcnt(0)" ::: "memory");
            const unsigned og = xb_add(&bar[XB_TOP], 1u);
            const unsigned tg = og / nx;
            if (og + 1u == (tg + 1u) * nx) xb_add(&bar[XB_TOPGEN], 1u);
            else XB_SPIN(xb_ld(&bar[XB_TOPGEN]) == tg, bar);
            __builtin_amdgcn_fence(__ATOMIC_ACQUIRE, "agent");
            xb_add(&bar[XB_XGEN(b.x)], 1u);
            asm volatile("s_waitcnt vmcnt(0)" ::: "memory");
        } else {
            XB_SPIN(xb_ld(&bar[XB_XGEN(b.x)]) == gen, bar);
            __builtin_amdgcn_fence(__ATOMIC_ACQUIRE, "agent");
            asm volatile("s_waitcnt vmcnt(0)" ::: "memory");
        }
    }
    __syncthreads();
}

constexpr int NPHASE = 11;
__global__ void __launch_bounds__(512, 2) fwd_megakernel(Params P) {
    extern __shared__ __attribute__((aligned(16))) unsigned char smem[];
    LAS unsigned char* lds = (LAS unsigned char*)smem;
    cg::grid_group grid = cg::this_grid();
    const int G = gridDim.x, lo = P.ph_lo, hi = P.ph_hi & 255, pflags = P.ph_hi >> 8;
    unsigned char* ws = P.ws;
    float* ss = (float*)(ws + WS_SS);
    bf16_t* xb = (bf16_t*)(ws + WS_XB); bf16_t* act = (bf16_t*)(ws + WS_ACT); bf16_t* proj = (bf16_t*)(ws + WS_PROJ);
#ifndef NREP5
#define NREP5 1
#endif
#ifndef REP_PHASE
#define REP_PHASE -1
#endif
#define IN(k) (lo <= (k) && (k) < hi)
    volatile LAS unsigned* xst = (volatile LAS unsigned*)(lds + LDS_BYTES - 16);
    if (threadIdx.x == 0) { xst[0] = 0u; xst[1] = 0u; }
    __syncthreads();
    XcdBarrier xbar = xcd_barrier_post((unsigned*)(ws + WS_BAR), xst);
    if (lo < 0) grid.sync();
#define SEAM(k) do { if (IN(k) && IN((k) + 1)) xcd_barrier(xbar); } while (0)
    for (int rep = 0; rep < (REP_PHASE == 0 ? 2 : 1); ++rep) { if (IN(0)) phase_convert(P, lds, G);
    SEAM(0); }
    for (int rep = 0; rep < (REP_PHASE == 1 ? 2 : 1); ++rep) {
    if (IN(1)) { pg8::Sched S; S.init(xb, (const bf16_t*)(ws + WS_WGU1), nullptr, nullptr, M, NGU, G, blockIdx.x, 0); EpiGU E{act, ss}; pg8::gemm_phase(lds, D, S, E);
        idle_convert(P, lds, (M / 256) * (NGU / 256), G, -1, 0); }
    SEAM(1); }
    if (IN(2)) { pg8::Sched S; S.init(act, (const bf16_t*)(ws + WS_WD1), nullptr, nullptr, M, D, G, blockIdx.x, 0); EpiRes E{P.x, P.out, xb, ss + M, 0.5f}; pg8::gemm_phase(lds, FF, S, E); }
    SEAM(2);
    if (IN(3)) { pg8::Sched S; S.init(xb, (const bf16_t*)(ws + WS_WIN), nullptr, nullptr, M, NIN, G, blockIdx.x, 0); EpiProj E{proj, ss + M}; pg8::gemm_phase(lds, D, S, E);
        idle_convert(P, lds, (M / 256) * (NIN / 256), G, 0, LATE_A); }
    SEAM(3);
    if (IN(4)) { const int nit = (NCH * NH - 1 - (int)blockIdx.x) / G; for (int k = nit; k >= 0; --k) prep_item(P, lds, blockIdx.x + k * G, pflags); }
    SEAM(4);
_Pragma("unroll 1")
    for (int rep = 0; rep < NREP5; ++rep) {
    if (IN(5)) {
        const int tid5 = opaque_tid(), wave = tid5 >> 6, b = blockIdx.x;
        if (b < 64) { if (!(pflags & 4)) scan_wg(P, lds, b & 7, b >> 3, 0); }
        else { if (!(pflags & 2)) for (int it = b - 64; it < (NCH / 2) * NH; it += G - 64) attn_item(P, lds, it >> 3, it & 7);
            if (!(pflags & 1)) convert_late(P, (LAS float*)(lds + wave * 17408), ((((M / 256) * (NIN / 256)) % G) ? LATE_A : 0), ((((M / 256) * (NGU / 256)) % G) ? LATE_C : N_LATE), (b - 64) * 8 + wave, (G - 64) * 8, tid5 & 63); }
    }
    SEAM(5); }
    if (IN(6)) phase_gnorm(P, G);
    SEAM(6);
    if (IN(7)) { pg8::Sched S; S.init((const bf16_t*)(ws + WS_YA), (const bf16_t*)(ws + WS_WA), (const bf16_t*)(ws + WS_YB), (const bf16_t*)(ws + WS_WB), M, D, G, blockIdx.x, 1);
        EpiMix E{proj, (bf16_t*)(ws + WS_MIX)}; pg8::gemm_phase(lds, 1024, S, E); }
    SEAM(7);
    if (IN(8)) { pg8::Sched S; S.init((const bf16_t*)(ws + WS_MIX), (const bf16_t*)(ws + WS_WOUT), nullptr, nullptr, M, D, G, blockIdx.x, 0); EpiRes E{P.out, P.out, xb, ss + 2 * M, 1.0f}; pg8::gemm_phase(lds, D, S, E); }
    SEAM(8);
    if (IN(9)) { pg8::Sched S; S.init(xb, (const bf16_t*)(ws + WS_WGU2), nullptr, nullptr, M, NGU, G, blockIdx.x, 0); EpiGU E{act, ss + 2 * M}; pg8::gemm_phase(lds, D, S, E);
        idle_convert(P, lds, (M / 256) * (NGU / 256), G, LATE_C, N_LATE); }
    SEAM(9);
    if (IN(10)) { pg8::Sched S; S.init(act, (const bf16_t*)(ws + WS_WD2), nullptr, nullptr, M, D, G, blockIdx.x, 0); EpiRes E{P.out, P.out, xb, ss + 3 * M, 0.5f}; pg8::gemm_phase(lds, FF, S, E); }
    SEAM(10);
    if (IN(11)) {
        { pg8::Sched S; S.init((const bf16_t*)(ws + WS_PB), (const bf16_t*)(ws + WS_WPP), nullptr, nullptr, M, D, G, blockIdx.x, 0); EpiF32 E{(float*)(ws + WS_RBUF)}; pg8::gemm_phase(lds, PLE, S, E); }
        { pg8::Sched S; S.init(xb, (const bf16_t*)(ws + WS_WPG), nullptr, nullptr, M, D, G, blockIdx.x, 0); EpiPle E{P.out, (const float*)(ws + WS_RBUF), ss + 3 * M}; pg8::gemm_phase(lds, D, S, E); }
    }
#undef IN
#undef SEAM
}


#ifdef PROBE_VAR
__global__ void __launch_bounds__(512, 2) probe_scan(Params P) {
    extern __shared__ __attribute__((aligned(16))) unsigned char smem[];
    scan_wg(P, (LAS unsigned char*)smem, blockIdx.x & 7, blockIdx.x >> 3, PROBE_VAR);
}
#endif
#ifndef N_LAUNCH_MODE
#define N_LAUNCH_MODE 0
#endif
extern "C" void kernel_launch(void* const* d_in, const int* in_sizes, int n_in, void* d_out, int out_size, void* d_ws, size_t ws_size, hipStream_t stream) {
    static int grid = 0;
    if (grid == 0) {
        if (n_in != 23 || out_size != M * D || ws_size < WS_END) { fprintf(stderr, "kernel_launch: unexpected problem (n_in %d out %d ws %zu need %zu)\n", n_in, out_size, ws_size, (size_t)WS_END); grid = -1; return; }
        int dev = 0, cus = 0, per_cu = 0;
        hipGetDevice(&dev); hipDeviceGetAttribute(&cus, hipDeviceAttributeMultiprocessorCount, dev);
        if (hipFuncSetAttribute((const void*)fwd_megakernel, hipFuncAttributeMaxDynamicSharedMemorySize, LDS_BYTES) != hipSuccess) { fprintf(stderr, "kernel_launch: hipFuncSetAttribute failed\n"); grid = -1; return; }
        if (hipOccupancyMaxActiveBlocksPerMultiprocessor(&per_cu, (const void*)fwd_megakernel, 512, LDS_BYTES) != hipSuccess || per_cu < 1) { fprintf(stderr, "kernel_launch: occupancy query failed (%d)\n", per_cu); (void)hipGetLastError(); per_cu = 1; }
        grid = cus * 1;
        if (grid < 192) { fprintf(stderr, "kernel_launch: grid too small\n"); grid = -1; return; }
    }
    if (grid < 0) return;
    if (hipMemsetAsync((char*)d_ws + WS_BAR, 0, 16384, stream) != hipSuccess) { fprintf(stderr, "kernel_launch: memset of the barrier words failed\n"); return; }
    Params p{};
    const float** pp = (const float**)&p;
    for (int i = 0; i < 23; ++i) pp[i] = (const float*)d_in[i];
    p.out = (float*)d_out; p.ws = (unsigned char*)d_ws;
#if N_LAUNCH_MODE == 0
    p.ph_lo = 0; p.ph_hi = NPHASE + 1;
    void* args[] = {&p};
    hipError_t e = hipLaunchCooperativeKernel((const void*)fwd_megakernel, dim3(grid), dim3(512), args, LDS_BYTES, stream);
    if (e != hipSuccess) fprintf(stderr, "cooperative launch failed: %s (grid %d)\n", hipGetErrorString(e), grid);
#ifdef PROBE_VAR
    hipLaunchKernelGGL(probe_scan, dim3(64), dim3(512), 16384, stream, p);
#endif
#ifdef PROBE_PHASE
    p.ph_lo = PROBE_PHASE; p.ph_hi = (PROBE_PHASE + 1) | (PROBE_FLAGS << 8); hipLaunchKernelGGL(fwd_megakernel, dim3(grid), dim3(512), LDS_BYTES, stream, p);
#endif
#else
    for (int ph = 0; ph <= NPHASE; ++ph) { p.ph_lo = ph; p.ph_hi = ph + 1; hipLaunchKernelGGL(fwd_megakernel, dim3(grid), dim3(512), LDS_BYTES, stream, p); }
#endif
}
```

```cpp
#include <hip/hip_runtime.h>
#include <hip/hip_cooperative_groups.h>
#include <cstdio>
namespace cg = cooperative_groups;

#define LAS __attribute__((address_space(3)))
typedef unsigned short bf16_t;
typedef short bf16x8 __attribute__((ext_vector_type(8)));
typedef float f32x4 __attribute__((ext_vector_type(4)));
typedef unsigned u32x4 __attribute__((ext_vector_type(4)));
typedef unsigned u32x2 __attribute__((ext_vector_type(2)));
typedef __bf16 bf16v2 __attribute__((ext_vector_type(2)));

constexpr int M = 8192, D = 2048, FF = 5632, NGU = 11264, NIN = 11520, NINSRC = 11280, PLE = 256;
constexpr int NH = 8, DH = 128, NCH = 128;
constexpr int C_QA = 0, C_KA = 1024, C_VA = 2048, C_Z = 3072, C_QB = 4096, C_KB = 5120, C_VB = 6144, C_GA = 7168, C_GB = 9216, C_AR = 11264, C_BR = 11272;
constexpr float EPS = 1e-6f;
constexpr size_t WS_WGU1 = 0;
constexpr size_t WS_WD1  = WS_WGU1 + (size_t)NGU * D * 2;
constexpr size_t WS_WIN  = WS_WD1 + (size_t)D * FF * 2;
constexpr size_t WS_WA   = WS_WIN + (size_t)NIN * D * 2;
constexpr size_t WS_WB   = WS_WA + (size_t)D * 1024 * 2;
constexpr size_t WS_WOUT = WS_WB + (size_t)D * 1024 * 2;
constexpr size_t WS_WGU2 = WS_WOUT + (size_t)D * D * 2;
constexpr size_t WS_WD2  = WS_WGU2 + (size_t)NGU * D * 2;
constexpr size_t WS_WPG  = WS_WD2 + (size_t)D * FF * 2;
constexpr size_t WS_WPP  = WS_WPG + (size_t)D * D * 2;
constexpr size_t WS_XB   = WS_WPP + (size_t)D * PLE * 2;
constexpr size_t WS_PROJ = WS_XB + (size_t)M * D * 2;
constexpr size_t WS_AQK  = WS_PROJ + (size_t)M * NIN * 2;
constexpr size_t WS_KTT  = WS_AQK + (size_t)1024 * 64 * 64 * 2;
constexpr size_t WS_PB   = WS_KTT + (size_t)M * 1024 * 2;
constexpr size_t WS_VT   = WS_PB + (size_t)M * PLE * 2;
constexpr size_t WS_SS   = WS_VT + (size_t)M * 1024 * 2;
constexpr size_t WS_TAIL = WS_SS + (size_t)4 * M * 4;
constexpr size_t WS_PROG = WS_TAIL + 4096;
constexpr size_t WS_BAR  = WS_PROG + 4096;
constexpr size_t WS_END  = WS_BAR + 16384;
constexpr size_t WS_ACT  = WS_PROJ;
constexpr size_t WS_RBUF = WS_PROJ;
constexpr size_t WS_U    = 0;
constexpr size_t WS_W    = WS_U + (size_t)M * 1024 * 4;
constexpr size_t WS_QD   = WS_W + (size_t)M * 1024 * 2;
constexpr size_t WS_MIX  = 0;
constexpr size_t WS_YB   = WS_XB;
constexpr size_t WS_YA   = WS_XB + (size_t)M * 1024 * 2;
static_assert(WS_QD + (size_t)M * 1024 * 2 <= WS_WIN, "gdn scratch overlaps live weights");

constexpr int LDS_BYTES = 147456;

__device__ __forceinline__ unsigned pk2(float lo, float hi) { bf16v2 v = {(__bf16)lo, (__bf16)hi}; return __builtin_bit_cast(unsigned, v); }
__device__ __forceinline__ float bf2f(bf16_t b) { return __uint_as_float(((unsigned)b) << 16); }
__device__ __forceinline__ float bflo(unsigned w) { return __uint_as_float(w << 16); }
__device__ __forceinline__ float bfhi(unsigned w) { return __uint_as_float(w & 0xffff0000u); }
__device__ __forceinline__ void unpack8(u32x4 w, float (&f)[8]) { f[0] = bflo(w.x); f[1] = bfhi(w.x); f[2] = bflo(w.y); f[3] = bfhi(w.y); f[4] = bflo(w.z); f[5] = bfhi(w.z); f[6] = bflo(w.w); f[7] = bfhi(w.w); }
__device__ __forceinline__ u32x4 pack8f(const float (&f)[8]) { u32x4 w; w.x = pk2(f[0], f[1]); w.y = pk2(f[2], f[3]); w.z = pk2(f[4], f[5]); w.w = pk2(f[6], f[7]); return w; }
__device__ __forceinline__ bf16x8 pack_acc(f32x4 a, f32x4 b) { u32x4 p; p.x = pk2(a[0], a[1]); p.y = pk2(a[2], a[3]); p.z = pk2(b[0], b[1]); p.w = pk2(b[2], b[3]); return __builtin_bit_cast(bf16x8, p); }
__device__ __forceinline__ bf16x8 ld2x8(const bf16_t* p0, const bf16_t* p1) { const u32x2 a = *(const u32x2*)p0, b = *(const u32x2*)p1; u32x4 v; v.x = a.x; v.y = a.y; v.z = b.x; v.w = b.y; return __builtin_bit_cast(bf16x8, v); }
__device__ __forceinline__ bf16x8 ld8(const bf16_t* p) { return __builtin_bit_cast(bf16x8, *(const u32x4*)p); }
__device__ __forceinline__ float sigmoidf_(float x) { return __builtin_amdgcn_rcpf(1.f + __expf(-x)); }
__device__ __forceinline__ float siluf_(float x) { return x * __builtin_amdgcn_rcpf(1.f + __expf(-x)); }
__device__ __forceinline__ float wave_sum(float v) {
#pragma unroll
    for (int o = 1; o < 64; o <<= 1) v += __shfl_xor(v, o);
    return v;
}
__device__ __forceinline__ int opaque_tid() { int t = threadIdx.x; asm volatile("" : "+v"(t)); return t; }
#define MFMA16(a, b, c) __builtin_amdgcn_mfma_f32_16x16x32_bf16((a), (b), (c), 0, 0, 0)

namespace pg8 {
constexpr int BM = 256, BK = 64, HALF = 128, HTB = HALF * BK * 2, STAGE_BYTES = 8 * HTB, NXCD = 8, WGM = 8;
__device__ __forceinline__ int lds_byte(int r, int c) { const int st = (r >> 4) * 2 + (c >> 5), rr = r & 15, cc = c & 31, ob = rr * 64 + cc * 2; return st * 1024 + (ob ^ (((ob >> 9) & 1) << 5)); }
__device__ __forceinline__ void stage_rc(int b, int& R, int& C) { const int st = b / 1024, sb = b % 1024, swz = sb ^ (((sb >> 9) & 1) << 5); R = (st >> 1) * 16 + swz / 64; C = (st & 1) * 32 + (swz % 64) / 2; }
__device__ __forceinline__ int perm32(int rho) { const int n = rho >> 4, i = rho & 15; return 8 * (i >> 2) + 4 * n + (i & 3); }

struct Unit { int pm, pn, sel; };
struct Sched {
    const bf16_t *A0, *B0, *A1, *B1;
    int nM, nN, nwg, G, c, dual;
    __device__ __forceinline__ void init(const bf16_t* a0, const bf16_t* b0, const bf16_t* a1, const bf16_t* b1, int Mr, int Nc, int G_, int c_, int dual_) {
        A0 = a0; B0 = b0; A1 = a1; B1 = b1; nM = Mr / BM; nN = Nc / BM; nwg = nM * nN; G = G_; c = c_; dual = dual_; }
    __device__ __forceinline__ bool next(int i, Unit& u) const {
        const int tile = dual ? (i >> 1) : i;
        const long L = (long)tile * G + c; if (L >= nwg) return false;
        int wgid = (int)L; { const int q = nwg / NXCD, r = nwg % NXCD, xcd = wgid % NXCD, off = wgid / NXCD; wgid = (xcd < r ? xcd * (q + 1) : r * (q + 1) + (xcd - r) * q) + off; }
        const int nig = WGM * nN, gid = wgid / nig, fm = gid * WGM, gsz = (nM - fm) < WGM ? (nM - fm) : WGM;
        u.pm = fm + ((wgid % nig) % gsz); u.pn = (wgid % nig) / gsz; u.sel = dual ? (i & 1) : 0; return true;
    }
};

template <class Epi>
__device__ __forceinline__ void gemm_phase(LAS unsigned char* lds, const int K, const Sched& S, const Epi& E) {
    const int tid = opaque_tid(), wid = __builtin_amdgcn_readfirstlane(tid >> 6), lane = tid & 63, wr = wid >> 2, wc = wid & 3, fr = lane & 15, fq = lane >> 4;
    const int nt = K / BK;
    unsigned voffA[2], voffB[2];
#pragma unroll
    for (int i = 0; i < 2; ++i) { int R, C; stage_rc(tid * 16 + i * 8192, R, C); const int Rb = Epi::PERM ? ((R & ~31) + perm32(R & 31)) : R;
        voffA[i] = (unsigned)(R * K + C) * 2u; voffB[i] = (unsigned)(Rb * K + C) * 2u; }
    const size_t kstep = (size_t)(BK * 2);
    const size_t hstep = (size_t)HALF * K * 2;
    const size_t tstep = 2 * hstep;
    const unsigned ldsw = (unsigned)wid * 1024u;
    const int aoff = lds_byte(wr * 64 + fr, fq * 8), boff = lds_byte(wc * 32 + fr, fq * 8);
#define PG8_SA(b, h) (((b) * 2 + (h)) * HTB)
#define PG8_SB(b, h) ((4 + (b) * 2 + (h)) * HTB)
#define PG8_STAGE(bufoff, gbase, voff) do { _Pragma("unroll") for (int _i = 0; _i < 2; ++_i) \
        __builtin_amdgcn_global_load_lds((const unsigned*)((const char*)(gbase) + (voff)[_i]), (LAS unsigned*)(lds + (bufoff) + ldsw + _i * 8192), 16, 0, 0); } while (0)
#define PG8_LDA(dst, b, h) do { _Pragma("unroll") for (int m = 0; m < 4; ++m) _Pragma("unroll") for (int k = 0; k < 2; ++k) dst[m][k] = *(const LAS bf16x8*)(lds + PG8_SA(b, h) + aoff + m * 2048 + k * 1024); } while (0)
#define PG8_LDB(dst, b, h) do { _Pragma("unroll") for (int n = 0; n < 2; ++n) _Pragma("unroll") for (int k = 0; k < 2; ++k) dst[n][k] = *(const LAS bf16x8*)(lds + PG8_SB(b, h) + boff + n * 2048 + k * 1024); } while (0)
#define PG8_MMA(ai, bj, At, Bt) do { __builtin_amdgcn_s_setprio(1); _Pragma("unroll") for (int m = 0; m < 4; ++m) _Pragma("unroll") for (int n = 0; n < 2; ++n) _Pragma("unroll") for (int k = 0; k < 2; ++k) \
        acc[ai][bj][m][n] = __builtin_amdgcn_mfma_f32_16x16x32_bf16(Bt[n][k], At[m][k], acc[ai][bj][m][n], 0, 0, 0); __builtin_amdgcn_s_setprio(0); } while (0)
#define PG8_WAIT_V(n) asm volatile("s_waitcnt vmcnt(" #n ")" ::: "memory")
#define PG8_WAIT_L(n) asm volatile("s_waitcnt lgkmcnt(" #n ")" ::: "memory")
#define PG8_BAR __builtin_amdgcn_s_barrier()
#define PG8_SCHED __builtin_amdgcn_sched_barrier(0)
    Unit cur, nxt; int ui = 0;
    if (!S.next(0, cur)) return;
    float ssv[8]; E.pre(cur, wr, fr, ssv);
    f32x4 acc[2][2][4][2];
#pragma unroll
    for (int a = 0; a < 2; ++a)
#pragma unroll
        for (int b = 0; b < 2; ++b)
#pragma unroll
            for (int m = 0; m < 4; ++m)
#pragma unroll
                for (int n = 0; n < 2; ++n) acc[a][b][m][n] = (f32x4){0.f, 0.f, 0.f, 0.f};
    bf16x8 At[4][2], B0[2][2], B1[2][2];
    const char* cA = (const char*)(cur.sel ? S.A1 : S.A0) + (size_t)cur.pm * tstep; const char* cB = (const char*)(cur.sel ? S.B1 : S.B0) + (size_t)cur.pn * tstep;
    PG8_STAGE(PG8_SB(0, 0), cB, voffB); PG8_STAGE(PG8_SA(0, 0), cA, voffA); PG8_STAGE(PG8_SB(0, 1), cB + hstep, voffB); PG8_STAGE(PG8_SA(0, 1), cA + hstep, voffA);
    if (wr == 1) PG8_BAR;
    PG8_WAIT_V(4); PG8_BAR;
    PG8_STAGE(PG8_SB(1, 0), cB + kstep, voffB); PG8_STAGE(PG8_SA(1, 0), cA + kstep, voffA); PG8_STAGE(PG8_SB(1, 1), cB + hstep + kstep, voffB);
    PG8_WAIT_V(6); PG8_BAR;
    for (;;) {
        const bool has_next = S.next(ui + 1, nxt);
        const char* nA = has_next ? (const char*)(nxt.sel ? S.A1 : S.A0) + (size_t)nxt.pm * tstep : cA; const char* nB = has_next ? (const char*)(nxt.sel ? S.B1 : S.B0) + (size_t)nxt.pn * tstep : cB;
        for (int t = 0; t < nt; t += 2) {
            const bool last = (t == nt - 2);
            const char* a1 = cA + (size_t)(t + 1) * kstep;
            const char* a2 = last ? nA : cA + (size_t)(t + 2) * kstep; const char* b2 = last ? nB : cB + (size_t)(t + 2) * kstep;
            const char* a3 = a2 + kstep; const char* b3 = b2 + kstep;
            PG8_LDB(B0, 0, 0); PG8_SCHED; PG8_LDA(At, 0, 0); PG8_STAGE(PG8_SA(1, 1), a1 + hstep, voffA);
            PG8_WAIT_L(8); PG8_BAR; PG8_WAIT_L(0); PG8_MMA(0, 0, At, B0); PG8_BAR; PG8_SCHED;
            PG8_LDB(B1, 0, 1); PG8_STAGE(PG8_SB(0, 0), b2, voffB);
            PG8_BAR; PG8_WAIT_L(0); PG8_MMA(0, 1, At, B1); PG8_BAR;
            PG8_LDA(At, 0, 1); PG8_STAGE(PG8_SA(0, 0), a2, voffA);
            PG8_BAR; PG8_WAIT_L(0); PG8_MMA(1, 0, At, B0); PG8_BAR; PG8_SCHED;
            PG8_STAGE(PG8_SB(0, 1), b2 + hstep, voffB);
            PG8_WAIT_V(6); PG8_BAR; PG8_MMA(1, 1, At, B1); PG8_BAR;
            PG8_LDB(B0, 1, 0); PG8_SCHED; PG8_LDA(At, 1, 0); PG8_STAGE(PG8_SA(0, 1), a2 + hstep, voffA);
            PG8_WAIT_L(8); PG8_BAR; PG8_WAIT_L(0); PG8_MMA(0, 0, At, B0); PG8_BAR; PG8_SCHED;
            PG8_LDB(B1, 1, 1); PG8_STAGE(PG8_SB(1, 0), b3, voffB);
            PG8_BAR; PG8_WAIT_L(0); PG8_MMA(0, 1, At, B1); PG8_BAR;
            PG8_LDA(At, 1, 1); PG8_STAGE(PG8_SA(1, 0), a3, voffA);
            PG8_BAR; PG8_WAIT_L(0); PG8_MMA(1, 0, At, B0); PG8_BAR; PG8_SCHED;
            PG8_STAGE(PG8_SB(1, 1), b3 + hstep, voffB);
            PG8_WAIT_V(6); PG8_BAR; PG8_MMA(1, 1, At, B1); PG8_BAR;
        }
        E(acc, cur, wr, wc, fr, fq, ssv);
        if (!has_next) break;
        if (!E.keep(cur)) {
#pragma unroll
            for (int a = 0; a < 2; ++a)
#pragma unroll
                for (int b = 0; b < 2; ++b)
#pragma unroll
                    for (int m = 0; m < 4; ++m)
#pragma unroll
                        for (int n = 0; n < 2; ++n) acc[a][b][m][n] = (f32x4){0.f, 0.f, 0.f, 0.f};
        }
        cur = nxt; cA = nA; cB = nB; ++ui;
        E.pre(cur, wr, fr, ssv);
    }
    PG8_WAIT_V(0);
    if (wr == 0) PG8_BAR;
    PG8_BAR;
#undef PG8_SA
#undef PG8_SB
#undef PG8_STAGE
#undef PG8_LDA
#undef PG8_LDB
#undef PG8_MMA
#undef PG8_WAIT_V
#undef PG8_WAIT_L
#undef PG8_BAR
#undef PG8_SCHED
}
}
using pg8::Unit;
typedef f32x4 Acc[2][2][4][2];

struct EpiGU {
    static constexpr bool PERM = true;
    bf16_t* O; const float* ss;
    __device__ __forceinline__ void pre(const Unit& u, int wr, int fr, float (&ssv)[8]) const {
#pragma unroll
        for (int ai = 0; ai < 2; ++ai)
#pragma unroll
            for (int m = 0; m < 4; ++m) ssv[ai * 4 + m] = ss[u.pm * 256 + ai * 128 + wr * 64 + m * 16 + fr];
    }
    __device__ __forceinline__ bool keep(const Unit&) const { return false; }
    __device__ __forceinline__ void operator()(Acc& acc, const Unit& u, int wr, int wc, int fr, int fq, const float (&ssv)[8]) const {
        const int row0 = u.pm * 256 + wr * 64 + fr, col0 = u.pn * 128 + wc * 32 + 8 * fq;
#pragma unroll
        for (int ai = 0; ai < 2; ++ai)
#pragma unroll
            for (int m = 0; m < 4; ++m) {
                const int row = row0 + ai * 128 + m * 16;
                const float rs = rsqrtf(ssv[ai * 4 + m] * (1.f / D) + EPS);
                const float rs2 = rs * rs, nrl = -1.4426950408889634f * rs;
                float o[8];
#pragma unroll
                for (int n = 0; n < 2; ++n)
#pragma unroll
                    for (int j = 0; j < 4; j += 2) {
                        typedef float f32x2v __attribute__((ext_vector_type(2)));
                        const f32x2v g = {acc[ai][0][m][n][j], acc[ai][0][m][n][j + 1]}, uu = {acc[ai][1][m][n][j], acc[ai][1][m][n][j + 1]};
                        const f32x2v t = g * nrl, p = (g * uu) * rs2;
                        f32x2v d; d.x = __builtin_amdgcn_exp2f(t.x); d.y = __builtin_amdgcn_exp2f(t.y); d = d + 1.0f;
                        f32x2v r; r.x = __builtin_amdgcn_rcpf(d.x); r.y = __builtin_amdgcn_rcpf(d.y);
                        const f32x2v q = p * r; o[n * 4 + j] = q.x; o[n * 4 + j + 1] = q.y;
                    }
                *(u32x4*)(O + (size_t)row * FF + col0) = pack8f(o);
            }
    }
};
struct EpiRes {
    static constexpr bool PERM = false;
    const float* base; float* out; bf16_t* ob; float* ssn; float scale;
    __device__ __forceinline__ void pre(const Unit&, int, int, float (&ssv)[8]) const {
#pragma unroll
        for (int i = 0; i < 8; ++i) ssv[i] = 0.f; }
    __device__ __forceinline__ bool keep(const Unit&) const { return false; }
    __device__ __forceinline__ void operator()(Acc& acc, const Unit& u, int wr, int wc, int fr, int fq, const float (&ssv)[8]) const {
        const int row0 = u.pm * 256 + wr * 64 + fr, col0 = u.pn * 256 + wc * 32 + 4 * fq;
#pragma unroll
        for (int ai = 0; ai < 2; ++ai) {
            f32x4 b[4][2][2];
#pragma unroll
            for (int m = 0; m < 4; ++m)
#pragma unroll
                for (int bj = 0; bj < 2; ++bj)
#pragma unroll
                    for (int n = 0; n < 2; ++n) b[m][bj][n] = *(const f32x4*)(base + (size_t)(row0 + ai * 128 + m * 16) * D + col0 + bj * 128 + n * 16);
#pragma unroll
            for (int m = 0; m < 4; ++m) {
                const int row = row0 + ai * 128 + m * 16; float sq = 0.f;
#pragma unroll
                for (int bj = 0; bj < 2; ++bj)
#pragma unroll
                    for (int n = 0; n < 2; ++n) {
                        const size_t off = (size_t)row * D + col0 + bj * 128 + n * 16;
                        const f32x4 v = b[m][bj][n] + acc[ai][bj][m][n] * scale;
                        *(f32x4*)(out + off) = v;
                        sq += (v[0] * v[0] + v[1] * v[1]) + (v[2] * v[2] + v[3] * v[3]);
                        u32x2 w; w.x = pk2(v[0], v[1]); w.y = pk2(v[2], v[3]);
                        *(u32x2*)(ob + off) = w;
                    }
                sq += __shfl_xor(sq, 16); sq += __shfl_xor(sq, 32);
                if (fq == 0) unsafeAtomicAdd(ssn + row, sq);
            }
        }
    }
};
struct EpiProj {
    static constexpr bool PERM = true;
    bf16_t* O; const float* ss;
    __device__ __forceinline__ void pre(const Unit& u, int wr, int fr, float (&ssv)[8]) const {
#pragma unroll
        for (int ai = 0; ai < 2; ++ai)
#pragma unroll
            for (int m = 0; m < 4; ++m) ssv[ai * 4 + m] = ss[u.pm * 256 + ai * 128 + wr * 64 + m * 16 + fr];
    }
    __device__ __forceinline__ bool keep(const Unit&) const { return false; }
    __device__ __forceinline__ void operator()(Acc& acc, const Unit& u, int wr, int wc, int fr, int fq, const float (&ssv)[8]) const {
        const int row0 = u.pm * 256 + wr * 64 + fr, col0 = u.pn * 256 + wc * 32 + 8 * fq;
#pragma unroll
        for (int ai = 0; ai < 2; ++ai)
#pragma unroll
            for (int m = 0; m < 4; ++m) {
                const int row = row0 + ai * 128 + m * 16;
                const float rs = rsqrtf(ssv[ai * 4 + m] * (1.f / D) + EPS);
#pragma unroll
                for (int bj = 0; bj < 2; ++bj) {
                    float o[8];
#pragma unroll
                    for (int n = 0; n < 2; ++n)
#pragma unroll
                        for (int j = 0; j < 4; ++j) o[n * 4 + j] = acc[ai][bj][m][n][j] * rs;
                    *(u32x4*)(O + (size_t)row * NIN + col0 + bj * 128) = pack8f(o);
                }
            }
    }
};
struct EpiMix {
    static constexpr bool PERM = true;
    const bf16_t* proj; bf16_t* O;
    __device__ __forceinline__ void pre(const Unit&, int, int, float (&ssv)[8]) const {
#pragma unroll
        for (int i = 0; i < 8; ++i) ssv[i] = 0.f; }
    __device__ __forceinline__ bool keep(const Unit& u) const { return u.sel == 0; }
    __device__ __forceinline__ void operator()(Acc& acc, const Unit& u, int wr, int wc, int fr, int fq, const float (&ssv)[8]) const {
        const int row0 = u.pm * 256 + wr * 64 + fr, col0 = u.pn * 256 + wc * 32 + 8 * fq;
#pragma unroll
        for (int ai = 0; ai < 2; ++ai) {
            u32x4 rga[4][2], rgb[4][2];
#pragma unroll
            for (int m = 0; m < 4; ++m)
#pragma unroll
                for (int bj = 0; bj < 2; ++bj) { const size_t o = (size_t)(row0 + ai * 128 + m * 16) * NIN + col0 + bj * 128;
                    rga[m][bj] = *(const u32x4*)(proj + o + C_GA); rgb[m][bj] = *(const u32x4*)(proj + o + C_GB); }
#pragma unroll
            for (int m = 0; m < 4; ++m) {
                const int row = row0 + ai * 128 + m * 16;
#pragma unroll
                for (int bj = 0; bj < 2; ++bj) {
                    const int col = col0 + bj * 128;
                    float ga[8], gb[8];
                    unpack8(rga[m][bj], ga);
                    unpack8(rgb[m][bj], gb);
                    if (u.sel == 0) {
#pragma unroll
                        for (int n = 0; n < 2; ++n)
#pragma unroll
                            for (int j = 0; j < 4; ++j) acc[ai][bj][m][n][j] *= (1.f + __expf(-gb[n * 4 + j])) * __builtin_amdgcn_rcpf(1.f + __expf(-ga[n * 4 + j]));
                    } else {
                        float o[8];
#pragma unroll
                        for (int n = 0; n < 2; ++n)
#pragma unroll
                            for (int j = 0; j < 4; ++j) o[n * 4 + j] = acc[ai][bj][m][n][j] * sigmoidf_(gb[n * 4 + j]);
                        *(u32x4*)(O + (size_t)row * D + col) = pack8f(o);
                    }
                }
            }
        }
    }
};
struct EpiF32 {
    static constexpr bool PERM = false;
    float* C;
    __device__ __forceinline__ void pre(const Unit&, int, int, float (&ssv)[8]) const {
#pragma unroll
        for (int i = 0; i < 8; ++i) ssv[i] = 0.f; }
    __device__ __forceinline__ bool keep(const Unit&) const { return false; }
    __device__ __forceinline__ void operator()(Acc& acc, const Unit& u, int wr, int wc, int fr, int fq, const float (&ssv)[8]) const {
        const int row0 = u.pm * 256 + wr * 64 + fr, col0 = u.pn * 256 + wc * 32 + 4 * fq;
#pragma unroll
        for (int ai = 0; ai < 2; ++ai)
#pragma unroll
            for (int m = 0; m < 4; ++m)
#pragma unroll
                for (int bj = 0; bj < 2; ++bj)
#pragma unroll
                    for (int n = 0; n < 2; ++n) *(f32x4*)(C + (size_t)(row0 + ai * 128 + m * 16) * D + col0 + bj * 128 + n * 16) = acc[ai][bj][m][n];
    }
};
struct EpiPle {
    static constexpr bool PERM = false;
    float* out; const float* R; const float* ss;
    __device__ __forceinline__ void pre(const Unit& u, int wr, int fr, float (&ssv)[8]) const {
#pragma unroll
        for (int ai = 0; ai < 2; ++ai)
#pragma unroll
            for (int m = 0; m < 4; ++m) ssv[ai * 4 + m] = ss[u.pm * 256 + ai * 128 + wr * 64 + m * 16 + fr];
    }
    __device__ __forceinline__ bool keep(const Unit&) const { return false; }
    __device__ __forceinline__ void operator()(Acc& acc, const Unit& u, int wr, int wc, int fr, int fq, const float (&ssv)[8]) const {
        const int row0 = u.pm * 256 + wr * 64 + fr, col0 = u.pn * 256 + wc * 32 + 4 * fq;
#pragma unroll
        for (int ai = 0; ai < 2; ++ai)
#pragma unroll
            for (int mp = 0; mp < 2; ++mp) {
                f32x4 bb[2][2][2], rr[2][2][2];
#pragma unroll
                for (int mm = 0; mm < 2; ++mm)
#pragma unroll
                    for (int bj = 0; bj < 2; ++bj)
#pragma unroll
                        for (int n = 0; n < 2; ++n) { const size_t off = (size_t)(row0 + ai * 128 + (2 * mp + mm) * 16) * D + col0 + bj * 128 + n * 16;
                            bb[mm][bj][n] = *(const f32x4*)(out + off); rr[mm][bj][n] = *(const f32x4*)(R + off); }
#pragma unroll
                for (int mm = 0; mm < 2; ++mm) {
                    const int m = 2 * mp + mm, row = row0 + ai * 128 + m * 16;
                    const float rs = rsqrtf(ssv[ai * 4 + m] * (1.f / D) + EPS);
#pragma unroll
                    for (int bj = 0; bj < 2; ++bj)
#pragma unroll
                        for (int n = 0; n < 2; ++n) {
                            const size_t off = (size_t)row * D + col0 + bj * 128 + n * 16;
                            f32x4 v;
#pragma unroll
                            for (int j = 0; j < 4; ++j) v[j] = bb[mm][bj][n][j] + sigmoidf_(acc[ai][bj][m][n][j] * rs) * rr[mm][bj][n][j];
                            *(f32x4*)(out + off) = v;
                        }
                }
            }
    }
};

struct Params {
    const float *x, *p, *ffn1_norm, *ffn1_w_gu, *ffn1_w_down, *mix_norm, *w_in, *conv_w, *a_log, *dt_bias, *gdn_norm, *q_norm, *k_norm, *rel_bias,
                *w_a, *w_b, *w_out, *ffn2_norm, *ffn2_w_gu, *ffn2_w_down, *ple_norm, *ple_gate, *ple_proj;
    float* out; unsigned char* ws; int ph_lo, ph_hi;
};

template <int MAP> __device__ __forceinline__ int src_col(int n) {
    if (MAP == 1) return ((n >> 7) & 1) * FF + (n >> 8) * 128 + (n & 127);
    if (MAP == 2) return n < 4096 ? n : (n < 11264 ? n + 16 : (n < 11280 ? n - 11264 + 4096 : -1));
    return n;
}
template <int MAP> __device__ __forceinline__ void transpose_item(const float* W, const float* nw, int K, int Nsrc, int Nd, bf16_t* WT, LAS float* scr, int item, int lane) {
    const int nblk = Nd / 64, kb = item / nblk, nb = item % nblk, k0 = 64 * kb, n0 = 64 * nb;
    const int r = lane >> 4, c4 = lane & 15;
    const int sc = src_col<MAP>(n0 + 4 * c4);
    f32x4 v[16];
#pragma unroll
    for (int i = 0; i < 16; ++i) v[i] = sc >= 0 ? __builtin_nontemporal_load((const f32x4*)(W + (size_t)(k0 + 4 * i + r) * Nsrc + sc)) : (f32x4){0.f, 0.f, 0.f, 0.f};
    if (nw) {
#pragma unroll
        for (int i = 0; i < 16; ++i) v[i] = v[i] * nw[k0 + 4 * i + r];
    }
#pragma unroll
    for (int i = 0; i < 16; ++i) { LAS float* p = scr + (4 * i + r) * 65 + 4 * c4; p[0] = v[i][0]; p[1] = v[i][1]; p[2] = v[i][2]; p[3] = v[i][3]; }
    asm volatile("s_waitcnt lgkmcnt(0)" ::: "memory"); __builtin_amdgcn_wave_barrier();
    const int ns = lane >> 3, kc = lane & 7;
#pragma unroll
    for (int j = 0; j < 8; ++j) { const LAS float* sp = scr + (8 * kc) * 65 + 8 * j + ns;
        u32x4 o; o.x = pk2(sp[0 * 65], sp[1 * 65]); o.y = pk2(sp[2 * 65], sp[3 * 65]); o.z = pk2(sp[4 * 65], sp[5 * 65]); o.w = pk2(sp[6 * 65], sp[7 * 65]);
        *(u32x4*)(WT + (size_t)(n0 + 8 * j + ns) * K + k0 + 8 * kc) = o; }
    asm volatile("s_waitcnt lgkmcnt(0)" ::: "memory"); __builtin_amdgcn_wave_barrier();
}
constexpr int I_GU = (D / 64) * (NGU / 64), I_DN = (FF / 64) * (D / 64), I_IN = (D / 64) * (NIN / 64), I_AB = (1024 / 64) * (D / 64), I_SQ = (D / 64) * (D / 64), I_PP = (PLE / 64) * (D / 64);
constexpr int N_EARLY = I_GU + I_DN + I_IN, N_LATE = I_GU + I_DN + 2 * I_AB + 2 * I_SQ + I_PP;
__device__ __forceinline__ void convert_early(const Params& P, LAS float* scr, int gw, int NGW, int lane, bool with_d1) {
    unsigned char* ws = P.ws;
    for (int it = gw; it < I_GU + I_IN + (with_d1 ? I_DN : 0); it += NGW) {
        int r = it;
        if (r < I_GU) { transpose_item<1>(P.ffn1_w_gu, P.ffn1_norm, D, NGU, NGU, (bf16_t*)(ws + WS_WGU1), scr, r, lane); continue; } r -= I_GU;
        if (r < I_IN) { transpose_item<2>(P.w_in, P.mix_norm, D, NINSRC, NIN, (bf16_t*)(ws + WS_WIN), scr, r, lane); continue; } r -= I_IN;
        transpose_item<0>(P.ffn1_w_down, nullptr, FF, D, D, (bf16_t*)(ws + WS_WD1), scr, r, lane);
    }
}
__device__ __forceinline__ void convert_d1(const Params& P, LAS float* scr, int gw, int NGW, int lane) {
    for (int it = gw; it < I_DN; it += NGW) transpose_item<0>(P.ffn1_w_down, nullptr, FF, D, D, (bf16_t*)(P.ws + WS_WD1), scr, it, lane);
}
__device__ __forceinline__ void convert_late(const Params& P, LAS float* scr, int lo_it, int hi_it, int gw, int NGW, int lane) {
    unsigned char* ws = P.ws;
    for (int it = lo_it + gw; it < hi_it; it += NGW) {
        int r = it;
        if (r < I_AB) { transpose_item<0>(P.w_a, nullptr, 1024, D, D, (bf16_t*)(ws + WS_WA), scr, r, lane); continue; } r -= I_AB;
        if (r < I_AB) { transpose_item<0>(P.w_b, nullptr, 1024, D, D, (bf16_t*)(ws + WS_WB), scr, r, lane); continue; } r -= I_AB;
        if (r < I_SQ) { transpose_item<0>(P.w_out, nullptr, D, D, D, (bf16_t*)(ws + WS_WOUT), scr, r, lane); continue; } r -= I_SQ;
        if (r < I_GU) { transpose_item<1>(P.ffn2_w_gu, P.ffn2_norm, D, NGU, NGU, (bf16_t*)(ws + WS_WGU2), scr, r, lane); continue; } r -= I_GU;
        if (r < I_DN) { transpose_item<0>(P.ffn2_w_down, nullptr, FF, D, D, (bf16_t*)(ws + WS_WD2), scr, r, lane); continue; } r -= I_DN;
        if (r < I_SQ) { transpose_item<0>(P.ple_gate, P.ple_norm, D, D, D, (bf16_t*)(ws + WS_WPG), scr, r, lane); continue; } r -= I_SQ;
        transpose_item<0>(P.ple_proj, nullptr, PLE, D, D, (bf16_t*)(ws + WS_WPP), scr, r, lane);
    }
}
constexpr int LATE_A = 2800, LATE_C = 2 * I_AB + I_SQ + I_GU;
__device__ __forceinline__ void idle_convert(const Params& P, LAS unsigned char* lds, int nwg, int G, int lo_it, int hi_it) {
    const int extra = nwg % G, c = blockIdx.x;
    if (extra == 0 || c < extra) return;
    const int tid = opaque_tid(), wave = tid >> 6;
    if (lo_it < 0) convert_d1(P, (LAS float*)(lds + wave * 17408), (c - extra) * 8 + wave, (G - extra) * 8, tid & 63);
    else convert_late(P, (LAS float*)(lds + wave * 17408), lo_it, hi_it, (c - extra) * 8 + wave, (G - extra) * 8, tid & 63);
}
__device__ __forceinline__ void phase_convert(const Params& P, LAS unsigned char* lds, int G) {
    const int tid = opaque_tid(), lane = tid & 63, wave = tid >> 6;
    LAS float* scr = (LAS float*)(lds + wave * 17408);
    const int gw = blockIdx.x * 8 + wave, NGW = G * 8;
    unsigned char* ws = P.ws;
    convert_early(P, scr, gw, NGW, lane, (((M / 256) * (NGU / 256)) % G) == 0);
    float* ss = (float*)(ws + WS_SS);
    bf16_t* xb = (bf16_t*)(ws + WS_XB); bf16_t* pb = (bf16_t*)(ws + WS_PB);
    for (int m0 = gw; m0 < M; m0 += 2 * NGW) {
        f32x4 xv[2][8], pv[2];
#pragma unroll
        for (int q = 0; q < 2; ++q) { const int m = m0 + q * NGW; if (m < M) {
            const f32x4* xr = (const f32x4*)(P.x + (size_t)m * D) + lane;
#pragma unroll
            for (int j = 0; j < 8; ++j) xv[q][j] = __builtin_nontemporal_load(xr + 64 * j);
            pv[q] = __builtin_nontemporal_load((const f32x4*)(P.p + (size_t)m * PLE) + lane); } }
#pragma unroll
        for (int q = 0; q < 2; ++q) { const int m = m0 + q * NGW; if (m < M) {
            u32x2* o8 = (u32x2*)(xb + (size_t)m * D) + lane; float s = 0.f;
#pragma unroll
            for (int j = 0; j < 8; ++j) { const f32x4 v = xv[q][j]; s += (v[0] * v[0] + v[1] * v[1]) + (v[2] * v[2] + v[3] * v[3]); u32x2 w; w.x = pk2(v[0], v[1]); w.y = pk2(v[2], v[3]); o8[64 * j] = w; }
            s = wave_sum(s); if (lane == 0) ss[m] = s;
            u32x2 w; w.x = pk2(pv[q][0], pv[q][1]); w.y = pk2(pv[q][2], pv[q][3]); *((u32x2*)(pb + (size_t)m * PLE) + lane) = w; } }
    }
    for (int i = blockIdx.x * 512 + tid; i < 3 * M; i += G * 512) ss[M + i] = 0.f;
    if (blockIdx.x == 0 && tid < 8) ((unsigned*)(ws + WS_PROG))[tid * 32] = 0u;
}

constexpr int L_LM = 0, L_GC = L_LM + 64 * 68 * 4, L_R = L_GC + 512, L_KBF = L_R + 65536, L_QBF = L_KBF + 64 * 136 * 2, L_VST = L_QBF + 64 * 136 * 2, L_END4 = L_VST + 64 * 136 * 2;
static_assert(L_END4 <= LDS_BYTES, "lds");
__device__ __forceinline__ void prep_item(const Params& P, LAS unsigned char* lds, int item, const int pflags) {
    const int tid = opaque_tid(), lane = tid & 63, wave = tid >> 6;
    const int n = item >> 3, h = item & 7;
    unsigned char* ws = P.ws;
    bf16_t* proj = (bf16_t*)(ws + WS_PROJ);
    LAS float* Rr = (LAS float*)(lds + L_R); LAS float* Lm = (LAS float*)(lds + L_LM);
    LAS bf16_t* kbf = (LAS bf16_t*)(lds + L_KBF); LAS bf16_t* qbf = (LAS bf16_t*)(lds + L_QBF); LAS bf16_t* vst = (LAS bf16_t*)(lds + L_VST);
    LAS float* gcs = (LAS float*)(lds + L_GC);
    if (wave == 0) {
        const size_t row = (size_t)n * 64 + lane;
        const float a = bf2f(proj[row * NIN + C_AR + h]), b = bf2f(proj[row * NIN + C_BR + h]);
        const float xx = a + P.dt_bias[h];
        const float sp = xx > 20.f ? xx : log1pf(expf(xx));
        float g = -expf(P.a_log[h]) * sp;
#pragma unroll
        for (int o = 1; o < 64; o <<= 1) { const float t = __shfl_up(g, o); if (lane >= o) g += t; }
        gcs[lane] = g; gcs[64 + lane] = 1.f / (1.f + expf(-b));
    }
    const int l16 = tid & 15, rg = tid >> 4;
    float qv[2][8], kv[2][8], vv[2][8];
#pragma unroll
    for (int X = 0; X < 3; ++X) {
        const int col = (X == 0 ? C_QA : (X == 1 ? C_KA : C_VA)) + h * DH + 8 * l16;
        const int ccol = X * 1024 + h * DH + 8 * l16;
        float xin[5][8];
#pragma unroll
        for (int i = 0; i < 5; ++i) { const int gr = n * 64 + 2 * rg - 3 + i;
            if (gr >= 0) unpack8(__builtin_nontemporal_load((const u32x4*)(proj + (size_t)gr * NIN + col)), xin[i]);
            else {
#pragma unroll
                for (int e = 0; e < 8; ++e) xin[i][e] = 0.f; } }
        float y[2][8];
#pragma unroll
        for (int r = 0; r < 2; ++r)
#pragma unroll
            for (int e = 0; e < 8; ++e) y[r][e] = 0.f;
#pragma unroll
        for (int j = 0; j < 4; ++j) {
            const f32x4 c0 = *(const f32x4*)(P.conv_w + j * 3072 + ccol), c1 = *(const f32x4*)(P.conv_w + j * 3072 + ccol + 4);
#pragma unroll
            for (int r = 0; r < 2; ++r)
#pragma unroll
                for (int e = 0; e < 8; ++e) y[r][e] += (e < 4 ? c0[e] : c1[e - 4]) * xin[r + j][e];
        }
#pragma unroll
        for (int r = 0; r < 2; ++r) {
            float sq = 0.f;
#pragma unroll
            for (int e = 0; e < 8; ++e) { y[r][e] = siluf_(y[r][e]); sq += y[r][e] * y[r][e]; }
            if (X < 2) {
                sq += __shfl_xor(sq, 1); sq += __shfl_xor(sq, 2); sq += __shfl_xor(sq, 4); sq += __shfl_xor(sq, 8);
                const float rn = rsqrtf(sq + EPS) * (X == 0 ? 0.08838834764831845f : 1.f);
#pragma unroll
                for (int e = 0; e < 8; ++e) y[r][e] *= rn;
            }
#pragma unroll
            for (int e = 0; e < 8; ++e) { if (X == 0) qv[r][e] = y[r][e]; else if (X == 1) kv[r][e] = y[r][e]; else vv[r][e] = y[r][e]; }
        }
    }
    {
        u32x4 raw[2][3]; f32x4 gw[2][2];
#pragma unroll
        for (int r = 0; r < 2; ++r) { const size_t grow = (size_t)n * 64 + 2 * rg + r;
            raw[r][0] = __builtin_nontemporal_load((const u32x4*)(proj + grow * NIN + C_QB + h * DH + 8 * l16));
            raw[r][1] = __builtin_nontemporal_load((const u32x4*)(proj + grow * NIN + C_KB + h * DH + 8 * l16));
            raw[r][2] = __builtin_nontemporal_load((const u32x4*)(proj + grow * NIN + C_VB + h * DH + 8 * l16)); }
#pragma unroll
        for (int X = 0; X < 2; ++X) { const float* nwp = (X == 0 ? P.q_norm : P.k_norm) + 8 * l16; gw[X][0] = *(const f32x4*)nwp; gw[X][1] = *(const f32x4*)(nwp + 4); }
#pragma unroll
        for (int r = 0; r < 2; ++r) {
            const size_t grow = (size_t)n * 64 + 2 * rg + r;
#pragma unroll
            for (int X = 0; X < 2; ++X) {
                bf16_t* ptr = proj + grow * NIN + (X == 0 ? C_QB : C_KB) + h * DH + 8 * l16;
                float f[8]; unpack8(raw[r][X], f);
                float sq = 0.f;
#pragma unroll
                for (int e = 0; e < 8; ++e) sq += f[e] * f[e];
                sq += __shfl_xor(sq, 1); sq += __shfl_xor(sq, 2); sq += __shfl_xor(sq, 4); sq += __shfl_xor(sq, 8);
                const float rn = rsqrtf(sq * (1.f / DH) + EPS);
#pragma unroll
                for (int e = 0; e < 8; ++e) f[e] = f[e] * rn * (e < 4 ? gw[X][0][e] : gw[X][1][e - 4]);
                *(u32x4*)ptr = pack8f(f);
            }
            *(LAS u32x4*)(vst + (2 * rg + r) * 136 + 8 * l16) = raw[r][2];
        }
    }
    __syncthreads();
    {
        bf16_t* qd = (bf16_t*)(ws + WS_QD) + (size_t)item * 64 * 128;
        bf16_t* ktT = (bf16_t*)(ws + WS_KTT) + (size_t)item * 128 * 64;
        const float gl = gcs[63];
        float ktl[2][8];
#pragma unroll
        for (int r = 0; r < 2; ++r) {
            const int t = 2 * rg + r; const float gc = gcs[t], bt = gcs[64 + t];
            const float eg = __expf(gc), egl = __expf(gl - gc);
            float f[8];
#pragma unroll
            for (int e = 0; e < 8; ++e) f[e] = qv[r][e] * eg;
            *(u32x4*)(qd + ((((t >> 4) * 4 + (l16 >> 2)) * 64) + (l16 & 3) * 16 + (t & 15)) * 8) = pack8f(f);
#pragma unroll
            for (int e = 0; e < 8; ++e) ktl[r][e] = kv[r][e] * egl;
            *(LAS u32x4*)(qbf + t * 136 + 8 * l16) = pack8f(qv[r]);
            *(LAS u32x4*)(kbf + t * 136 + 8 * l16) = pack8f(kv[r]);
            LAS float* rr = Rr + t * 256 + 8 * l16;
            *(LAS f32x4*)(rr) = (f32x4){vv[r][0] * bt, vv[r][1] * bt, vv[r][2] * bt, vv[r][3] * bt};
            *(LAS f32x4*)(rr + 4) = (f32x4){vv[r][4] * bt, vv[r][5] * bt, vv[r][6] * bt, vv[r][7] * bt};
            const float be = bt * eg;
            *(LAS f32x4*)(rr + 128) = (f32x4){kv[r][0] * be, kv[r][1] * be, kv[r][2] * be, kv[r][3] * be};
            *(LAS f32x4*)(rr + 132) = (f32x4){kv[r][4] * be, kv[r][5] * be, kv[r][6] * be, kv[r][7] * be};
        }
#pragma unroll
        for (int e = 0; e < 8; ++e) { const int t0 = 2 * rg; *(unsigned*)(ktT + (((((l16 >> 1) * 2 + (t0 >> 5)) * 64) + ((t0 >> 3) & 3) * 16 + 8 * (l16 & 1) + e) * 8 + (t0 & 7))) = pk2(ktl[0][e], ktl[1][e]); }
        if (tid == 0) ((float*)(ws + WS_TAIL))[item] = __expf(gl);
        bf16_t* vt = (bf16_t*)(ws + WS_VT);
        const int d = tid & 127, tg = tid >> 7;
        unsigned pw[8];
#pragma unroll
        for (int i = 0; i < 8; ++i) { const unsigned lo = vst[(16 * tg + 2 * i) * 136 + d], hi = vst[(16 * tg + 2 * i + 1) * 136 + d]; pw[i] = lo | (hi << 16); }
        bf16_t* dst = vt + (size_t)(h * DH + d) * M + n * 64 + 16 * tg;
        *(u32x4*)dst = (u32x4){pw[0], pw[1], pw[2], pw[3]}; *(u32x4*)(dst + 8) = (u32x4){pw[4], pw[5], pw[6], pw[7]};
    }
    __syncthreads();
    {
        const int fr = lane & 15, fq = lane >> 4, which = wave >> 2, ti = wave & 3;
        LAS bf16_t* X = which ? qbf : kbf;
        bf16x8 a[4];
#pragma unroll
        for (int s = 0; s < 4; ++s) a[s] = *(const LAS bf16x8*)(X + (16 * ti + fr) * 136 + 32 * s + 8 * fq);
        bf16_t* aqk = (bf16_t*)(ws + WS_AQK) + (size_t)item * 64 * 64;
        for (int tj = 0; tj < 4; ++tj) {
            f32x4 c = {0.f, 0.f, 0.f, 0.f};
            if (tj <= ti) {
#pragma unroll
                for (int s = 0; s < 4; ++s) { const bf16x8 b = *(const LAS bf16x8*)(kbf + (16 * tj + fr) * 136 + 32 * s + 8 * fq); c = MFMA16(a[s], b, c); }
            }
            const int j = 16 * tj + fr; const float gj = gcs[j];
#pragma unroll
            for (int r = 0; r < 4; ++r) {
                const int i = 16 * ti + 4 * fq + r;
                const float dec = (i >= j) ? __expf(gcs[i] - gj) : 0.f;
                if (which == 0) { Lm[i * 68 + j] = (i > j) ? gcs[64 + i] * c[r] * dec : 0.f; }
                else { const float v = (i >= j) ? c[r] * dec : 0.f; aqk[((((i >> 4) * 2 + (j >> 5)) * 64) + ((j >> 3) & 3) * 16 + (i & 15)) * 8 + (j & 7)] = (bf16_t)(pk2(v, 0.f) & 0xffffu); }
            }
        }
    }
    __syncthreads();
    if (tid < 256) {
        int Lrow[64];
#pragma unroll
        for (int i = 0; i < 64; ++i) Lrow[i] = __float_as_int(Lm[i * 68 + lane]);
        float s[64];
#define LRD(i, j) __int_as_float(__builtin_amdgcn_readlane(Lrow[i], j))
#pragma unroll
        for (int g = 0; g < 16; ++g) {
            const int i0 = 4 * g;
            float a0 = Rr[(i0 + 0) * 256 + tid], a1 = Rr[(i0 + 1) * 256 + tid], a2 = Rr[(i0 + 2) * 256 + tid], a3 = Rr[(i0 + 3) * 256 + tid];
            if (!(pflags & 8)) {
#pragma unroll
            for (int j = 0; j < i0; ++j) { const float sj = s[j]; a0 -= LRD(i0, j) * sj; a1 -= LRD(i0 + 1, j) * sj; a2 -= LRD(i0 + 2, j) * sj; a3 -= LRD(i0 + 3, j) * sj; }
            a1 -= LRD(i0 + 1, i0) * a0;
            a2 -= LRD(i0 + 2, i0) * a0; a2 -= LRD(i0 + 2, i0 + 1) * a1;
            a3 -= LRD(i0 + 3, i0) * a0; a3 -= LRD(i0 + 3, i0 + 1) * a1; a3 -= LRD(i0 + 3, i0 + 2) * a2;
            }
            s[i0] = a0; s[i0 + 1] = a1; s[i0 + 2] = a2; s[i0 + 3] = a3;
        }
#undef LRD
        if (pflags & 32) { if (s[63] == 1.2345f) ((float*)(ws + WS_U))[tid] = s[5]; } else
        if (tid < 128) { float* u = (float*)(ws + WS_U) + (size_t)item * 64 * 128 + ((tid >> 4) * 256 + (tid & 15)) * 4;
#pragma unroll
            for (int i4 = 0; i4 < 16; ++i4) *(f32x4*)(u + ((i4 >> 2) * 64 + (i4 & 3) * 16) * 4) = (f32x4){s[4 * i4], s[4 * i4 + 1], s[4 * i4 + 2], s[4 * i4 + 3]}; }
        else { const int dk = tid - 128; bf16_t* w = (bf16_t*)(ws + WS_W) + (size_t)item * 64 * 128 + (((dk >> 5) * 64) + ((dk >> 3) & 3) * 16) * 8 + (dk & 7);
#pragma unroll
            for (int i = 0; i < 64; ++i) w[((i >> 4) * 256 + (i & 15)) * 8] = (bf16_t)(pk2(s[i], 0.f) & 0xffffu); }
    }
    __syncthreads();
}

struct ScanA { bf16x8 W[4], K0[2], K1[2]; f32x4 u; float tl; };
struct ScanB { bf16x8 Q[4], A[2]; };
struct ScanOff { unsigned w, aq, kt, u; };
__device__ __forceinline__ void scan_loadA(ScanA& o, const unsigned char* ws, int c, int h, const ScanOff& f) {
    const int item = c * 8 + h;
    const unsigned char* w = ws + WS_W + (size_t)item * 16384; const unsigned char* kt = ws + WS_KTT + (size_t)item * 16384; const unsigned char* u = ws + WS_U + (size_t)item * 32768;
#pragma unroll
    for (int s = 0; s < 4; ++s) o.W[s] = __builtin_bit_cast(bf16x8, *(const u32x4*)(w + f.w + 1024 * s));
#pragma unroll
    for (int s = 0; s < 2; ++s) { o.K0[s] = __builtin_bit_cast(bf16x8, *(const u32x4*)(kt + f.kt + 1024 * s)); o.K1[s] = __builtin_bit_cast(bf16x8, *(const u32x4*)(kt + f.kt + 2048 + 1024 * s)); }
    o.u = *(const f32x4*)(u + f.u);
    o.tl = ((const float*)(ws + WS_TAIL))[item];
}
__device__ __forceinline__ void scan_loadB(ScanB& o, const unsigned char* ws, int c, int h, const ScanOff& f) {
    const int item = c * 8 + h;
    const unsigned char* qd = ws + WS_QD + (size_t)item * 16384; const unsigned char* aq = ws + WS_AQK + (size_t)item * 8192;
#pragma unroll
    for (int s = 0; s < 4; ++s) o.Q[s] = __builtin_bit_cast(bf16x8, *(const u32x4*)(qd + f.w + 1024 * s));
#pragma unroll
    for (int s = 0; s < 2; ++s) o.A[s] = __builtin_bit_cast(bf16x8, *(const u32x4*)(aq + f.aq + 1024 * s));
}
__device__ __forceinline__ void scan_stepA(const ScanA& cur, f32x4& S0, f32x4& S1, LAS bf16_t* Sl, LAS bf16_t* Vl, int fr, int fq, int mt) {
    f32x4 wsv = {0.f, 0.f, 0.f, 0.f};
#pragma unroll
    for (int s = 0; s < 4; ++s) wsv = MFMA16(cur.W[s], *(const LAS bf16x8*)(Sl + fr * 136 + 32 * s + 8 * fq), wsv);
    const f32x4 vn = cur.u - wsv;
    { u32x2 pv; pv.x = pk2(vn[0], vn[1]); pv.y = pk2(vn[2], vn[3]); *(LAS u32x2*)(Vl + fr * 72 + 16 * mt + 4 * fq) = pv; }
    __syncthreads();
    S0 = S0 * cur.tl; S1 = S1 * cur.tl;
#pragma unroll
    for (int s = 0; s < 2; ++s) { const bf16x8 Vb = *(const LAS bf16x8*)(Vl + fr * 72 + 32 * s + 8 * fq); S0 = MFMA16(cur.K0[s], Vb, S0); S1 = MFMA16(cur.K1[s], Vb, S1); }
    { u32x2 p0, p1; p0.x = pk2(S0[0], S0[1]); p0.y = pk2(S0[2], S0[3]); p1.x = pk2(S1[0], S1[1]); p1.y = pk2(S1[2], S1[3]);
      *(LAS u32x2*)(Sl + fr * 136 + 32 * mt + 4 * fq) = p0; *(LAS u32x2*)(Sl + fr * 136 + 32 * mt + 16 + 4 * fq) = p1; }
    __syncthreads();
}
__device__ __forceinline__ void scan_stepB(const ScanB& cur, const LAS bf16_t* Sl, const LAS bf16_t* Vl, bf16_t* og, int fr, int fq) {
    f32x4 qs = {0.f, 0.f, 0.f, 0.f};
#pragma unroll
    for (int s = 0; s < 4; ++s) qs = MFMA16(*(const LAS bf16x8*)(Sl + fr * 136 + 32 * s + 8 * fq), cur.Q[s], qs);
    __syncthreads();
#pragma unroll
    for (int s = 0; s < 2; ++s) qs = MFMA16(*(const LAS bf16x8*)(Vl + fr * 72 + 32 * s + 8 * fq), cur.A[s], qs);
    { u32x2 w; w.x = pk2(qs[0], qs[1]); w.y = pk2(qs[2], qs[3]); *(u32x2*)og = w; }
    __syncthreads();
}
__device__ __forceinline__ void scan_wg(const Params& P, LAS unsigned char* lds, int h, int pair, const int VAR) {
    const int tid = opaque_tid(), lane = tid & 63, wave = tid >> 6, fr = lane & 15, fq = lane >> 4, mt = wave & 3, e0 = 16 * pair;
    const unsigned char* ws = P.ws;
    LAS bf16_t* Sl = (LAS bf16_t*)(lds);
    LAS bf16_t* Vl = (LAS bf16_t*)(lds + 4352);
    for (int i = tid; i < 4352 / 4; i += 512) ((LAS unsigned*)Sl)[i] = 0u;
    ScanOff f; f.w = (unsigned)(mt * 4096 + lane * 16); f.aq = (unsigned)(mt * 2048 + lane * 16); f.kt = (unsigned)(mt * 4096 + lane * 16); f.u = (unsigned)((((e0 >> 4) * 4 + mt) * 64 + lane) * 16);
    if (wave < 4) {
        f32x4 S0 = {0.f, 0.f, 0.f, 0.f}, S1 = {0.f, 0.f, 0.f, 0.f};
        ScanA a, b, c3; scan_loadA(a, ws, 0, h, f); scan_loadA(b, ws, 1, h, f);
        __syncthreads();
#pragma unroll 1
        for (int c = 0; c < NCH - 2; c += 3) {
            if (VAR != 3) scan_loadA(c3, ws, c + 2, h, f); scan_stepA(a, S0, S1, Sl, Vl, fr, fq, mt);
            if (VAR != 3) scan_loadA(a, ws, c + 3, h, f); scan_stepA(b, S0, S1, Sl, Vl, fr, fq, mt);
            if (VAR != 3) scan_loadA(b, ws, c + 4, h, f); scan_stepA(VAR == 3 ? a : c3, S0, S1, Sl, Vl, fr, fq, mt);
        }
        scan_stepA(a, S0, S1, Sl, Vl, fr, fq, mt); scan_stepA(b, S0, S1, Sl, Vl, fr, fq, mt);
    } else {
        bf16_t* Og = (bf16_t*)(P.ws + (VAR ? WS_END : WS_YA)) + (size_t)(16 * mt + fr) * 1024 + h * DH + e0 + 4 * fq;
        ScanB a, b, c3; scan_loadB(a, ws, 0, h, f); scan_loadB(b, ws, 1, h, f);
        __syncthreads();
#pragma unroll 1
        for (int c = 0; c < NCH - 2; c += 3) {
            if (VAR != 3) scan_loadB(c3, ws, c + 2, h, f); scan_stepB(a, Sl, Vl, Og + (size_t)c * 65536, fr, fq);
            if (VAR != 3) scan_loadB(a, ws, c + 3, h, f); scan_stepB(b, Sl, Vl, Og + (size_t)(c + 1) * 65536, fr, fq);
            if (VAR != 3) scan_loadB(b, ws, c + 4, h, f); scan_stepB(VAR == 3 ? a : c3, Sl, Vl, Og + (size_t)(c + 2) * 65536, fr, fq);
        }
        scan_stepB(a, Sl, Vl, Og + (size_t)(NCH - 2) * 65536, fr, fq); scan_stepB(b, Sl, Vl, Og + (size_t)(NCH - 1) * 65536, fr, fq);
    }
}

__device__ __forceinline__ void scan_helper(const Params& P, int h, int j, int NHp) {
    const int tid = threadIdx.x;
    const unsigned char* ws = P.ws;
    unsigned* prog = (unsigned*)(P.ws + WS_PROG) + h * 32;
    for (int c = j; c < NCH; c += NHp) {
        for (;;) { const unsigned pr = __hip_atomic_load(prog, __ATOMIC_RELAXED, __HIP_MEMORY_SCOPE_AGENT); if ((int)pr + 16 >= c) break; __builtin_amdgcn_s_sleep(16); }
        const int item = c * 8 + h;
        const u32x4* w16 = (const u32x4*)(ws + WS_W + (size_t)item * 16384); const u32x4* q16 = (const u32x4*)(ws + WS_QD + (size_t)item * 16384);
        const u32x4* k16 = (const u32x4*)(ws + WS_KTT + (size_t)item * 16384); const u32x4* a16 = (const u32x4*)(ws + WS_AQK + (size_t)item * 8192);
        const u32x4* u16 = (const u32x4*)(ws + WS_U + (size_t)item * 32768);
        u32x4 v[11];
        v[0] = w16[tid]; v[1] = w16[512 + tid]; v[2] = q16[tid]; v[3] = q16[512 + tid]; v[4] = k16[tid]; v[5] = k16[512 + tid]; v[6] = a16[tid];
        v[7] = u16[tid]; v[8] = u16[512 + tid]; v[9] = u16[1024 + tid]; v[10] = u16[1536 + tid];
#pragma unroll
        for (int i = 0; i < 11; ++i) asm volatile("" :: "v"(v[i]));
    }
}

constexpr int AL_K = 0, AL_V = 2 * 64 * 272, AL_B = AL_V + 2 * 128 * 144;
__device__ __forceinline__ void attn_compute(const LAS unsigned char* Kl, const LAS unsigned char* Vl, const LAS float* biasl, const bf16x8 (&Qb)[4], f32x4 (&Ot)[8], float& mrun, float& lrun,
                                             int c, int qi, int fr, int fq) {
    const float scale = 0.08838834764831845f;
    f32x4 st[4]; float mx = -1e30f;
#pragma unroll
    for (int kt = 0; kt < 4; ++kt) {
        f32x4 a = {0.f, 0.f, 0.f, 0.f};
#pragma unroll
        for (int s = 0; s < 4; ++s) a = MFMA16(*(const LAS bf16x8*)(Kl + (16 * kt + fr) * 272 + 64 * s + 16 * fq), Qb[s], a);
#pragma unroll
        for (int r = 0; r < 4; ++r) {
            const int ki = c * 64 + 16 * kt + 4 * fq + r; int dd = qi - ki; dd = dd < -63 ? -63 : (dd > 128 ? 128 : dd);
            a[r] = a[r] * scale + biasl[dd + 63]; mx = fmaxf(mx, a[r]);
        }
        st[kt] = a;
    }
    mx = fmaxf(mx, __shfl_xor(mx, 16)); mx = fmaxf(mx, __shfl_xor(mx, 32));
    const float mnew = fmaxf(mrun, mx), alpha = __expf(mrun - mnew); mrun = mnew;
    float rsum = 0.f;
#pragma unroll
    for (int kt = 0; kt < 4; ++kt)
#pragma unroll
        for (int r = 0; r < 4; ++r) { const float p = __expf(st[kt][r] - mnew); st[kt][r] = p; rsum += p; }
    lrun = lrun * alpha + rsum;
    bf16x8 Pb[2];
#pragma unroll
    for (int s = 0; s < 2; ++s) Pb[s] = pack_acc(st[2 * s], st[2 * s + 1]);
#pragma unroll
    for (int dt = 0; dt < 8; ++dt) {
        f32x4 o = Ot[dt] * alpha;
#pragma unroll
        for (int s = 0; s < 2; ++s) { const LAS unsigned char* pv = Vl + (16 * dt + fr) * 144 + 64 * s + 8 * fq;
            const u32x2 lo = *(const LAS u32x2*)pv, hi = *(const LAS u32x2*)(pv + 32); u32x4 av; av.x = lo.x; av.y = lo.y; av.z = hi.x; av.w = hi.y;
            o = MFMA16(__builtin_bit_cast(bf16x8, av), Pb[s], o); }
        Ot[dt] = o;
    }
}
__device__ __forceinline__ void attn_item(const Params& P, LAS unsigned char* lds, int m, int h) {
    const int tid = opaque_tid(), lane = tid & 63, wave = tid >> 6, fr = lane & 15, fq = lane >> 4;
    unsigned char* ws = P.ws;
    const bf16_t* proj = (const bf16_t*)(ws + WS_PROJ); const bf16_t* vt = (const bf16_t*)(ws + WS_VT); bf16_t* yb = (bf16_t*)(ws + WS_YB);
    LAS float* biasl = (LAS float*)(lds + AL_B);
    const int nq = 2 * m + (wave >> 2), w4 = wave & 3;
    const int qi = nq * 64 + 16 * w4 + fr;
    const int cbeg = 2 * m - 8 < 0 ? 0 : 2 * m - 8, cend = 2 * m + 1;
    const bf16_t* kg[2]; const bf16_t* vg[2]; int kl[2], vl[2];
#pragma unroll
    for (int i = 0; i < 2; ++i) { const int p = tid + 512 * i;
        kg[i] = proj + (size_t)(p >> 4) * NIN + C_KB + h * DH + 8 * (p & 15); kl[i] = (p >> 4) * 272 + 16 * (p & 15);
        vg[i] = vt + (size_t)(h * DH + (p >> 3)) * M + 8 * (p & 7); vl[i] = (p >> 3) * 144 + 16 * (p & 7); }
#define ATT_LOAD(KR, VR, C) do { _Pragma("unroll") for (int i = 0; i < 2; ++i) { KR[i] = *(const u32x4*)(kg[i] + (size_t)(C) * 64 * NIN); VR[i] = *(const u32x4*)(vg[i] + (C) * 64); } } while (0)
#define ATT_WRITE(KR, VR, BUF) do { _Pragma("unroll") for (int i = 0; i < 2; ++i) { *(LAS u32x4*)(lds + AL_K + (BUF) * (64 * 272) + kl[i]) = KR[i]; *(LAS u32x4*)(lds + AL_V + (BUF) * (128 * 144) + vl[i]) = VR[i]; } } while (0)
    u32x4 kA[2], vA[2], kB[2], vB[2];
    ATT_LOAD(kA, vA, cbeg);
    ATT_LOAD(kB, vB, cbeg + 1);
    if (tid < 192) biasl[tid] = P.rel_bias[h * 192 + tid];
    bf16x8 Qb[4];
#pragma unroll
    for (int s = 0; s < 4; ++s) Qb[s] = ld8(proj + (size_t)qi * NIN + C_QB + h * DH + 32 * s + 8 * fq);
    ATT_WRITE(kA, vA, 0);
    __syncthreads();
    float mrun = -1e30f, lrun = 0.f;
    f32x4 Ot[8];
#pragma unroll
    for (int i = 0; i < 8; ++i) Ot[i] = (f32x4){0.f, 0.f, 0.f, 0.f};
#pragma unroll 1
    for (int c = cbeg; c <= cend; c += 2) {
        if (c + 2 <= cend) ATT_LOAD(kA, vA, c + 2);
        if (c >= nq - 8 && c <= nq) attn_compute(lds + AL_K, lds + AL_V, biasl, Qb, Ot, mrun, lrun, c, qi, fr, fq);
        if (c + 1 <= cend) ATT_WRITE(kB, vB, 1);
        __syncthreads();
        if (c + 1 > cend) break;
        if (c + 3 <= cend) ATT_LOAD(kB, vB, c + 3);
        if (c + 1 >= nq - 8 && c + 1 <= nq) attn_compute(lds + AL_K + 64 * 272, lds + AL_V + 128 * 144, biasl, Qb, Ot, mrun, lrun, c + 1, qi, fr, fq);
        if (c + 2 <= cend) ATT_WRITE(kA, vA, 0);
        __syncthreads();
    }
#undef ATT_LOAD
#undef ATT_WRITE
    lrun += __shfl_xor(lrun, 16); lrun += __shfl_xor(lrun, 32);
    const float inv = 1.f / lrun;
#pragma unroll
    for (int dt = 0; dt < 8; ++dt) { u32x2 w; w.x = pk2(Ot[dt][0] * inv, Ot[dt][1] * inv); w.y = pk2(Ot[dt][2] * inv, Ot[dt][3] * inv);
        *(u32x2*)(yb + (size_t)qi * 1024 + h * DH + 16 * dt + 4 * fq) = w; }
}

__device__ __forceinline__ void phase_gnorm(const Params& P, int G) {
    unsigned char* ws = P.ws;
    bf16_t* ya = (bf16_t*)(ws + WS_YA); const bf16_t* proj = (const bf16_t*)(ws + WS_PROJ);
    const int gt = blockIdx.x * 512 + opaque_tid(), l16 = gt & 15;
    const f32x4 w0 = *(const f32x4*)(P.gdn_norm + 8 * l16), w1 = *(const f32x4*)(P.gdn_norm + 8 * l16 + 4);
    const int stride = (G * 512) >> 4;
    for (int g0 = gt >> 4; g0 < M * NH; g0 += 4 * stride) {
        u32x4 ro[4], rz[4]; bf16_t* po[4];
#pragma unroll
        for (int q = 0; q < 4; ++q) { const int g = g0 + q * stride; const int row = g >> 3, h = g & 7;
            po[q] = ya + (size_t)row * 1024 + h * DH + 8 * l16;
            if (g < M * NH) { ro[q] = *(const u32x4*)po[q]; rz[q] = __builtin_nontemporal_load((const u32x4*)(proj + (size_t)row * NIN + C_Z + h * DH + 8 * l16)); } }
#pragma unroll
        for (int q = 0; q < 4; ++q) if (g0 + q * stride < M * NH) {
            float o[8], z[8]; unpack8(ro[q], o); unpack8(rz[q], z);
            float sq = 0.f;
#pragma unroll
            for (int e = 0; e < 8; ++e) sq += o[e] * o[e];
            sq += __shfl_xor(sq, 1); sq += __shfl_xor(sq, 2); sq += __shfl_xor(sq, 4); sq += __shfl_xor(sq, 8);
            const float rn = rsqrtf(sq * (1.f / DH) + EPS);
#pragma unroll
            for (int e = 0; e < 8; ++e) o[e] = o[e] * rn * (e < 4 ? w0[e] : w1[e - 4]) * siluf_(z[e]);
            *(u32x4*)po[q] = pack8f(o);
        }
    }
}

#define XB_TMO      128
#define XB_XCNT(j)  (256  + 64 * (j))
#define XB_XSUB(j)  (1280 + 64 * (j))
#define XB_XGEN(j)  (2304 + 64 * (j))
#define XB_TOP      3328
#define XB_TOPGEN   3392
#define XCD_BAR_WORDS 3456
#define XB_SPIN_CAP (1u << 18)
__device__ __forceinline__ unsigned xb_ld(unsigned* p)              { return __hip_atomic_load(p, __ATOMIC_RELAXED, __HIP_MEMORY_SCOPE_AGENT); }
__device__ __forceinline__ unsigned xb_add(unsigned* p, unsigned v) { return __hip_atomic_fetch_add(p, v, __ATOMIC_RELAXED, __HIP_MEMORY_SCOPE_AGENT); }
__device__ __forceinline__ unsigned xb_xcc_id() { return (unsigned)__builtin_amdgcn_s_getreg((3 << 11) | 20) & 0xFu; }
#define XB_SPIN(cond, bar) do { unsigned _sp = 0; while (cond) { __builtin_amdgcn_s_sleep(1); \
    if ((++_sp & 255u) == 0u) { if (xb_ld(&(bar)[XB_TMO])) break; if (_sp > XB_SPIN_CAP) { atomicAdd(&(bar)[XB_TMO], 1u); break; } } } } while (0)
struct XcdBarrier { unsigned* bar; unsigned x; volatile LAS unsigned* st; };
__device__ __forceinline__ XcdBarrier xcd_barrier_post(unsigned* bar, volatile LAS unsigned* st) {
    XcdBarrier b; b.bar = bar; b.x = xb_xcc_id(); b.st = st;
    if (threadIdx.x == 0) (void)xb_add(&bar[XB_XCNT(b.x)], 1u);
    return b;
}
__device__ __forceinline__ void xcd_barrier_complete(unsigned* bar, unsigned x, unsigned& nloc, unsigned& nx) {
    const unsigned G = gridDim.x * gridDim.y * gridDim.z;
    unsigned sum, cnt, mine, sp = 0u;
    for (;;) {
        sum = 0u; cnt = 0u; mine = 0u;
#pragma unroll
        for (unsigned j = 0; j < 16; ++j) { const unsigned c = xb_ld(&bar[XB_XCNT(j)]); sum += c; cnt += (c > 0u) ? 1u : 0u; mine = (j == x) ? c : mine; }
        if (sum == G) break;
        __builtin_amdgcn_s_sleep(1);
        if ((++sp & 255u) == 0u) { if (xb_ld(&bar[XB_TMO])) break; if (sp > XB_SPIN_CAP) { atomicAdd(&bar[XB_TMO], 1u); break; } }
    }
    nloc = mine > 0u ? mine : 1u; nx = cnt > 0u ? cnt : 1u;
}
__device__ __forceinline__ void xcd_barrier(const XcdBarrier& b) {
    asm volatile("s_waitcnt vmcnt(0)" ::: "memory");
    __syncthreads();
    if (threadIdx.x == 0) {
        unsigned* bar = b.bar;
        __builtin_amdgcn_s_waitcnt(0);
        unsigned nloc = b.st[0], nx = b.st[1];
        if (nloc == 0u) { xcd_barrier_complete(bar, b.x, nloc, nx); b.st[0] = nloc; b.st[1] = nx; }
        const unsigned old = xb_add(&bar[XB_XSUB(b.x)], 1u);
        const unsigned gen = old / nloc;
        if (old + 1u == (gen + 1u) * nloc) {
            __builtin_amdgcn_fence(__ATOMIC_RELEASE, "agent");
            asm volatile("s_waitcnt vmcnt(0)" ::: "memory");
            const unsigned og = xb_add(&bar[XB_TOP], 1u);
            const unsigned tg = og / nx;
            if (og + 1u == (tg + 1u) * nx) xb_add(&bar[XB_TOPGEN], 1u);
            else XB_SPIN(xb_ld(&bar[XB_TOPGEN]) == tg, bar);
            __builtin_amdgcn_fence(__ATOMIC_ACQUIRE, "agent");
            xb_add(&bar[XB_XGEN(b.x)], 1u);
            asm volatile("s_waitcnt vmcnt(0)" ::: "memory");
        } else {
            XB_SPIN(xb_ld(&bar[XB_XGEN(b.x)]) == gen, bar);
            __builtin_amdgcn_fence(__ATOMIC_ACQUIRE, "agent");
            asm volatile("s_waitcnt vmcnt(0)" ::: "memory");
        }
    }
    __syncthreads();
}

constexpr int NPHASE = 11;
__global__ void __launch_bounds__(512, 2) fwd_megakernel(Params P) {
    extern __shared__ __attribute__((aligned(16))) unsigned char smem[];
    LAS unsigned char* lds = (LAS unsigned char*)smem;
    cg::grid_group grid = cg::this_grid();
    const int G = gridDim.x, lo = P.ph_lo, hi = P.ph_hi & 255, pflags = P.ph_hi >> 8;
    unsigned char* ws = P.ws;
    float* ss = (float*)(ws + WS_SS);
    bf16_t* xb = (bf16_t*)(ws + WS_XB); bf16_t* act = (bf16_t*)(ws + WS_ACT); bf16_t* proj = (bf16_t*)(ws + WS_PROJ);
#ifndef NREP5
#define NREP5 1
#endif
#ifndef REP_PHASE
#define REP_PHASE -1
#endif
#define IN(k) (lo <= (k) && (k) < hi)
    volatile LAS unsigned* xst = (volatile LAS unsigned*)(lds + LDS_BYTES - 16);
    if (threadIdx.x == 0) { xst[0] = 0u; xst[1] = 0u; }
    __syncthreads();
    XcdBarrier xbar = xcd_barrier_post((unsigned*)(ws + WS_BAR), xst);
    if (lo < 0) grid.sync();
#define SEAM(k) do { if (IN(k) && IN((k) + 1)) xcd_barrier(xbar); } while (0)
    for (int rep = 0; rep < (REP_PHASE == 0 ? 2 : 1); ++rep) { if (IN(0)) phase_convert(P, lds, G);
    SEAM(0); }
    for (int rep = 0; rep < (REP_PHASE == 1 ? 2 : 1); ++rep) {
    if (IN(1)) { pg8::Sched S; S.init(xb, (const bf16_t*)(ws + WS_WGU1), nullptr, nullptr, M, NGU, G, blockIdx.x, 0); EpiGU E{act, ss}; pg8::gemm_phase(lds, D, S, E);
        idle_convert(P, lds, (M / 256) * (NGU / 256), G, -1, 0); }
    SEAM(1); }
    if (IN(2)) { pg8::Sched S; S.init(act, (const bf16_t*)(ws + WS_WD1), nullptr, nullptr, M, D, G, blockIdx.x, 0); EpiRes E{P.x, P.out, xb, ss + M, 0.5f}; pg8::gemm_phase(lds, FF, S, E); }
    SEAM(2);
    if (IN(3)) { pg8::Sched S; S.init(xb, (const bf16_t*)(ws + WS_WIN), nullptr, nullptr, M, NIN, G, blockIdx.x, 0); EpiProj E{proj, ss + M}; pg8::gemm_phase(lds, D, S, E);
        idle_convert(P, lds, (M / 256) * (NIN / 256), G, 0, LATE_A); }
    SEAM(3);
    if (IN(4)) { const int nit = (NCH * NH - 1 - (int)blockIdx.x) / G; for (int k = nit; k >= 0; --k) prep_item(P, lds, blockIdx.x + k * G, pflags); }
    SEAM(4);
_Pragma("unroll 1")
    for (int rep = 0; rep < NREP5; ++rep) {
    if (IN(5)) {
        const int tid5 = opaque_tid(), wave = tid5 >> 6, b = blockIdx.x;
        if (b < 64) { if (!(pflags & 4)) scan_wg(P, lds, b & 7, b >> 3, 0); }
        else { if (!(pflags & 2)) for (int it = b - 64; it < (NCH / 2) * NH; it += G - 64) attn_item(P, lds, it >> 3, it & 7);
            if (!(pflags & 1)) convert_late(P, (LAS float*)(lds + wave * 17408), ((((M / 256) * (NIN / 256)) % G) ? LATE_A : 0), ((((M / 256) * (NGU / 256)) % G) ? LATE_C : N_LATE), (b - 64) * 8 + wave, (G - 64) * 8, tid5 & 63); }
    }
    SEAM(5); }
    if (IN(6)) phase_gnorm(P, G);
    SEAM(6);
    if (IN(7)) { pg8::Sched S; S.init((const bf16_t*)(ws + WS_YA), (const bf16_t*)(ws + WS_WA), (const bf16_t*)(ws + WS_YB), (const bf16_t*)(ws + WS_WB), M, D, G, blockIdx.x, 1);
        EpiMix E{proj, (bf16_t*)(ws + WS_MIX)}; pg8::gemm_phase(lds, 1024, S, E); }
    SEAM(7);
    if (IN(8)) { pg8::Sched S; S.init((const bf16_t*)(ws + WS_MIX), (const bf16_t*)(ws + WS_WOUT), nullptr, nullptr, M, D, G, blockIdx.x, 0); EpiRes E{P.out, P.out, xb, ss + 2 * M, 1.0f}; pg8::gemm_phase(lds, D, S, E); }
    SEAM(8);
    if (IN(9)) { pg8::Sched S; S.init(xb, (const bf16_t*)(ws + WS_WGU2), nullptr, nullptr, M, NGU, G, blockIdx.x, 0); EpiGU E{act, ss + 2 * M}; pg8::gemm_phase(lds, D, S, E);
        idle_convert(P, lds, (M / 256) * (NGU / 256), G, LATE_C, N_LATE); }
    SEAM(9);
    if (IN(10)) { pg8::Sched S; S.init(act, (const bf16_t*)(ws + WS_WD2), nullptr, nullptr, M, D, G, blockIdx.x, 0); EpiRes E{P.out, P.out, xb, ss + 3 * M, 0.5f}; pg8::gemm_phase(lds, FF, S, E); }
    SEAM(10);
    if (IN(11)) {
        { pg8::Sched S; S.init((const bf16_t*)(ws + WS_PB), (const bf16_t*)(ws + WS_WPP), nullptr, nullptr, M, D, G, blockIdx.x, 0); EpiF32 E{(float*)(ws + WS_RBUF)}; pg8::gemm_phase(lds, PLE, S, E); }
        { pg8::Sched S; S.init(xb, (const bf16_t*)(ws + WS_WPG), nullptr, nullptr, M, D, G, blockIdx.x, 0); EpiPle E{P.out, (const float*)(ws + WS_RBUF), ss + 3 * M}; pg8::gemm_phase(lds, D, S, E); }
    }
#undef IN
#undef SEAM
}


#ifdef PROBE_VAR
__global__ void __launch_bounds__(512, 2) probe_scan(Params P) {
    extern __shared__ __attribute__((aligned(16))) unsigned char smem[];
    scan_wg(P, (LAS unsigned char*)smem, blockIdx.x & 7, blockIdx.x >> 3, PROBE_VAR);
}
#endif
#ifndef N_LAUNCH_MODE
#define N_LAUNCH_MODE 0
#endif
extern "C" void kernel_launch(void* const* d_in, const int* in_sizes, int n_in, void* d_out, int out_size, void* d_ws, size_t ws_size, hipStream_t stream) {
    static int grid = 0;
    if (grid == 0) {
        if (n_in != 23 || out_size != M * D || ws_size < WS_END) { fprintf(stderr, "kernel_launch: unexpected problem (n_in %d out %d ws %zu need %zu)\n", n_in, out_size, ws_size, (size_t)WS_END); grid = -1; return; }
        int dev = 0, cus = 0, per_cu = 0;
        hipGetDevice(&dev); hipDeviceGetAttribute(&cus, hipDeviceAttributeMultiprocessorCount, dev);
        if (hipFuncSetAttribute((const void*)fwd_megakernel, hipFuncAttributeMaxDynamicSharedMemorySize, LDS_BYTES) != hipSuccess) { fprintf(stderr, "kernel_launch: hipFuncSetAttribute failed\n"); grid = -1; return; }
        if (hipOccupancyMaxActiveBlocksPerMultiprocessor(&per_cu, (const void*)fwd_megakernel, 512, LDS_BYTES) != hipSuccess || per_cu < 1) { fprintf(stderr, "kernel_launch: occupancy query failed (%d)\n", per_cu); (void)hipGetLastError(); per_cu = 1; }
        grid = cus * 1;
        if (grid < 192) { fprintf(stderr, "kernel_launch: grid too small\n"); grid = -1; return; }
    }
    if (grid < 0) return;
    if (hipMemsetAsync((char*)d_ws + WS_BAR, 0, 16384, stream) != hipSuccess) { fprintf(stderr, "kernel_launch: memset of the barrier words failed\n"); return; }
    Params p{};
    const float** pp = (const float**)&p;
    for (int i = 0; i < 23; ++i) pp[i] = (const float*)d_in[i];
    p.out = (float*)d_out; p.ws = (unsigned char*)d_ws;
#if N_LAUNCH_MODE == 0
    p.ph_lo = 0; p.ph_hi = NPHASE + 1;
    void* args[] = {&p};
    hipError_t e = hipLaunchCooperativeKernel((const void*)fwd_megakernel, dim3(grid), dim3(512), args, LDS_BYTES, stream);
    if (e != hipSuccess) fprintf(stderr, "cooperative launch failed: %s (grid %d)\n", hipGetErrorString(e), grid);
#ifdef PROBE_VAR
    hipLaunchKernelGGL(probe_scan, dim3(64), dim3(512), 16384, stream, p);
#endif
#ifdef PROBE_PHASE
    p.ph_lo = PROBE_PHASE; p.ph_hi = (PROBE_PHASE + 1) | (PROBE_FLAGS << 8); hipLaunchKernelGGL(fwd_megakernel, dim3(grid), dim3(512), LDS_BYTES, stream, p);
#endif
#else
    for (int ph = 0; ph <= NPHASE; ++ph) { p.ph_lo = ph; p.ph_hi = ph + 1; hipLaunchKernelGGL(fwd_megakernel, dim3(grid), dim3(512), LDS_BYTES, stream, p); }
#endif
}
```

```cpp
#include <hip/hip_runtime.h>
#include <hip/hip_cooperative_groups.h>
#include <cstdio>
namespace cg = cooperative_groups;

#define LAS __attribute__((address_space(3)))
typedef unsigned short bf16_t;
typedef short bf16x8 __attribute__((ext_vector_type(8)));
typedef float f32x4 __attribute__((ext_vector_type(4)));
typedef unsigned u32x4 __attribute__((ext_vector_type(4)));
typedef unsigned u32x2 __attribute__((ext_vector_type(2)));
typedef __bf16 bf16v2 __attribute__((ext_vector_type(2)));

constexpr int M = 8192, D = 2048, FF = 5632, NGU = 11264, NIN = 11520, NINSRC = 11280, PLE = 256;
constexpr int NH = 8, DH = 128, NCH = 128;
constexpr int C_QA = 0, C_KA = 1024, C_VA = 2048, C_Z = 3072, C_QB = 4096, C_KB = 5120, C_VB = 6144, C_GA = 7168, C_GB = 9216, C_AR = 11264, C_BR = 11272;
constexpr float EPS = 1e-6f;
constexpr size_t WS_WGU1 = 0;
constexpr size_t WS_WD1  = WS_WGU1 + (size_t)NGU * D * 2;
constexpr size_t WS_WIN  = WS_WD1 + (size_t)D * FF * 2;
constexpr size_t WS_WA   = WS_WIN + (size_t)NIN * D * 2;
constexpr size_t WS_WB   = WS_WA + (size_t)D * 1024 * 2;
constexpr size_t WS_WOUT = WS_WB + (size_t)D * 1024 * 2;
constexpr size_t WS_WGU2 = WS_WOUT + (size_t)D * D * 2;
constexpr size_t WS_WD2  = WS_WGU2 + (size_t)NGU * D * 2;
constexpr size_t WS_WPG  = WS_WD2 + (size_t)D * FF * 2;
constexpr size_t WS_WPP  = WS_WPG + (size_t)D * D * 2;
constexpr size_t WS_XB   = WS_WPP + (size_t)D * PLE * 2;
constexpr size_t WS_PROJ = WS_XB + (size_t)M * D * 2;
constexpr size_t WS_AQK  = WS_PROJ + (size_t)M * NIN * 2;
constexpr size_t WS_KTT  = WS_AQK + (size_t)1024 * 64 * 64 * 2;
constexpr size_t WS_PB   = WS_KTT + (size_t)M * 1024 * 2;
constexpr size_t WS_VT   = WS_PB + (size_t)M * PLE * 2;
constexpr size_t WS_SS   = WS_VT + (size_t)M * 1024 * 2;
constexpr size_t WS_TAIL = WS_SS + (size_t)4 * M * 4;
constexpr size_t WS_PROG = WS_TAIL + 4096;
constexpr size_t WS_BAR  = WS_PROG + 4096;
constexpr size_t WS_END  = WS_BAR + 16384;
constexpr size_t WS_ACT  = WS_PROJ;
constexpr size_t WS_RBUF = WS_PROJ;
constexpr size_t WS_U    = 0;
constexpr size_t WS_W    = WS_U + (size_t)M * 1024 * 4;
constexpr size_t WS_QD   = WS_W + (size_t)M * 1024 * 2;
constexpr size_t WS_MIX  = 0;
constexpr size_t WS_YB   = WS_XB;
constexpr size_t WS_YA   = WS_XB + (size_t)M * 1024 * 2;
static_assert(WS_QD + (size_t)M * 1024 * 2 <= WS_WIN, "gdn scratch overlaps live weights");

constexpr int LDS_BYTES = 147456;

__device__ __forceinline__ unsigned pk2(float lo, float hi) { bf16v2 v = {(__bf16)lo, (__bf16)hi}; return __builtin_bit_cast(unsigned, v); }
__device__ __forceinline__ float bf2f(bf16_t b) { return __uint_as_float(((unsigned)b) << 16); }
__device__ __forceinline__ float bflo(unsigned w) { return __uint_as_float(w << 16); }
__device__ __forceinline__ float bfhi(unsigned w) { return __uint_as_float(w & 0xffff0000u); }
__device__ __forceinline__ void unpack8(u32x4 w, float (&f)[8]) { f[0] = bflo(w.x); f[1] = bfhi(w.x); f[2] = bflo(w.y); f[3] = bfhi(w.y); f[4] = bflo(w.z); f[5] = bfhi(w.z); f[6] = bflo(w.w); f[7] = bfhi(w.w); }
__device__ __forceinline__ u32x4 pack8f(const float (&f)[8]) { u32x4 w; w.x = pk2(f[0], f[1]); w.y = pk2(f[2], f[3]); w.z = pk2(f[4], f[5]); w.w = pk2(f[6], f[7]); return w; }
__device__ __forceinline__ bf16x8 pack_acc(f32x4 a, f32x4 b) { u32x4 p; p.x = pk2(a[0], a[1]); p.y = pk2(a[2], a[3]); p.z = pk2(b[0], b[1]); p.w = pk2(b[2], b[3]); return __builtin_bit_cast(bf16x8, p); }
__device__ __forceinline__ bf16x8 ld2x8(const bf16_t* p0, const bf16_t* p1) { const u32x2 a = *(const u32x2*)p0, b = *(const u32x2*)p1; u32x4 v; v.x = a.x; v.y = a.y; v.z = b.x; v.w = b.y; return __builtin_bit_cast(bf16x8, v); }
__device__ __forceinline__ bf16x8 ld8(const bf16_t* p) { return __builtin_bit_cast(bf16x8, *(const u32x4*)p); }
__device__ __forceinline__ float sigmoidf_(float x) { return __builtin_amdgcn_rcpf(1.f + __expf(-x)); }
__device__ __forceinline__ float siluf_(float x) { return x * __builtin_amdgcn_rcpf(1.f + __expf(-x)); }
__device__ __forceinline__ float wave_sum(float v) {
#pragma unroll
    for (int o = 1; o < 64; o <<= 1) v += __shfl_xor(v, o);
    return v;
}
__device__ __forceinline__ int opaque_tid() { int t = threadIdx.x; asm volatile("" : "+v"(t)); return t; }
#define MFMA16(a, b, c) __builtin_amdgcn_mfma_f32_16x16x32_bf16((a), (b), (c), 0, 0, 0)

namespace pg8 {
constexpr int BM = 256, BK = 64, HALF = 128, HTB = HALF * BK * 2, STAGE_BYTES = 8 * HTB, NXCD = 8, WGM = 8;
__device__ __forceinline__ int lds_byte(int r, int c) { const int st = (r >> 4) * 2 + (c >> 5), rr = r & 15, cc = c & 31, ob = rr * 64 + cc * 2; return st * 1024 + (ob ^ (((ob >> 9) & 1) << 5)); }
__device__ __forceinline__ void stage_rc(int b, int& R, int& C) { const int st = b / 1024, sb = b % 1024, swz = sb ^ (((sb >> 9) & 1) << 5); R = (st >> 1) * 16 + swz / 64; C = (st & 1) * 32 + (swz % 64) / 2; }
__device__ __forceinline__ int perm32(int rho) { const int n = rho >> 4, i = rho & 15; return 8 * (i >> 2) + 4 * n + (i & 3); }

struct Unit { int pm, pn, sel; };
struct Sched {
    const bf16_t *A0, *B0, *A1, *B1;
    int nM, nN, nwg, G, c, dual;
    __device__ __forceinline__ void init(const bf16_t* a0, const bf16_t* b0, const bf16_t* a1, const bf16_t* b1, int Mr, int Nc, int G_, int c_, int dual_) {
        A0 = a0; B0 = b0; A1 = a1; B1 = b1; nM = Mr / BM; nN = Nc / BM; nwg = nM * nN; G = G_; c = c_; dual = dual_; }
    __device__ __forceinline__ bool next(int i, Unit& u) const {
        const int tile = dual ? (i >> 1) : i;
        const long L = (long)tile * G + c; if (L >= nwg) return false;
        int wgid = (int)L; { const int q = nwg / NXCD, r = nwg % NXCD, xcd = wgid % NXCD, off = wgid / NXCD; wgid = (xcd < r ? xcd * (q + 1) : r * (q + 1) + (xcd - r) * q) + off; }
        const int nig = WGM * nN, gid = wgid / nig, fm = gid * WGM, gsz = (nM - fm) < WGM ? (nM - fm) : WGM;
        u.pm = fm + ((wgid % nig) % gsz); u.pn = (wgid % nig) / gsz; u.sel = dual ? (i & 1) : 0; return true;
    }
};

template <class Epi>
__device__ __forceinline__ void gemm_phase(LAS unsigned char* lds, const int K, const Sched& S, const Epi& E) {
    const int tid = opaque_tid(), wid = __builtin_amdgcn_readfirstlane(tid >> 6), lane = tid & 63, wr = wid >> 2, wc = wid & 3, fr = lane & 15, fq = lane >> 4;
    const int nt = K / BK;
    unsigned voffA[2], voffB[2];
#pragma unroll
    for (int i = 0; i < 2; ++i) { int R, C; stage_rc(tid * 16 + i * 8192, R, C); const int Rb = Epi::PERM ? ((R & ~31) + perm32(R & 31)) : R;
        voffA[i] = (unsigned)(R * K + C) * 2u; voffB[i] = (unsigned)(Rb * K + C) * 2u; }
    const size_t kstep = (size_t)(BK * 2);
    const size_t hstep = (size_t)HALF * K * 2;
    const size_t tstep = 2 * hstep;
    const unsigned ldsw = (unsigned)wid * 1024u;
    const int aoff = lds_byte(wr * 64 + fr, fq * 8), boff = lds_byte(wc * 32 + fr, fq * 8);
#define PG8_SA(b, h) (((b) * 2 + (h)) * HTB)
#define PG8_SB(b, h) ((4 + (b) * 2 + (h)) * HTB)
#define PG8_STAGE(bufoff, gbase, voff) do { _Pragma("unroll") for (int _i = 0; _i < 2; ++_i) \
        __builtin_amdgcn_global_load_lds((const unsigned*)((const char*)(gbase) + (voff)[_i]), (LAS unsigned*)(lds + (bufoff) + ldsw + _i * 8192), 16, 0, 0); } while (0)
#define PG8_LDA(dst, b, h) do { _Pragma("unroll") for (int m = 0; m < 4; ++m) _Pragma("unroll") for (int k = 0; k < 2; ++k) dst[m][k] = *(const LAS bf16x8*)(lds + PG8_SA(b, h) + aoff + m * 2048 + k * 1024); } while (0)
#define PG8_LDB(dst, b, h) do { _Pragma("unroll") for (int n = 0; n < 2; ++n) _Pragma("unroll") for (int k = 0; k < 2; ++k) dst[n][k] = *(const LAS bf16x8*)(lds + PG8_SB(b, h) + boff + n * 2048 + k * 1024); } while (0)
#define PG8_MMA(ai, bj, At, Bt) do { __builtin_amdgcn_s_setprio(1); _Pragma("unroll") for (int m = 0; m < 4; ++m) _Pragma("unroll") for (int n = 0; n < 2; ++n) _Pragma("unroll") for (int k = 0; k < 2; ++k) \
        acc[ai][bj][m][n] = __builtin_amdgcn_mfma_f32_16x16x32_bf16(Bt[n][k], At[m][k], acc[ai][bj][m][n], 0, 0, 0); __builtin_amdgcn_s_setprio(0); } while (0)
#define PG8_WAIT_V(n) asm volatile("s_waitcnt vmcnt(" #n ")" ::: "memory")
#define PG8_WAIT_L(n) asm volatile("s_waitcnt lgkmcnt(" #n ")" ::: "memory")
#define PG8_BAR __builtin_amdgcn_s_barrier()
#define PG8_SCHED __builtin_amdgcn_sched_barrier(0)
    Unit cur, nxt; int ui = 0;
    if (!S.next(0, cur)) return;
    float ssv[8]; E.pre(cur, wr, fr, ssv);
    f32x4 acc[2][2][4][2];
#pragma unroll
    for (int a = 0; a < 2; ++a)
#pragma unroll
        for (int b = 0; b < 2; ++b)
#pragma unroll
            for (int m = 0; m < 4; ++m)
#pragma unroll
                for (int n = 0; n < 2; ++n) acc[a][b][m][n] = (f32x4){0.f, 0.f, 0.f, 0.f};
    bf16x8 At[4][2], B0[2][2], B1[2][2];
    const char* cA = (const char*)(cur.sel ? S.A1 : S.A0) + (size_t)cur.pm * tstep; const char* cB = (const char*)(cur.sel ? S.B1 : S.B0) + (size_t)cur.pn * tstep;
    PG8_STAGE(PG8_SB(0, 0), cB, voffB); PG8_STAGE(PG8_SA(0, 0), cA, voffA); PG8_STAGE(PG8_SB(0, 1), cB + hstep, voffB); PG8_STAGE(PG8_SA(0, 1), cA + hstep, voffA);
    if (wr == 1) PG8_BAR;
    PG8_WAIT_V(4); PG8_BAR;
    PG8_STAGE(PG8_SB(1, 0), cB + kstep, voffB); PG8_STAGE(PG8_SA(1, 0), cA + kstep, voffA); PG8_STAGE(PG8_SB(1, 1), cB + hstep + kstep, voffB);
    PG8_WAIT_V(6); PG8_BAR;
    for (;;) {
        const bool has_next = S.next(ui + 1, nxt);
        const char* nA = has_next ? (const char*)(nxt.sel ? S.A1 : S.A0) + (size_t)nxt.pm * tstep : cA; const char* nB = has_next ? (const char*)(nxt.sel ? S.B1 : S.B0) + (size_t)nxt.pn * tstep : cB;
        for (int t = 0; t < nt; t += 2) {
            const bool last = (t == nt - 2);
            const char* a1 = cA + (size_t)(t + 1) * kstep;
            const char* a2 = last ? nA : cA + (size_t)(t + 2) * kstep; const char* b2 = last ? nB : cB + (size_t)(t + 2) * kstep;
            const char* a3 = a2 + kstep; const char* b3 = b2 + kstep;
            PG8_LDB(B0, 0, 0); PG8_SCHED; PG8_LDA(At, 0, 0); PG8_STAGE(PG8_SA(1, 1), a1 + hstep, voffA);
            PG8_WAIT_L(8); PG8_BAR; PG8_WAIT_L(0); PG8_MMA(0, 0, At, B0); PG8_BAR; PG8_SCHED;
            PG8_LDB(B1, 0, 1); PG8_STAGE(PG8_SB(0, 0), b2, voffB);
            PG8_BAR; PG8_WAIT_L(0); PG8_MMA(0, 1, At, B1); PG8_BAR;
            PG8_LDA(At, 0, 1); PG8_STAGE(PG8_SA(0, 0), a2, voffA);
            PG8_BAR; PG8_WAIT_L(0); PG8_MMA(1, 0, At, B0); PG8_BAR; PG8_SCHED;
            PG8_STAGE(PG8_SB(0, 1), b2 + hstep, voffB);
            PG8_WAIT_V(6); PG8_BAR; PG8_MMA(1, 1, At, B1); PG8_BAR;
            PG8_LDB(B0, 1, 0); PG8_SCHED; PG8_LDA(At, 1, 0); PG8_STAGE(PG8_SA(0, 1), a2 + hstep, voffA);
            PG8_WAIT_L(8); PG8_BAR; PG8_WAIT_L(0); PG8_MMA(0, 0, At, B0); PG8_BAR; PG8_SCHED;
            PG8_LDB(B1, 1, 1); PG8_STAGE(PG8_SB(1, 0), b3, voffB);
            PG8_BAR; PG8_WAIT_L(0); PG8_MMA(0, 1, At, B1); PG8_BAR;
            PG8_LDA(At, 1, 1); PG8_STAGE(PG8_SA(1, 0), a3, voffA);
            PG8_BAR; PG8_WAIT_L(0); PG8_MMA(1, 0, At, B0); PG8_BAR; PG8_SCHED;
            PG8_STAGE(PG8_SB(1, 1), b3 + hstep, voffB);
            PG8_WAIT_V(6); PG8_BAR; PG8_MMA(1, 1, At, B1); PG8_BAR;
        }
        E(acc, cur, wr, wc, fr, fq, ssv);
        if (!has_next) break;
        if (!E.keep(cur)) {
#pragma unroll
            for (int a = 0; a < 2; ++a)
#pragma unroll
                for (int b = 0; b < 2; ++b)
#pragma unroll
                    for (int m = 0; m < 4; ++m)
#pragma unroll
                        for (int n = 0; n < 2; ++n) acc[a][b][m][n] = (f32x4){0.f, 0.f, 0.f, 0.f};
        }
        cur = nxt; cA = nA; cB = nB; ++ui;
        E.pre(cur, wr, fr, ssv);
    }
    PG8_WAIT_V(0);
    if (wr == 0) PG8_BAR;
    PG8_BAR;
#undef PG8_SA
#undef PG8_SB
#undef PG8_STAGE
#undef PG8_LDA
#undef PG8_LDB
#undef PG8_MMA
#undef PG8_WAIT_V
#undef PG8_WAIT_L
#undef PG8_BAR
#undef PG8_SCHED
}
}
using pg8::Unit;
typedef f32x4 Acc[2][2][4][2];

struct EpiGU {
    static constexpr bool PERM = true;
    bf16_t* O; const float* ss;
    __device__ __forceinline__ void pre(const Unit& u, int wr, int fr, float (&ssv)[8]) const {
#pragma unroll
        for (int ai = 0; ai < 2; ++ai)
#pragma unroll
            for (int m = 0; m < 4; ++m) ssv[ai * 4 + m] = ss[u.pm * 256 + ai * 128 + wr * 64 + m * 16 + fr];
    }
    __device__ __forceinline__ bool keep(const Unit&) const { return false; }
    __device__ __forceinline__ void operator()(Acc& acc, const Unit& u, int wr, int wc, int fr, int fq, const float (&ssv)[8]) const {
        const int row0 = u.pm * 256 + wr * 64 + fr, col0 = u.pn * 128 + wc * 32 + 8 * fq;
#pragma unroll
        for (int ai = 0; ai < 2; ++ai)
#pragma unroll
            for (int m = 0; m < 4; ++m) {
                const int row = row0 + ai * 128 + m * 16;
                const float rs = rsqrtf(ssv[ai * 4 + m] * (1.f / D) + EPS);
                const float rs2 = rs * rs, nrl = -1.4426950408889634f * rs;
                float o[8];
#pragma unroll
                for (int n = 0; n < 2; ++n)
#pragma unroll
                    for (int j = 0; j < 4; j += 2) {
                        typedef float f32x2v __attribute__((ext_vector_type(2)));
                        const f32x2v g = {acc[ai][0][m][n][j], acc[ai][0][m][n][j + 1]}, uu = {acc[ai][1][m][n][j], acc[ai][1][m][n][j + 1]};
                        const f32x2v t = g * nrl, p = (g * uu) * rs2;
                        f32x2v d; d.x = __builtin_amdgcn_exp2f(t.x); d.y = __builtin_amdgcn_exp2f(t.y); d = d + 1.0f;
                        f32x2v r; r.x = __builtin_amdgcn_rcpf(d.x); r.y = __builtin_amdgcn_rcpf(d.y);
                        const f32x2v q = p * r; o[n * 4 + j] = q.x; o[n * 4 + j + 1] = q.y;
                    }
                *(u32x4*)(O + (size_t)row * FF + col0) = pack8f(o);
            }
    }
};
struct EpiRes {
    static constexpr bool PERM = false;
    const float* base; float* out; bf16_t* ob; float* ssn; float scale;
    __device__ __forceinline__ void pre(const Unit&, int, int, float (&ssv)[8]) const {
#pragma unroll
        for (int i = 0; i < 8; ++i) ssv[i] = 0.f; }
    __device__ __forceinline__ bool keep(const Unit&) const { return false; }
    __device__ __forceinline__ void operator()(Acc& acc, const Unit& u, int wr, int wc, int fr, int fq, const float (&ssv)[8]) const {
        const int row0 = u.pm * 256 + wr * 64 + fr, col0 = u.pn * 256 + wc * 32 + 4 * fq;
#pragma unroll
        for (int ai = 0; ai < 2; ++ai) {
            f32x4 b[4][2][2];
#pragma unroll
            for (int m = 0; m < 4; ++m)
#pragma unroll
                for (int bj = 0; bj < 2; ++bj)
#pragma unroll
                    for (int n = 0; n < 2; ++n) b[m][bj][n] = *(const f32x4*)(base + (size_t)(row0 + ai * 128 + m * 16) * D + col0 + bj * 128 + n * 16);
#pragma unroll
            for (int m = 0; m < 4; ++m) {
                const int row = row0 + ai * 128 + m * 16; float sq = 0.f;
#pragma unroll
                for (int bj = 0; bj < 2; ++bj)
#pragma unroll
                    for (int n = 0; n < 2; ++n) {
                        const size_t off = (size_t)row * D + col0 + bj * 128 + n * 16;
                        const f32x4 v = b[m][bj][n] + acc[ai][bj][m][n] * scale;
                        *(f32x4*)(out + off) = v;
                        sq += (v[0] * v[0] + v[1] * v[1]) + (v[2] * v[2] + v[3] * v[3]);
                        u32x2 w; w.x = pk2(v[0], v[1]); w.y = pk2(v[2], v[3]);
                        *(u32x2*)(ob + off) = w;
                    }
                sq += __shfl_xor(sq, 16); sq += __shfl_xor(sq, 32);
                if (fq == 0) unsafeAtomicAdd(ssn + row, sq);
            }
        }
    }
};
struct EpiProj {
    static constexpr bool PERM = true;
    bf16_t* O; const float* ss;
    __device__ __forceinline__ void pre(const Unit& u, int wr, int fr, float (&ssv)[8]) const {
#pragma unroll
        for (int ai = 0; ai < 2; ++ai)
#pragma unroll
            for (int m = 0; m < 4; ++m) ssv[ai * 4 + m] = ss[u.pm * 256 + ai * 128 + wr * 64 + m * 16 + fr];
    }
    __device__ __forceinline__ bool keep(const Unit&) const { return false; }
    __device__ __forceinline__ void operator()(Acc& acc, const Unit& u, int wr, int wc, int fr, int fq, const float (&ssv)[8]) const {
        const int row0 = u.pm * 256 + wr * 64 + fr, col0 = u.pn * 256 + wc * 32 + 8 * fq;
#pragma unroll
        for (int ai = 0; ai < 2; ++ai)
#pragma unroll
            for (int m = 0; m < 4; ++m) {
                const int row = row0 + ai * 128 + m * 16;
                const float rs = rsqrtf(ssv[ai * 4 + m] * (1.f / D) + EPS);
#pragma unroll
                for (int bj = 0; bj < 2; ++bj) {
                    float o[8];
#pragma unroll
                    for (int n = 0; n < 2; ++n)
#pragma unroll
                        for (int j = 0; j < 4; ++j) o[n * 4 + j] = acc[ai][bj][m][n][j] * rs;
                    *(u32x4*)(O + (size_t)row * NIN + col0 + bj * 128) = pack8f(o);
                }
            }
    }
};
struct EpiMix {
    static constexpr bool PERM = true;
    const bf16_t* proj; bf16_t* O;
    __device__ __forceinline__ void pre(const Unit&, int, int, float (&ssv)[8]) const {
#pragma unroll
        for (int i = 0; i < 8; ++i) ssv[i] = 0.f; }
    __device__ __forceinline__ bool keep(const Unit& u) const { return u.sel == 0; }
    __device__ __forceinline__ void operator()(Acc& acc, const Unit& u, int wr, int wc, int fr, int fq, const float (&ssv)[8]) const {
        const int row0 = u.pm * 256 + wr * 64 + fr, col0 = u.pn * 256 + wc * 32 + 8 * fq;
#pragma unroll
        for (int ai = 0; ai < 2; ++ai) {
            u32x4 rga[4][2], rgb[4][2];
#pragma unroll
            for (int m = 0; m < 4; ++m)
#pragma unroll
                for (int bj = 0; bj < 2; ++bj) { const size_t o = (size_t)(row0 + ai * 128 + m * 16) * NIN + col0 + bj * 128;
                    rga[m][bj] = *(const u32x4*)(proj + o + C_GA); rgb[m][bj] = *(const u32x4*)(proj + o + C_GB); }
#pragma unroll
            for (int m = 0; m < 4; ++m) {
                const int row = row0 + ai * 128 + m * 16;
#pragma unroll
                for (int bj = 0; bj < 2; ++bj) {
                    const int col = col0 + bj * 128;
                    float ga[8], gb[8];
                    unpack8(rga[m][bj], ga);
                    unpack8(rgb[m][bj], gb);
                    if (u.sel == 0) {
#pragma unroll
                        for (int n = 0; n < 2; ++n)
#pragma unroll
                            for (int j = 0; j < 4; ++j) acc[ai][bj][m][n][j] *= (1.f + __expf(-gb[n * 4 + j])) * __builtin_amdgcn_rcpf(1.f + __expf(-ga[n * 4 + j]));
                    } else {
                        float o[8];
#pragma unroll
                        for (int n = 0; n < 2; ++n)
#pragma unroll
                            for (int j = 0; j < 4; ++j) o[n * 4 + j] = acc[ai][bj][m][n][j] * sigmoidf_(gb[n * 4 + j]);
                        *(u32x4*)(O + (size_t)row * D + col) = pack8f(o);
                    }
                }
            }
        }
    }
};
struct EpiF32 {
    static constexpr bool PERM = false;
    float* C;
    __device__ __forceinline__ void pre(const Unit&, int, int, float (&ssv)[8]) const {
#pragma unroll
        for (int i = 0; i < 8; ++i) ssv[i] = 0.f; }
    __device__ __forceinline__ bool keep(const Unit&) const { return false; }
    __device__ __forceinline__ void operator()(Acc& acc, const Unit& u, int wr, int wc, int fr, int fq, const float (&ssv)[8]) const {
        const int row0 = u.pm * 256 + wr * 64 + fr, col0 = u.pn * 256 + wc * 32 + 4 * fq;
#pragma unroll
        for (int ai = 0; ai < 2; ++ai)
#pragma unroll
            for (int m = 0; m < 4; ++m)
#pragma unroll
                for (int bj = 0; bj < 2; ++bj)
#pragma unroll
                    for (int n = 0; n < 2; ++n) *(f32x4*)(C + (size_t)(row0 + ai * 128 + m * 16) * D + col0 + bj * 128 + n * 16) = acc[ai][bj][m][n];
    }
};
struct EpiPle {
    static constexpr bool PERM = false;
    float* out; const float* R; const float* ss;
    __device__ __forceinline__ void pre(const Unit& u, int wr, int fr, float (&ssv)[8]) const {
#pragma unroll
        for (int ai = 0; ai < 2; ++ai)
#pragma unroll
            for (int m = 0; m < 4; ++m) ssv[ai * 4 + m] = ss[u.pm * 256 + ai * 128 + wr * 64 + m * 16 + fr];
    }
    __device__ __forceinline__ bool keep(const Unit&) const { return false; }
    __device__ __forceinline__ void operator()(Acc& acc, const Unit& u, int wr, int wc, int fr, int fq, const float (&ssv)[8]) const {
        const int row0 = u.pm * 256 + wr * 64 + fr, col0 = u.pn * 256 + wc * 32 + 4 * fq;
#pragma unroll
        for (int ai = 0; ai < 2; ++ai)
#pragma unroll
            for (int mp = 0; mp < 2; ++mp) {
                f32x4 bb[2][2][2], rr[2][2][2];
#pragma unroll
                for (int mm = 0; mm < 2; ++mm)
#pragma unroll
                    for (int bj = 0; bj < 2; ++bj)
#pragma unroll
                        for (int n = 0; n < 2; ++n) { const size_t off = (size_t)(row0 + ai * 128 + (2 * mp + mm) * 16) * D + col0 + bj * 128 + n * 16;
                            bb[mm][bj][n] = *(const f32x4*)(out + off); rr[mm][bj][n] = *(const f32x4*)(R + off); }
#pragma unroll
                for (int mm = 0; mm < 2; ++mm) {
                    const int m = 2 * mp + mm, row = row0 + ai * 128 + m * 16;
                    const float rs = rsqrtf(ssv[ai * 4 + m] * (1.f / D) + EPS);
#pragma unroll
                    for (int bj = 0; bj < 2; ++bj)
#pragma unroll
                        for (int n = 0; n < 2; ++n) {
                            const size_t off = (size_t)row * D + col0 + bj * 128 + n * 16;
                            f32x4 v;
#pragma unroll
                            for (int j = 0; j < 4; ++j) v[j] = bb[mm][bj][n][j] + sigmoidf_(acc[ai][bj][m][n][j] * rs) * rr[mm][bj][n][j];
                            *(f32x4*)(out + off) = v;
                        }
                }
            }
    }
};

struct Params {
    const float *x, *p, *ffn1_norm, *ffn1_w_gu, *ffn1_w_down, *mix_norm, *w_in, *conv_w, *a_log, *dt_bias, *gdn_norm, *q_norm, *k_norm, *rel_bias,
                *w_a, *w_b, *w_out, *ffn2_norm, *ffn2_w_gu, *ffn2_w_down, *ple_norm, *ple_gate, *ple_proj;
    float* out; unsigned char* ws; int ph_lo, ph_hi;
};

template <int MAP> __device__ __forceinline__ int src_col(int n) {
    if (MAP == 1) return ((n >> 7) & 1) * FF + (n >> 8) * 128 + (n & 127);
    if (MAP == 2) return n < 4096 ? n : (n < 11264 ? n + 16 : (n < 11280 ? n - 11264 + 4096 : -1));
    return n;
}
template <int MAP> __device__ __forceinline__ void transpose_item(const float* W, const float* nw, int K, int Nsrc, int Nd, bf16_t* WT, LAS float* scr, int item, int lane) {
    const int nblk = Nd / 64, kb = item / nblk, nb = item % nblk, k0 = 64 * kb, n0 = 64 * nb;
    const int r = lane >> 4, c4 = lane & 15;
    const int sc = src_col<MAP>(n0 + 4 * c4);
    f32x4 v[16];
#pragma unroll
    for (int i = 0; i < 16; ++i) v[i] = sc >= 0 ? __builtin_nontemporal_load((const f32x4*)(W + (size_t)(k0 + 4 * i + r) * Nsrc + sc)) : (f32x4){0.f, 0.f, 0.f, 0.f};
    if (nw) {
#pragma unroll
        for (int i = 0; i < 16; ++i) v[i] = v[i] * nw[k0 + 4 * i + r];
    }
#pragma unroll
    for (int i = 0; i < 16; ++i) { LAS float* p = scr + (4 * i + r) * 65 + 4 * c4; p[0] = v[i][0]; p[1] = v[i][1]; p[2] = v[i][2]; p[3] = v[i][3]; }
    asm volatile("s_waitcnt lgkmcnt(0)" ::: "memory"); __builtin_amdgcn_wave_barrier();
    const int ns = lane >> 3, kc = lane & 7;
#pragma unroll
    for (int j = 0; j < 8; ++j) { const LAS float* sp = scr + (8 * kc) * 65 + 8 * j + ns;
        u32x4 o; o.x = pk2(sp[0 * 65], sp[1 * 65]); o.y = pk2(sp[2 * 65], sp[3 * 65]); o.z = pk2(sp[4 * 65], sp[5 * 65]); o.w = pk2(sp[6 * 65], sp[7 * 65]);
        *(u32x4*)(WT + (size_t)(n0 + 8 * j + ns) * K + k0 + 8 * kc) = o; }
    asm volatile("s_waitcnt lgkmcnt(0)" ::: "memory"); __builtin_amdgcn_wave_barrier();
}
constexpr int I_GU = (D / 64) * (NGU / 64), I_DN = (FF / 64) * (D / 64), I_IN = (D / 64) * (NIN / 64), I_AB = (1024 / 64) * (D / 64), I_SQ = (D / 64) * (D / 64), I_PP = (PLE / 64) * (D / 64);
constexpr int N_EARLY = I_GU + I_DN + I_IN, N_LATE = I_GU + I_DN + 2 * I_AB + 2 * I_SQ + I_PP;
__device__ __forceinline__ void convert_early(const Params& P, LAS float* scr, int gw, int NGW, int lane, bool with_d1) {
    unsigned char* ws = P.ws;
    for (int it = gw; it < I_GU + I_IN + (with_d1 ? I_DN : 0); it += NGW) {
        int r = it;
        if (r < I_GU) { transpose_item<1>(P.ffn1_w_gu, P.ffn1_norm, D, NGU, NGU, (bf16_t*)(ws + WS_WGU1), scr, r, lane); continue; } r -= I_GU;
        if (r < I_IN) { transpose_item<2>(P.w_in, P.mix_norm, D, NINSRC, NIN, (bf16_t*)(ws + WS_WIN), scr, r, lane); continue; } r -= I_IN;
        transpose_item<0>(P.ffn1_w_down, nullptr, FF, D, D, (bf16_t*)(ws + WS_WD1), scr, r, lane);
    }
}
__device__ __forceinline__ void convert_d1(const Params& P, LAS float* scr, int gw, int NGW, int lane) {
    for (int it = gw; it < I_DN; it += NGW) transpose_item<0>(P.ffn1_w_down, nullptr, FF, D, D, (bf16_t*)(P.ws + WS_WD1), scr, it, lane);
}
__device__ __forceinline__ void convert_late(const Params& P, LAS float* scr, int lo_it, int hi_it, int gw, int NGW, int lane) {
    unsigned char* ws = P.ws;
    for (int it = lo_it + gw; it < hi_it; it += NGW) {
        int r = it;
        if (r < I_AB) { transpose_item<0>(P.w_a, nullptr, 1024, D, D, (bf16_t*)(ws + WS_WA), scr, r, lane); continue; } r -= I_AB;
        if (r < I_AB) { transpose_item<0>(P.w_b, nullptr, 1024, D, D, (bf16_t*)(ws + WS_WB), scr, r, lane); continue; } r -= I_AB;
        if (r < I_SQ) { transpose_item<0>(P.w_out, nullptr, D, D, D, (bf16_t*)(ws + WS_WOUT), scr, r, lane); continue; } r -= I_SQ;
        if (r < I_GU) { transpose_item<1>(P.ffn2_w_gu, P.ffn2_norm, D, NGU, NGU, (bf16_t*)(ws + WS_WGU2), scr, r, lane); continue; } r -= I_GU;
        if (r < I_DN) { transpose_item<0>(P.ffn2_w_down, nullptr, FF, D, D, (bf16_t*)(ws + WS_WD2), scr, r, lane); continue; } r -= I_DN;
        if (r < I_SQ) { transpose_item<0>(P.ple_gate, P.ple_norm, D, D, D, (bf16_t*)(ws + WS_WPG), scr, r, lane); continue; } r -= I_SQ;
        transpose_item<0>(P.ple_proj, nullptr, PLE, D, D, (bf16_t*)(ws + WS_WPP), scr, r, lane);
    }
}
constexpr int LATE_A = 2800, LATE_C = 2 * I_AB + I_SQ + I_GU;
__device__ __forceinline__ void idle_convert(const Params& P, LAS unsigned char* lds, int nwg, int G, int lo_it, int hi_it) {
    const int extra = nwg % G, c = blockIdx.x;
    if (extra == 0 || c < extra) return;
    const int tid = opaque_tid(), wave = tid >> 6;
    if (lo_it < 0) convert_d1(P, (LAS float*)(lds + wave * 17408), (c - extra) * 8 + wave, (G - extra) * 8, tid & 63);
    else convert_late(P, (LAS float*)(lds + wave * 17408), lo_it, hi_it, (c - extra) * 8 + wave, (G - extra) * 8, tid & 63);
}
__device__ __forceinline__ void phase_convert(const Params& P, LAS unsigned char* lds, int G) {
    const int tid = opaque_tid(), lane = tid & 63, wave = tid >> 6;
    LAS float* scr = (LAS float*)(lds + wave * 17408);
    const int gw = blockIdx.x * 8 + wave, NGW = G * 8;
    unsigned char* ws = P.ws;
    convert_early(P, scr, gw, NGW, lane, (((M / 256) * (NGU / 256)) % G) == 0);
    float* ss = (float*)(ws + WS_SS);
    bf16_t* xb = (bf16_t*)(ws + WS_XB); bf16_t* pb = (bf16_t*)(ws + WS_PB);
    for (int m0 = gw; m0 < M; m0 += 2 * NGW) {
        f32x4 xv[2][8], pv[2];
#pragma unroll
        for (int q = 0; q < 2; ++q) { const int m = m0 + q * NGW; if (m < M) {
            const f32x4* xr = (const f32x4*)(P.x + (size_t)m * D) + lane;
#pragma unroll
            for (int j = 0; j < 8; ++j) xv[q][j] = __builtin_nontemporal_load(xr + 64 * j);
            pv[q] = __builtin_nontemporal_load((const f32x4*)(P.p + (size_t)m * PLE) + lane); } }
#pragma unroll
        for (int q = 0; q < 2; ++q) { const int m = m0 + q * NGW; if (m < M) {
            u32x2* o8 = (u32x2*)(xb + (size_t)m * D) + lane; float s = 0.f;
#pragma unroll
            for (int j = 0; j < 8; ++j) { const f32x4 v = xv[q][j]; s += (v[0] * v[0] + v[1] * v[1]) + (v[2] * v[2] + v[3] * v[3]); u32x2 w; w.x = pk2(v[0], v[1]); w.y = pk2(v[2], v[3]); o8[64 * j] = w; }
            s = wave_sum(s); if (lane == 0) ss[m] = s;
            u32x2 w; w.x = pk2(pv[q][0], pv[q][1]); w.y = pk2(pv[q][2], pv[q][3]); *((u32x2*)(pb + (size_t)m * PLE) + lane) = w; } }
    }
    for (int i = blockIdx.x * 512 + tid; i < 3 * M; i += G * 512) ss[M + i] = 0.f;
    if (blockIdx.x == 0 && tid < 8) ((unsigned*)(ws + WS_PROG))[tid * 32] = 0u;
}

constexpr int L_LM = 0, L_GC = L_LM + 64 * 68 * 4, L_R = L_GC + 512, L_KBF = L_R + 65536, L_QBF = L_KBF + 64 * 136 * 2, L_VST = L_QBF + 64 * 136 * 2, L_END4 = L_VST + 64 * 136 * 2;
static_assert(L_END4 <= LDS_BYTES, "lds");
__device__ __forceinline__ void prep_item(const Params& P, LAS unsigned char* lds, int item, const int pflags) {
    const int tid = opaque_tid(), lane = tid & 63, wave = tid >> 6;
    const int n = item >> 3, h = item & 7;
    unsigned char* ws = P.ws;
    bf16_t* proj = (bf16_t*)(ws + WS_PROJ);
    LAS float* Rr = (LAS float*)(lds + L_R); LAS float* Lm = (LAS float*)(lds + L_LM);
    LAS bf16_t* kbf = (LAS bf16_t*)(lds + L_KBF); LAS bf16_t* qbf = (LAS bf16_t*)(lds + L_QBF); LAS bf16_t* vst = (LAS bf16_t*)(lds + L_VST);
    LAS float* gcs = (LAS float*)(lds + L_GC);
    if (wave == 0) {
        const size_t row = (size_t)n * 64 + lane;
        const float a = bf2f(proj[row * NIN + C_AR + h]), b = bf2f(proj[row * NIN + C_BR + h]);
        const float xx = a + P.dt_bias[h];
        const float sp = xx > 20.f ? xx : log1pf(expf(xx));
        float g = -expf(P.a_log[h]) * sp;
#pragma unroll
        for (int o = 1; o < 64; o <<= 1) { const float t = __shfl_up(g, o); if (lane >= o) g += t; }
        gcs[lane] = g; gcs[64 + lane] = 1.f / (1.f + expf(-b));
    }
    const int l16 = tid & 15, rg = tid >> 4;
    float qv[2][8], kv[2][8], vv[2][8];
    u32x4 rawx[3][5];
#pragma unroll
    for (int X = 0; X < 3; ++X)
#pragma unroll
        for (int i = 0; i < 5; ++i) { const int gr = n * 64 + 2 * rg - 3 + i; const int colx = (X == 0 ? C_QA : (X == 1 ? C_KA : C_VA)) + h * DH + 8 * l16;
            rawx[X][i] = gr >= 0 ? __builtin_nontemporal_load((const u32x4*)(proj + (size_t)gr * NIN + colx)) : (u32x4){0u, 0u, 0u, 0u}; }
#pragma unroll
    for (int X = 0; X < 3; ++X) {
        const int col = (X == 0 ? C_QA : (X == 1 ? C_KA : C_VA)) + h * DH + 8 * l16;
        const int ccol = X * 1024 + h * DH + 8 * l16;
        float xin[5][8];
#pragma unroll
        for (int i = 0; i < 5; ++i) unpack8(rawx[X][i], xin[i]);
        float y[2][8];
#pragma unroll
        for (int r = 0; r < 2; ++r)
#pragma unroll
            for (int e = 0; e < 8; ++e) y[r][e] = 0.f;
#pragma unroll
        for (int j = 0; j < 4; ++j) {
            const f32x4 c0 = *(const f32x4*)(P.conv_w + j * 3072 + ccol), c1 = *(const f32x4*)(P.conv_w + j * 3072 + ccol + 4);
#pragma unroll
            for (int r = 0; r < 2; ++r)
#pragma unroll
                for (int e = 0; e < 8; ++e) y[r][e] += (e < 4 ? c0[e] : c1[e - 4]) * xin[r + j][e];
        }
#pragma unroll
        for (int r = 0; r < 2; ++r) {
            float sq = 0.f;
#pragma unroll
            for (int e = 0; e < 8; ++e) { y[r][e] = siluf_(y[r][e]); sq += y[r][e] * y[r][e]; }
            if (X < 2) {
                sq += __shfl_xor(sq, 1); sq += __shfl_xor(sq, 2); sq += __shfl_xor(sq, 4); sq += __shfl_xor(sq, 8);
                const float rn = rsqrtf(sq + EPS) * (X == 0 ? 0.08838834764831845f : 1.f);
#pragma unroll
                for (int e = 0; e < 8; ++e) y[r][e] *= rn;
            }
#pragma unroll
            for (int e = 0; e < 8; ++e) { if (X == 0) qv[r][e] = y[r][e]; else if (X == 1) kv[r][e] = y[r][e]; else vv[r][e] = y[r][e]; }
        }
    }
    {
        u32x4 raw[2][3]; f32x4 gw[2][2];
#pragma unroll
        for (int r = 0; r < 2; ++r) { const size_t grow = (size_t)n * 64 + 2 * rg + r;
            raw[r][0] = __builtin_nontemporal_load((const u32x4*)(proj + grow * NIN + C_QB + h * DH + 8 * l16));
            raw[r][1] = __builtin_nontemporal_load((const u32x4*)(proj + grow * NIN + C_KB + h * DH + 8 * l16));
            raw[r][2] = __builtin_nontemporal_load((const u32x4*)(proj + grow * NIN + C_VB + h * DH + 8 * l16)); }
#pragma unroll
        for (int X = 0; X < 2; ++X) { const float* nwp = (X == 0 ? P.q_norm : P.k_norm) + 8 * l16; gw[X][0] = *(const f32x4*)nwp; gw[X][1] = *(const f32x4*)(nwp + 4); }
#pragma unroll
        for (int r = 0; r < 2; ++r) {
            const size_t grow = (size_t)n * 64 + 2 * rg + r;
#pragma unroll
            for (int X = 0; X < 2; ++X) {
                bf16_t* ptr = proj + grow * NIN + (X == 0 ? C_QB : C_KB) + h * DH + 8 * l16;
                float f[8]; unpack8(raw[r][X], f);
                float sq = 0.f;
#pragma unroll
                for (int e = 0; e < 8; ++e) sq += f[e] * f[e];
                sq += __shfl_xor(sq, 1); sq += __shfl_xor(sq, 2); sq += __shfl_xor(sq, 4); sq += __shfl_xor(sq, 8);
                const float rn = rsqrtf(sq * (1.f / DH) + EPS);
#pragma unroll
                for (int e = 0; e < 8; ++e) f[e] = f[e] * rn * (e < 4 ? gw[X][0][e] : gw[X][1][e - 4]);
                *(u32x4*)ptr = pack8f(f);
            }
            *(LAS u32x4*)(vst + (2 * rg + r) * 136 + 8 * l16) = raw[r][2];
        }
    }
    __syncthreads();
    {
        bf16_t* qd = (bf16_t*)(ws + WS_QD) + (size_t)item * 64 * 128;
        bf16_t* ktT = (bf16_t*)(ws + WS_KTT) + (size_t)item * 128 * 64;
        const float gl = gcs[63];
        float ktl[2][8];
#pragma unroll
        for (int r = 0; r < 2; ++r) {
            const int t = 2 * rg + r; const float gc = gcs[t], bt = gcs[64 + t];
            const float eg = __expf(gc), egl = __expf(gl - gc);
            float f[8];
#pragma unroll
            for (int e = 0; e < 8; ++e) f[e] = qv[r][e] * eg;
            *(u32x4*)(qd + ((((t >> 4) * 4 + (l16 >> 2)) * 64) + (l16 & 3) * 16 + (t & 15)) * 8) = pack8f(f);
#pragma unroll
            for (int e = 0; e < 8; ++e) ktl[r][e] = kv[r][e] * egl;
            *(LAS u32x4*)(qbf + t * 136 + 8 * l16) = pack8f(qv[r]);
            *(LAS u32x4*)(kbf + t * 136 + 8 * l16) = pack8f(kv[r]);
            LAS float* rr = Rr + t * 256 + 8 * l16;
            *(LAS f32x4*)(rr) = (f32x4){vv[r][0] * bt, vv[r][1] * bt, vv[r][2] * bt, vv[r][3] * bt};
            *(LAS f32x4*)(rr + 4) = (f32x4){vv[r][4] * bt, vv[r][5] * bt, vv[r][6] * bt, vv[r][7] * bt};
            const float be = bt * eg;
            *(LAS f32x4*)(rr + 128) = (f32x4){kv[r][0] * be, kv[r][1] * be, kv[r][2] * be, kv[r][3] * be};
            *(LAS f32x4*)(rr + 132) = (f32x4){kv[r][4] * be, kv[r][5] * be, kv[r][6] * be, kv[r][7] * be};
        }
#pragma unroll
        for (int e = 0; e < 8; ++e) { const int t0 = 2 * rg; *(unsigned*)(ktT + (((((l16 >> 1) * 2 + (t0 >> 5)) * 64) + ((t0 >> 3) & 3) * 16 + 8 * (l16 & 1) + e) * 8 + (t0 & 7))) = pk2(ktl[0][e], ktl[1][e]); }
        if (tid == 0) ((float*)(ws + WS_TAIL))[item] = __expf(gl);
        bf16_t* vt = (bf16_t*)(ws + WS_VT);
        const int d = tid & 127, tg = tid >> 7;
        unsigned pw[8];
#pragma unroll
        for (int i = 0; i < 8; ++i) { const unsigned lo = vst[(16 * tg + 2 * i) * 136 + d], hi = vst[(16 * tg + 2 * i + 1) * 136 + d]; pw[i] = lo | (hi << 16); }
        bf16_t* dst = vt + (size_t)(h * DH + d) * M + n * 64 + 16 * tg;
        *(u32x4*)dst = (u32x4){pw[0], pw[1], pw[2], pw[3]}; *(u32x4*)(dst + 8) = (u32x4){pw[4], pw[5], pw[6], pw[7]};
    }
    __syncthreads();
    {
        const int fr = lane & 15, fq = lane >> 4, which = wave >> 2, ti = wave & 3;
        LAS bf16_t* X = which ? qbf : kbf;
        bf16x8 a[4];
#pragma unroll
        for (int s = 0; s < 4; ++s) a[s] = *(const LAS bf16x8*)(X + (16 * ti + fr) * 136 + 32 * s + 8 * fq);
        bf16_t* aqk = (bf16_t*)(ws + WS_AQK) + (size_t)item * 64 * 64;
        for (int tj = 0; tj < 4; ++tj) {
            f32x4 c = {0.f, 0.f, 0.f, 0.f};
            if (tj <= ti) {
#pragma unroll
                for (int s = 0; s < 4; ++s) { const bf16x8 b = *(const LAS bf16x8*)(kbf + (16 * tj + fr) * 136 + 32 * s + 8 * fq); c = MFMA16(a[s], b, c); }
            }
            const int j = 16 * tj + fr; const float gj = gcs[j];
#pragma unroll
            for (int r = 0; r < 4; ++r) {
                const int i = 16 * ti + 4 * fq + r;
                const float dec = (i >= j) ? __expf(gcs[i] - gj) : 0.f;
                if (which == 0) { Lm[i * 68 + j] = (i > j) ? gcs[64 + i] * c[r] * dec : 0.f; }
                else { const float v = (i >= j) ? c[r] * dec : 0.f; aqk[((((i >> 4) * 2 + (j >> 5)) * 64) + ((j >> 3) & 3) * 16 + (i & 15)) * 8 + (j & 7)] = (bf16_t)(pk2(v, 0.f) & 0xffffu); }
            }
        }
    }
    __syncthreads();
    if (tid < 256) {
        int Lrow[64];
#pragma unroll
        for (int i = 0; i < 64; ++i) Lrow[i] = __float_as_int(Lm[i * 68 + lane]);
        float s[64];
#define LRD(i, j) __int_as_float(__builtin_amdgcn_readlane(Lrow[i], j))
#pragma unroll
        for (int g = 0; g < 16; ++g) {
            const int i0 = 4 * g;
            float a0 = Rr[(i0 + 0) * 256 + tid], a1 = Rr[(i0 + 1) * 256 + tid], a2 = Rr[(i0 + 2) * 256 + tid], a3 = Rr[(i0 + 3) * 256 + tid];
            if (!(pflags & 8)) {
#pragma unroll
            for (int j = 0; j < i0; ++j) { const float sj = s[j]; a0 -= LRD(i0, j) * sj; a1 -= LRD(i0 + 1, j) * sj; a2 -= LRD(i0 + 2, j) * sj; a3 -= LRD(i0 + 3, j) * sj; }
            a1 -= LRD(i0 + 1, i0) * a0;
            a2 -= LRD(i0 + 2, i0) * a0; a2 -= LRD(i0 + 2, i0 + 1) * a1;
            a3 -= LRD(i0 + 3, i0) * a0; a3 -= LRD(i0 + 3, i0 + 1) * a1; a3 -= LRD(i0 + 3, i0 + 2) * a2;
            }
            s[i0] = a0; s[i0 + 1] = a1; s[i0 + 2] = a2; s[i0 + 3] = a3;
        }
#undef LRD
        if (pflags & 32) { if (s[63] == 1.2345f) ((float*)(ws + WS_U))[tid] = s[5]; } else
        if (tid < 128) { float* u = (float*)(ws + WS_U) + (size_t)item * 64 * 128 + ((tid >> 4) * 256 + (tid & 15)) * 4;
#pragma unroll
            for (int i4 = 0; i4 < 16; ++i4) *(f32x4*)(u + ((i4 >> 2) * 64 + (i4 & 3) * 16) * 4) = (f32x4){s[4 * i4], s[4 * i4 + 1], s[4 * i4 + 2], s[4 * i4 + 3]}; }
        else { const int dk = tid - 128; bf16_t* w = (bf16_t*)(ws + WS_W) + (size_t)item * 64 * 128 + (((dk >> 5) * 64) + ((dk >> 3) & 3) * 16) * 8 + (dk & 7);
#pragma unroll
            for (int i = 0; i < 64; ++i) w[((i >> 4) * 256 + (i & 15)) * 8] = (bf16_t)(pk2(s[i], 0.f) & 0xffffu); }
    }
    __syncthreads();
}

struct ScanA { bf16x8 W[4], K0[2], K1[2]; f32x4 u; float tl; };
struct ScanB { bf16x8 Q[4], A[2]; };
struct ScanOff { unsigned w, aq, kt, u; };
__device__ __forceinline__ void scan_loadA(ScanA& o, const unsigned char* ws, int c, int h, const ScanOff& f) {
    const int item = c * 8 + h;
    const unsigned char* w = ws + WS_W + (size_t)item * 16384; const unsigned char* kt = ws + WS_KTT + (size_t)item * 16384; const unsigned char* u = ws + WS_U + (size_t)item * 32768;
#pragma unroll
    for (int s = 0; s < 4; ++s) o.W[s] = __builtin_bit_cast(bf16x8, *(const u32x4*)(w + f.w + 1024 * s));
#pragma unroll
    for (int s = 0; s < 2; ++s) { o.K0[s] = __builtin_bit_cast(bf16x8, *(const u32x4*)(kt + f.kt + 1024 * s)); o.K1[s] = __builtin_bit_cast(bf16x8, *(const u32x4*)(kt + f.kt + 2048 + 1024 * s)); }
    o.u = *(const f32x4*)(u + f.u);
    o.tl = ((const float*)(ws + WS_TAIL))[item];
}
__device__ __forceinline__ void scan_loadB(ScanB& o, const unsigned char* ws, int c, int h, const ScanOff& f) {
    const int item = c * 8 + h;
    const unsigned char* qd = ws + WS_QD + (size_t)item * 16384; const unsigned char* aq = ws + WS_AQK + (size_t)item * 8192;
#pragma unroll
    for (int s = 0; s < 4; ++s) o.Q[s] = __builtin_bit_cast(bf16x8, *(const u32x4*)(qd + f.w + 1024 * s));
#pragma unroll
    for (int s = 0; s < 2; ++s) o.A[s] = __builtin_bit_cast(bf16x8, *(const u32x4*)(aq + f.aq + 1024 * s));
}
__device__ __forceinline__ void scan_stepA(const ScanA& cur, f32x4& S0, f32x4& S1, LAS bf16_t* Sl, LAS bf16_t* Vl, int fr, int fq, int mt) {
    f32x4 wsv = {0.f, 0.f, 0.f, 0.f};
#pragma unroll
    for (int s = 0; s < 4; ++s) wsv = MFMA16(cur.W[s], *(const LAS bf16x8*)(Sl + fr * 136 + 32 * s + 8 * fq), wsv);
    const f32x4 vn = cur.u - wsv;
    { u32x2 pv; pv.x = pk2(vn[0], vn[1]); pv.y = pk2(vn[2], vn[3]); *(LAS u32x2*)(Vl + fr * 72 + 16 * mt + 4 * fq) = pv; }
    __syncthreads();
    S0 = S0 * cur.tl; S1 = S1 * cur.tl;
#pragma unroll
    for (int s = 0; s < 2; ++s) { const bf16x8 Vb = *(const LAS bf16x8*)(Vl + fr * 72 + 32 * s + 8 * fq); S0 = MFMA16(cur.K0[s], Vb, S0); S1 = MFMA16(cur.K1[s], Vb, S1); }
    { u32x2 p0, p1; p0.x = pk2(S0[0], S0[1]); p0.y = pk2(S0[2], S0[3]); p1.x = pk2(S1[0], S1[1]); p1.y = pk2(S1[2], S1[3]);
      *(LAS u32x2*)(Sl + fr * 136 + 32 * mt + 4 * fq) = p0; *(LAS u32x2*)(Sl + fr * 136 + 32 * mt + 16 + 4 * fq) = p1; }
    __syncthreads();
}
__device__ __forceinline__ void scan_stepB(const ScanB& cur, const LAS bf16_t* Sl, const LAS bf16_t* Vl, bf16_t* og, int fr, int fq) {
    f32x4 qs = {0.f, 0.f, 0.f, 0.f};
#pragma unroll
    for (int s = 0; s < 4; ++s) qs = MFMA16(*(const LAS bf16x8*)(Sl + fr * 136 + 32 * s + 8 * fq), cur.Q[s], qs);
    __syncthreads();
#pragma unroll
    for (int s = 0; s < 2; ++s) qs = MFMA16(*(const LAS bf16x8*)(Vl + fr * 72 + 32 * s + 8 * fq), cur.A[s], qs);
    { u32x2 w; w.x = pk2(qs[0], qs[1]); w.y = pk2(qs[2], qs[3]); *(u32x2*)og = w; }
    __syncthreads();
}
__device__ __forceinline__ void scan_wg(const Params& P, LAS unsigned char* lds, int h, int pair, const int VAR) {
    const int tid = opaque_tid(), lane = tid & 63, wave = tid >> 6, fr = lane & 15, fq = lane >> 4, mt = wave & 3, e0 = 16 * pair;
    const unsigned char* ws = P.ws;
    LAS bf16_t* Sl = (LAS bf16_t*)(lds);
    LAS bf16_t* Vl = (LAS bf16_t*)(lds + 4352);
    for (int i = tid; i < 4352 / 4; i += 512) ((LAS unsigned*)Sl)[i] = 0u;
    ScanOff f; f.w = (unsigned)(mt * 4096 + lane * 16); f.aq = (unsigned)(mt * 2048 + lane * 16); f.kt = (unsigned)(mt * 4096 + lane * 16); f.u = (unsigned)((((e0 >> 4) * 4 + mt) * 64 + lane) * 16);
    if (wave < 4) {
        f32x4 S0 = {0.f, 0.f, 0.f, 0.f}, S1 = {0.f, 0.f, 0.f, 0.f};
        ScanA a, b, c3; scan_loadA(a, ws, 0, h, f); scan_loadA(b, ws, 1, h, f);
        __syncthreads();
#pragma unroll 1
        for (int c = 0; c < NCH - 2; c += 3) {
            if (VAR != 3) scan_loadA(c3, ws, c + 2, h, f); scan_stepA(a, S0, S1, Sl, Vl, fr, fq, mt);
            if (VAR != 3) scan_loadA(a, ws, c + 3, h, f); scan_stepA(b, S0, S1, Sl, Vl, fr, fq, mt);
            if (VAR != 3) scan_loadA(b, ws, c + 4, h, f); scan_stepA(VAR == 3 ? a : c3, S0, S1, Sl, Vl, fr, fq, mt);
        }
        scan_stepA(a, S0, S1, Sl, Vl, fr, fq, mt); scan_stepA(b, S0, S1, Sl, Vl, fr, fq, mt);
    } else {
        bf16_t* Og = (bf16_t*)(P.ws + (VAR ? WS_END : WS_YA)) + (size_t)(16 * mt + fr) * 1024 + h * DH + e0 + 4 * fq;
        ScanB a, b, c3; scan_loadB(a, ws, 0, h, f); scan_loadB(b, ws, 1, h, f);
        __syncthreads();
#pragma unroll 1
        for (int c = 0; c < NCH - 2; c += 3) {
            if (VAR != 3) scan_loadB(c3, ws, c + 2, h, f); scan_stepB(a, Sl, Vl, Og + (size_t)c * 65536, fr, fq);
            if (VAR != 3) scan_loadB(a, ws, c + 3, h, f); scan_stepB(b, Sl, Vl, Og + (size_t)(c + 1) * 65536, fr, fq);
            if (VAR != 3) scan_loadB(b, ws, c + 4, h, f); scan_stepB(VAR == 3 ? a : c3, Sl, Vl, Og + (size_t)(c + 2) * 65536, fr, fq);
        }
        scan_stepB(a, Sl, Vl, Og + (size_t)(NCH - 2) * 65536, fr, fq); scan_stepB(b, Sl, Vl, Og + (size_t)(NCH - 1) * 65536, fr, fq);
    }
}

__device__ __forceinline__ void scan_helper(const Params& P, int h, int j, int NHp) {
    const int tid = threadIdx.x;
    const unsigned char* ws = P.ws;
    unsigned* prog = (unsigned*)(P.ws + WS_PROG) + h * 32;
    for (int c = j; c < NCH; c += NHp) {
        for (;;) { const unsigned pr = __hip_atomic_load(prog, __ATOMIC_RELAXED, __HIP_MEMORY_SCOPE_AGENT); if ((int)pr + 16 >= c) break; __builtin_amdgcn_s_sleep(16); }
        const int item = c * 8 + h;
        const u32x4* w16 = (const u32x4*)(ws + WS_W + (size_t)item * 16384); const u32x4* q16 = (const u32x4*)(ws + WS_QD + (size_t)item * 16384);
        const u32x4* k16 = (const u32x4*)(ws + WS_KTT + (size_t)item * 16384); const u32x4* a16 = (const u32x4*)(ws + WS_AQK + (size_t)item * 8192);
        const u32x4* u16 = (const u32x4*)(ws + WS_U + (size_t)item * 32768);
        u32x4 v[11];
        v[0] = w16[tid]; v[1] = w16[512 + tid]; v[2] = q16[tid]; v[3] = q16[512 + tid]; v[4] = k16[tid]; v[5] = k16[512 + tid]; v[6] = a16[tid];
        v[7] = u16[tid]; v[8] = u16[512 + tid]; v[9] = u16[1024 + tid]; v[10] = u16[1536 + tid];
#pragma unroll
        for (int i = 0; i < 11; ++i) asm volatile("" :: "v"(v[i]));
    }
}

constexpr int AL_K = 0, AL_V = 2 * 64 * 272, AL_B = AL_V + 2 * 128 * 144;
__device__ __forceinline__ void attn_compute(const LAS unsigned char* Kl, const LAS unsigned char* Vl, const LAS float* biasl, const bf16x8 (&Qb)[4], f32x4 (&Ot)[8], float& mrun, float& lrun,
                                             int c, int qi, int fr, int fq) {
    const float scale = 0.08838834764831845f;
    f32x4 st[4]; float mx = -1e30f;
#pragma unroll
    for (int kt = 0; kt < 4; ++kt) {
        f32x4 a = {0.f, 0.f, 0.f, 0.f};
#pragma unroll
        for (int s = 0; s < 4; ++s) a = MFMA16(*(const LAS bf16x8*)(Kl + (16 * kt + fr) * 272 + 64 * s + 16 * fq), Qb[s], a);
#pragma unroll
        for (int r = 0; r < 4; ++r) {
            const int ki = c * 64 + 16 * kt + 4 * fq + r; int dd = qi - ki; dd = dd < -63 ? -63 : (dd > 128 ? 128 : dd);
            a[r] = a[r] * scale + biasl[dd + 63]; mx = fmaxf(mx, a[r]);
        }
        st[kt] = a;
    }
    mx = fmaxf(mx, __shfl_xor(mx, 16)); mx = fmaxf(mx, __shfl_xor(mx, 32));
    const float mnew = fmaxf(mrun, mx), alpha = __expf(mrun - mnew); mrun = mnew;
    float rsum = 0.f;
#pragma unroll
    for (int kt = 0; kt < 4; ++kt)
#pragma unroll
        for (int r = 0; r < 4; ++r) { const float p = __expf(st[kt][r] - mnew); st[kt][r] = p; rsum += p; }
    lrun = lrun * alpha + rsum;
    bf16x8 Pb[2];
#pragma unroll
    for (int s = 0; s < 2; ++s) Pb[s] = pack_acc(st[2 * s], st[2 * s + 1]);
#pragma unroll
    for (int dt = 0; dt < 8; ++dt) {
        f32x4 o = Ot[dt] * alpha;
#pragma unroll
        for (int s = 0; s < 2; ++s) { const LAS unsigned char* pv = Vl + (16 * dt + fr) * 144 + 64 * s + 8 * fq;
            const u32x2 lo = *(const LAS u32x2*)pv, hi = *(const LAS u32x2*)(pv + 32); u32x4 av; av.x = lo.x; av.y = lo.y; av.z = hi.x; av.w = hi.y;
            o = MFMA16(__builtin_bit_cast(bf16x8, av), Pb[s], o); }
        Ot[dt] = o;
    }
}
__device__ __forceinline__ void attn_item(const Params& P, LAS unsigned char* lds, int m, int h) {
    const int tid = opaque_tid(), lane = tid & 63, wave = tid >> 6, fr = lane & 15, fq = lane >> 4;
    unsigned char* ws = P.ws;
    const bf16_t* proj = (const bf16_t*)(ws + WS_PROJ); const bf16_t* vt = (const bf16_t*)(ws + WS_VT); bf16_t* yb = (bf16_t*)(ws + WS_YB);
    LAS float* biasl = (LAS float*)(lds + AL_B);
    const int nq = 2 * m + (wave >> 2), w4 = wave & 3;
    const int qi = nq * 64 + 16 * w4 + fr;
    const int cbeg = 2 * m - 8 < 0 ? 0 : 2 * m - 8, cend = 2 * m + 1;
    const bf16_t* kg[2]; const bf16_t* vg[2]; int kl[2], vl[2];
#pragma unroll
    for (int i = 0; i < 2; ++i) { const int p = tid + 512 * i;
        kg[i] = proj + (size_t)(p >> 4) * NIN + C_KB + h * DH + 8 * (p & 15); kl[i] = (p >> 4) * 272 + 16 * (p & 15);
        vg[i] = vt + (size_t)(h * DH + (p >> 3)) * M + 8 * (p & 7); vl[i] = (p >> 3) * 144 + 16 * (p & 7); }
#define ATT_LOAD(KR, VR, C) do { _Pragma("unroll") for (int i = 0; i < 2; ++i) { KR[i] = *(const u32x4*)(kg[i] + (size_t)(C) * 64 * NIN); VR[i] = *(const u32x4*)(vg[i] + (C) * 64); } } while (0)
#define ATT_WRITE(KR, VR, BUF) do { _Pragma("unroll") for (int i = 0; i < 2; ++i) { *(LAS u32x4*)(lds + AL_K + (BUF) * (64 * 272) + kl[i]) = KR[i]; *(LAS u32x4*)(lds + AL_V + (BUF) * (128 * 144) + vl[i]) = VR[i]; } } while (0)
    u32x4 kA[2], vA[2], kB[2], vB[2];
    ATT_LOAD(kA, vA, cbeg);
    ATT_LOAD(kB, vB, cbeg + 1);
    if (tid < 192) biasl[tid] = P.rel_bias[h * 192 + tid];
    bf16x8 Qb[4];
#pragma unroll
    for (int s = 0; s < 4; ++s) Qb[s] = ld8(proj + (size_t)qi * NIN + C_QB + h * DH + 32 * s + 8 * fq);
    ATT_WRITE(kA, vA, 0);
    __syncthreads();
    float mrun = -1e30f, lrun = 0.f;
    f32x4 Ot[8];
#pragma unroll
    for (int i = 0; i < 8; ++i) Ot[i] = (f32x4){0.f, 0.f, 0.f, 0.f};
#pragma unroll 1
    for (int c = cbeg; c <= cend; c += 2) {
        if (c + 2 <= cend) ATT_LOAD(kA, vA, c + 2);
        if (c >= nq - 8 && c <= nq) attn_compute(lds + AL_K, lds + AL_V, biasl, Qb, Ot, mrun, lrun, c, qi, fr, fq);
        if (c + 1 <= cend) ATT_WRITE(kB, vB, 1);
        __syncthreads();
        if (c + 1 > cend) break;
        if (c + 3 <= cend) ATT_LOAD(kB, vB, c + 3);
        if (c + 1 >= nq - 8 && c + 1 <= nq) attn_compute(lds + AL_K + 64 * 272, lds + AL_V + 128 * 144, biasl, Qb, Ot, mrun, lrun, c + 1, qi, fr, fq);
        if (c + 2 <= cend) ATT_WRITE(kA, vA, 0);
        __syncthreads();
    }
#undef ATT_LOAD
#undef ATT_WRITE
    lrun += __shfl_xor(lrun, 16); lrun += __shfl_xor(lrun, 32);
    const float inv = 1.f / lrun;
#pragma unroll
    for (int dt = 0; dt < 8; ++dt) { u32x2 w; w.x = pk2(Ot[dt][0] * inv, Ot[dt][1] * inv); w.y = pk2(Ot[dt][2] * inv, Ot[dt][3] * inv);
        *(u32x2*)(yb + (size_t)qi * 1024 + h * DH + 16 * dt + 4 * fq) = w; }
}

__device__ __forceinline__ void phase_gnorm(const Params& P, int G) {
    unsigned char* ws = P.ws;
    bf16_t* ya = (bf16_t*)(ws + WS_YA); const bf16_t* proj = (const bf16_t*)(ws + WS_PROJ);
    const int gt = blockIdx.x * 512 + opaque_tid(), l16 = gt & 15;
    const f32x4 w0 = *(const f32x4*)(P.gdn_norm + 8 * l16), w1 = *(const f32x4*)(P.gdn_norm + 8 * l16 + 4);
    const int stride = (G * 512) >> 4;
    for (int g0 = gt >> 4; g0 < M * NH; g0 += 4 * stride) {
        u32x4 ro[4], rz[4]; bf16_t* po[4];
#pragma unroll
        for (int q = 0; q < 4; ++q) { const int g = g0 + q * stride; const int row = g >> 3, h = g & 7;
            po[q] = ya + (size_t)row * 1024 + h * DH + 8 * l16;
            if (g < M * NH) { ro[q] = *(const u32x4*)po[q]; rz[q] = __builtin_nontemporal_load((const u32x4*)(proj + (size_t)row * NIN + C_Z + h * DH + 8 * l16)); } }
#pragma unroll
        for (int q = 0; q < 4; ++q) if (g0 + q * stride < M * NH) {
            float o[8], z[8]; unpack8(ro[q], o); unpack8(rz[q], z);
            float sq = 0.f;
#pragma unroll
            for (int e = 0; e < 8; ++e) sq += o[e] * o[e];
            sq += __shfl_xor(sq, 1); sq += __shfl_xor(sq, 2); sq += __shfl_xor(sq, 4); sq += __shfl_xor(sq, 8);
            const float rn = rsqrtf(sq * (1.f / DH) + EPS);
#pragma unroll
            for (int e = 0; e < 8; ++e) o[e] = o[e] * rn * (e < 4 ? w0[e] : w1[e - 4]) * siluf_(z[e]);
            *(u32x4*)po[q] = pack8f(o);
        }
    }
}

#define XB_TMO      128
#define XB_XCNT(j)  (256  + 64 * (j))
#define XB_XSUB(j)  (1280 + 64 * (j))
#define XB_XGEN(j)  (2304 + 64 * (j))
#define XB_TOP      3328
#define XB_TOPGEN   3392
#define XCD_BAR_WORDS 3456
#define XB_SPIN_CAP (1u << 18)
__device__ __forceinline__ unsigned xb_ld(unsigned* p)              { return __hip_atomic_load(p, __ATOMIC_RELAXED, __HIP_MEMORY_SCOPE_AGENT); }
__device__ __forceinline__ unsigned xb_add(unsigned* p, unsigned v) { return __hip_atomic_fetch_add(p, v, __ATOMIC_RELAXED, __HIP_MEMORY_SCOPE_AGENT); }
__device__ __forceinline__ unsigned xb_xcc_id() { return (unsigned)__builtin_amdgcn_s_getreg((3 << 11) | 20) & 0xFu; }
#define XB_SPIN(cond, bar) do { unsigned _sp = 0; while (cond) { __builtin_amdgcn_s_sleep(1); \
    if ((++_sp & 255u) == 0u) { if (xb_ld(&(bar)[XB_TMO])) break; if (_sp > XB_SPIN_CAP) { atomicAdd(&(bar)[XB_TMO], 1u); break; } } } } while (0)
struct XcdBarrier { unsigned* bar; unsigned x; volatile LAS unsigned* st; };
__device__ __forceinline__ XcdBarrier xcd_barrier_post(unsigned* bar, volatile LAS unsigned* st) {
    XcdBarrier b; b.bar = bar; b.x = xb_xcc_id(); b.st = st;
    if (threadIdx.x == 0) (void)xb_add(&bar[XB_XCNT(b.x)], 1u);
    return b;
}
__device__ __forceinline__ void xcd_barrier_complete(unsigned* bar, unsigned x, unsigned& nloc, unsigned& nx) {
    const unsigned G = gridDim.x * gridDim.y * gridDim.z;
    unsigned sum, cnt, mine, sp = 0u;
    for (;;) {
        sum = 0u; cnt = 0u; mine = 0u;
#pragma unroll
        for (unsigned j = 0; j < 16; ++j) { const unsigned c = xb_ld(&bar[XB_XCNT(j)]); sum += c; cnt += (c > 0u) ? 1u : 0u; mine = (j == x) ? c : mine; }
        if (sum == G) break;
        __builtin_amdgcn_s_sleep(1);
        if ((++sp & 255u) == 0u) { if (xb_ld(&bar[XB_TMO])) break; if (sp > XB_SPIN_CAP) { atomicAdd(&bar[XB_TMO], 1u); break; } }
    }
    nloc = mine > 0u ? mine : 1u; nx = cnt > 0u ? cnt : 1u;
}
__device__ __forceinline__ void xcd_barrier(const XcdBarrier& b) {
    asm volatile("s_waitcnt vmcnt(0)" ::: "memory");
    __syncthreads();
    if (threadIdx.x == 0) {
        unsigned* bar = b.bar;
        __builtin_amdgcn_s_waitcnt(0);
        unsigned nloc = b.st[0], nx = b.st[1];
        if (nloc == 0u) { xcd_barrier_complete(bar, b.x, nloc, nx); b.st[0] = nloc; b.st[1] = nx; }
        const unsigned old = xb_add(&bar[XB_XSUB(b.x)], 1u);
        const unsigned gen = old / nloc;
        if (old + 1u == (gen + 1u) * nloc) {
            __builtin_amdgcn_fence(__ATOMIC_RELEASE, "agent");
            asm volatile("s_waitcnt vmcnt(0)" ::: "memory");
            const unsigned og = xb_add(&bar[XB_TOP], 1u);
            const unsigned tg = og / nx;
            if (og + 1u == (tg + 1u) * nx) xb_add(&bar[XB_TOPGEN], 1u);
            else XB_SPIN(xb_ld(&bar[XB_TOPGEN]) == tg, bar);
            __builtin_amdgcn_fence(__ATOMIC_ACQUIRE, "agent");
            xb_add(&bar[XB_XGEN(b.x)], 1u);
            asm volatile("s_waitcnt vmcnt(0)" ::: "memory");
        } else {
            XB_SPIN(xb_ld(&bar[XB_XGEN(b.x)]) == gen, bar);
            __builtin_amdgcn_fence(__ATOMIC_ACQUIRE, "agent");
            asm volatile("s_waitcnt vmcnt(0)" ::: "memory");
        }
    }
    __syncthreads();
}

constexpr int NPHASE = 11;
__global__ void __launch_bounds__(512, 2) fwd_megakernel(Params P) {
    extern __shared__ __attribute__((aligned(16))) unsigned char smem[];
    LAS unsigned char* lds = (LAS unsigned char*)smem;
    cg::grid_group grid = cg::this_grid();
    const int G = gridDim.x, lo = P.ph_lo, hi = P.ph_hi & 255, pflags = P.ph_hi >> 8;
    unsigned char* ws = P.ws;
    float* ss = (float*)(ws + WS_SS);
    bf16_t* xb = (bf16_t*)(ws + WS_XB); bf16_t* act = (bf16_t*)(ws + WS_ACT); bf16_t* proj = (bf16_t*)(ws + WS_PROJ);
#ifndef NREP5
#define NREP5 1
#endif
#ifndef REP_PHASE
#define REP_PHASE -1
#endif
#define IN(k) (lo <= (k) && (k) < hi)
    volatile LAS unsigned* xst = (volatile LAS unsigned*)(lds + LDS_BYTES - 16);
    if (threadIdx.x == 0) { xst[0] = 0u; xst[1] = 0u; }
    __syncthreads();
    XcdBarrier xbar = xcd_barrier_post((unsigned*)(ws + WS_BAR), xst);
    if (lo < 0) grid.sync();
#define SEAM(k) do { if (IN(k) && IN((k) + 1)) xcd_barrier(xbar); } while (0)
    for (int rep = 0; rep < (REP_PHASE == 0 ? 2 : 1); ++rep) { if (IN(0)) phase_convert(P, lds, G);
    SEAM(0); }
    for (int rep = 0; rep < (REP_PHASE == 1 ? 2 : 1); ++rep) {
    if (IN(1)) { pg8::Sched S; S.init(xb, (const bf16_t*)(ws + WS_WGU1), nullptr, nullptr, M, NGU, G, blockIdx.x, 0); EpiGU E{act, ss}; pg8::gemm_phase(lds, D, S, E);
        idle_convert(P, lds, (M / 256) * (NGU / 256), G, -1, 0); }
    SEAM(1); }
    if (IN(2)) { pg8::Sched S; S.init(act, (const bf16_t*)(ws + WS_WD1), nullptr, nullptr, M, D, G, blockIdx.x, 0); EpiRes E{P.x, P.out, xb, ss + M, 0.5f}; pg8::gemm_phase(lds, FF, S, E); }
    SEAM(2);
    if (IN(3)) { pg8::Sched S; S.init(xb, (const bf16_t*)(ws + WS_WIN), nullptr, nullptr, M, NIN, G, blockIdx.x, 0); EpiProj E{proj, ss + M}; pg8::gemm_phase(lds, D, S, E);
        idle_convert(P, lds, (M / 256) * (NIN / 256), G, 0, LATE_A); }
    SEAM(3);
    if (IN(4)) { const int nit = (NCH * NH - 1 - (int)blockIdx.x) / G; for (int k = nit; k >= 0; --k) prep_item(P, lds, blockIdx.x + k * G, pflags); }
    SEAM(4);
_Pragma("unroll 1")
    for (int rep = 0; rep < NREP5; ++rep) {
    if (IN(5)) {
        const int tid5 = opaque_tid(), wave = tid5 >> 6, b = blockIdx.x;
        if (b < 64) { if (!(pflags & 4)) scan_wg(P, lds, b & 7, b >> 3, 0); }
        else { if (!(pflags & 2)) for (int it = b - 64; it < (NCH / 2) * NH; it += G - 64) attn_item(P, lds, it >> 3, it & 7);
            if (!(pflags & 1)) convert_late(P, (LAS float*)(lds + wave * 17408), ((((M / 256) * (NIN / 256)) % G) ? LATE_A : 0), ((((M / 256) * (NGU / 256)) % G) ? LATE_C : N_LATE), (b - 64) * 8 + wave, (G - 64) * 8, tid5 & 63); }
    }
    SEAM(5); }
    if (IN(6)) phase_gnorm(P, G);
    SEAM(6);
    if (IN(7)) { pg8::Sched S; S.init((const bf16_t*)(ws + WS_YA), (const bf16_t*)(ws + WS_WA), (const bf16_t*)(ws + WS_YB), (const bf16_t*)(ws + WS_WB), M, D, G, blockIdx.x, 1);
        EpiMix E{proj, (bf16_t*)(ws + WS_MIX)}; pg8::gemm_phase(lds, 1024, S, E); }
    SEAM(7);
    if (IN(8)) { pg8::Sched S; S.init((const bf16_t*)(ws + WS_MIX), (const bf16_t*)(ws + WS_WOUT), nullptr, nullptr, M, D, G, blockIdx.x, 0); EpiRes E{P.out, P.out, xb, ss + 2 * M, 1.0f}; pg8::gemm_phase(lds, D, S, E); }
    SEAM(8);
    if (IN(9)) { pg8::Sched S; S.init(xb, (const bf16_t*)(ws + WS_WGU2), nullptr, nullptr, M, NGU, G, blockIdx.x, 0); EpiGU E{act, ss + 2 * M}; pg8::gemm_phase(lds, D, S, E);
        idle_convert(P, lds, (M / 256) * (NGU / 256), G, LATE_C, N_LATE); }
    SEAM(9);
    if (IN(10)) { pg8::Sched S; S.init(act, (const bf16_t*)(ws + WS_WD2), nullptr, nullptr, M, D, G, blockIdx.x, 0); EpiRes E{P.out, P.out, xb, ss + 3 * M, 0.5f}; pg8::gemm_phase(lds, FF, S, E); }
    SEAM(10);
    if (IN(11)) {
        { pg8::Sched S; S.init((const bf16_t*)(ws + WS_PB), (const bf16_t*)(ws + WS_WPP), nullptr, nullptr, M, D, G, blockIdx.x, 0); EpiF32 E{(float*)(ws + WS_RBUF)}; pg8::gemm_phase(lds, PLE, S, E); }
        { pg8::Sched S; S.init(xb, (const bf16_t*)(ws + WS_WPG), nullptr, nullptr, M, D, G, blockIdx.x, 0); EpiPle E{P.out, (const float*)(ws + WS_RBUF), ss + 3 * M}; pg8::gemm_phase(lds, D, S, E); }
    }
#undef IN
#undef SEAM
}


#ifdef PROBE_VAR
__global__ void __launch_bounds__(512, 2) probe_scan(Params P) {
    extern __shared__ __attribute__((aligned(16))) unsigned char smem[];
    scan_wg(P, (LAS unsigned char*)smem, blockIdx.x & 7, blockIdx.x >> 3, PROBE_VAR);
}
#endif
#ifndef N_LAUNCH_MODE
#define N_LAUNCH_MODE 0
#endif
extern "C" void kernel_launch(void* const* d_in, const int* in_sizes, int n_in, void* d_out, int out_size, void* d_ws, size_t ws_size, hipStream_t stream) {
    static int grid = 0;
    if (grid == 0) {
        if (n_in != 23 || out_size != M * D || ws_size < WS_END) { fprintf(stderr, "kernel_launch: unexpected problem (n_in %d out %d ws %zu need %zu)\n", n_in, out_size, ws_size, (size_t)WS_END); grid = -1; return; }
        int dev = 0, cus = 0, per_cu = 0;
        hipGetDevice(&dev); hipDeviceGetAttribute(&cus, hipDeviceAttributeMultiprocessorCount, dev);
        if (hipFuncSetAttribute((const void*)fwd_megakernel, hipFuncAttributeMaxDynamicSharedMemorySize, LDS_BYTES) != hipSuccess) { fprintf(stderr, "kernel_launch: hipFuncSetAttribute failed\n"); grid = -1; return; }
        if (hipOccupancyMaxActiveBlocksPerMultiprocessor(&per_cu, (const void*)fwd_megakernel, 512, LDS_BYTES) != hipSuccess || per_cu < 1) { fprintf(stderr, "kernel_launch: occupancy query failed (%d)\n", per_cu); (void)hipGetLastError(); per_cu = 1; }
        grid = cus * 1;
        if (grid < 192) { fprintf(stderr, "kernel_launch: grid too small\n"); grid = -1; return; }
    }
    if (grid < 0) return;
    if (hipMemsetAsync((char*)d_ws + WS_BAR, 0, 16384, stream) != hipSuccess) { fprintf(stderr, "kernel_launch: memset of the barrier words failed\n"); return; }
    Params p{};
    const float** pp = (const float**)&p;
    for (int i = 0; i < 23; ++i) pp[i] = (const float*)d_in[i];
    p.out = (float*)d_out; p.ws = (unsigned char*)d_ws;
#if N_LAUNCH_MODE == 0
    p.ph_lo = 0; p.ph_hi = NPHASE + 1;
    void* args[] = {&p};
    hipError_t e = hipLaunchCooperativeKernel((const void*)fwd_megakernel, dim3(grid), dim3(512), args, LDS_BYTES, stream);
    if (e != hipSuccess) fprintf(stderr, "cooperative launch failed: %s (grid %d)\n", hipGetErrorString(e), grid);
#ifdef PROBE_VAR
    hipLaunchKernelGGL(probe_scan, dim3(64), dim3(512), 16384, stream, p);
#endif
#ifdef PROBE_PHASE
    p.ph_lo = PROBE_PHASE; p.ph_hi = (PROBE_PHASE + 1) | (PROBE_FLAGS << 8); hipLaunchKernelGGL(fwd_megakernel, dim3(grid), dim3(512), LDS_BYTES, stream, p);
#endif
#else
    for (int ph = 0; ph <= NPHASE; ++ph) { p.ph_lo = ph; p.ph_hi = ph + 1; hipLaunchKernelGGL(fwd_megakernel, dim3(grid), dim3(512), LDS_BYTES, stream, p); }
#endif
}
```

```cpp
#include <hip/hip_runtime.h>
#include <hip/hip_cooperative_groups.h>
#include <cstdio>
namespace cg = cooperative_groups;

#define LAS __attribute__((address_space(3)))
typedef unsigned short bf16_t;
typedef short bf16x8 __attribute__((ext_vector_type(8)));
typedef float f32x4 __attribute__((ext_vector_type(4)));
typedef unsigned u32x4 __attribute__((ext_vector_type(4)));
typedef unsigned u32x2 __attribute__((ext_vector_type(2)));
typedef __bf16 bf16v2 __attribute__((ext_vector_type(2)));

constexpr int M = 8192, D = 2048, FF = 5632, NGU = 11264, NIN = 11520, NINSRC = 11280, PLE = 256;
constexpr int NH = 8, DH = 128, NCH = 128;
constexpr int C_QA = 0, C_KA = 1024, C_VA = 2048, C_Z = 3072, C_QB = 4096, C_KB = 5120, C_VB = 6144, C_GA = 7168, C_GB = 9216, C_AR = 11264, C_BR = 11272;
constexpr float EPS = 1e-6f;
constexpr size_t WS_WGU1 = 0;
constexpr size_t WS_WD1  = WS_WGU1 + (size_t)NGU * D * 2;
constexpr size_t WS_WIN  = WS_WD1 + (size_t)D * FF * 2;
constexpr size_t WS_WA   = WS_WIN + (size_t)NIN * D * 2;
constexpr size_t WS_WB   = WS_WA + (size_t)D * 1024 * 2;
constexpr size_t WS_WOUT = WS_WB + (size_t)D * 1024 * 2;
constexpr size_t WS_WGU2 = WS_WOUT + (size_t)D * D * 2;
constexpr size_t WS_WD2  = WS_WGU2 + (size_t)NGU * D * 2;
constexpr size_t WS_WPG  = WS_WD2 + (size_t)D * FF * 2;
constexpr size_t WS_WPP  = WS_WPG + (size_t)D * D * 2;
constexpr size_t WS_XB   = WS_WPP + (size_t)D * PLE * 2;
constexpr size_t WS_PROJ = WS_XB + (size_t)M * D * 2;
constexpr size_t WS_AQK  = WS_PROJ + (size_t)M * NIN * 2;
constexpr size_t WS_KTT  = WS_AQK + (size_t)1024 * 64 * 64 * 2;
constexpr size_t WS_PB   = WS_KTT + (size_t)M * 1024 * 2;
constexpr size_t WS_VT   = WS_PB + (size_t)M * PLE * 2;
constexpr size_t WS_SS   = WS_VT + (size_t)M * 1024 * 2;
constexpr size_t WS_TAIL = WS_SS + (size_t)4 * M * 4;
constexpr size_t WS_PROG = WS_TAIL + 4096;
constexpr size_t WS_BAR  = WS_PROG + 4096;
constexpr size_t WS_END  = WS_BAR + 16384;
constexpr size_t WS_ACT  = WS_PROJ;
constexpr size_t WS_RBUF = WS_PROJ;
constexpr size_t WS_U    = 0;
constexpr size_t WS_W    = WS_U + (size_t)M * 1024 * 4;
constexpr size_t WS_QD   = WS_W + (size_t)M * 1024 * 2;
constexpr size_t WS_MIX  = 0;
constexpr size_t WS_YB   = WS_XB;
constexpr size_t WS_YA   = WS_XB + (size_t)M * 1024 * 2;
static_assert(WS_QD + (size_t)M * 1024 * 2 <= WS_WIN, "gdn scratch overlaps live weights");

constexpr int LDS_BYTES = 147456;

__device__ __forceinline__ unsigned pk2(float lo, float hi) { bf16v2 v = {(__bf16)lo, (__bf16)hi}; return __builtin_bit_cast(unsigned, v); }
__device__ __forceinline__ float bf2f(bf16_t b) { return __uint_as_float(((unsigned)b) << 16); }
__device__ __forceinline__ float bflo(unsigned w) { return __uint_as_float(w << 16); }
__device__ __forceinline__ float bfhi(unsigned w) { return __uint_as_float(w & 0xffff0000u); }
__device__ __forceinline__ void unpack8(u32x4 w, float (&f)[8]) { f[0] = bflo(w.x); f[1] = bfhi(w.x); f[2] = bflo(w.y); f[3] = bfhi(w.y); f[4] = bflo(w.z); f[5] = bfhi(w.z); f[6] = bflo(w.w); f[7] = bfhi(w.w); }
__device__ __forceinline__ u32x4 pack8f(const float (&f)[8]) { u32x4 w; w.x = pk2(f[0], f[1]); w.y = pk2(f[2], f[3]); w.z = pk2(f[4], f[5]); w.w = pk2(f[6], f[7]); return w; }
__device__ __forceinline__ bf16x8 pack_acc(f32x4 a, f32x4 b) { u32x4 p; p.x = pk2(a[0], a[1]); p.y = pk2(a[2], a[3]); p.z = pk2(b[0], b[1]); p.w = pk2(b[2], b[3]); return __builtin_bit_cast(bf16x8, p); }
__device__ __forceinline__ bf16x8 ld2x8(const bf16_t* p0, const bf16_t* p1) { const u32x2 a = *(const u32x2*)p0, b = *(const u32x2*)p1; u32x4 v; v.x = a.x; v.y = a.y; v.z = b.x; v.w = b.y; return __builtin_bit_cast(bf16x8, v); }
__device__ __forceinline__ bf16x8 ld8(const bf16_t* p) { return __builtin_bit_cast(bf16x8, *(const u32x4*)p); }
__device__ __forceinline__ float sigmoidf_(float x) { return __builtin_amdgcn_rcpf(1.f + __expf(-x)); }
__device__ __forceinline__ float siluf_(float x) { return x * __builtin_amdgcn_rcpf(1.f + __expf(-x)); }
__device__ __forceinline__ float wave_sum(float v) {
#pragma unroll
    for (int o = 1; o < 64; o <<= 1) v += __shfl_xor(v, o);
    return v;
}
__device__ __forceinline__ int opaque_tid() { int t = threadIdx.x; asm volatile("" : "+v"(t)); return t; }
#define MFMA16(a, b, c) __builtin_amdgcn_mfma_f32_16x16x32_bf16((a), (b), (c), 0, 0, 0)

namespace pg8 {
constexpr int BM = 256, BK = 64, HALF = 128, HTB = HALF * BK * 2, STAGE_BYTES = 8 * HTB, NXCD = 8, WGM = 8;
__device__ __forceinline__ int lds_byte(int r, int c) { const int st = (r >> 4) * 2 + (c >> 5), rr = r & 15, cc = c & 31, ob = rr * 64 + cc * 2; return st * 1024 + (ob ^ (((ob >> 9) & 1) << 5)); }
__device__ __forceinline__ void stage_rc(int b, int& R, int& C) { const int st = b / 1024, sb = b % 1024, swz = sb ^ (((sb >> 9) & 1) << 5); R = (st >> 1) * 16 + swz / 64; C = (st & 1) * 32 + (swz % 64) / 2; }
__device__ __forceinline__ int perm32(int rho) { const int n = rho >> 4, i = rho & 15; return 8 * (i >> 2) + 4 * n + (i & 3); }

struct Unit { int pm, pn, sel; };
struct Sched {
    const bf16_t *A0, *B0, *A1, *B1;
    int nM, nN, nwg, G, c, dual;
    __device__ __forceinline__ void init(const bf16_t* a0, const bf16_t* b0, const bf16_t* a1, const bf16_t* b1, int Mr, int Nc, int G_, int c_, int dual_) {
        A0 = a0; B0 = b0; A1 = a1; B1 = b1; nM = Mr / BM; nN = Nc / BM; nwg = nM * nN; G = G_; c = c_; dual = dual_; }
    __device__ __forceinline__ bool next(int i, Unit& u) const {
        const int tile = dual ? (i >> 1) : i;
        const long L = (long)tile * G + c; if (L >= nwg) return false;
        int wgid = (int)L; { const int q = nwg / NXCD, r = nwg % NXCD, xcd = wgid % NXCD, off = wgid / NXCD; wgid = (xcd < r ? xcd * (q + 1) : r * (q + 1) + (xcd - r) * q) + off; }
        const int nig = WGM * nN, gid = wgid / nig, fm = gid * WGM, gsz = (nM - fm) < WGM ? (nM - fm) : WGM;
        u.pm = fm + ((wgid % nig) % gsz); u.pn = (wgid % nig) / gsz; u.sel = dual ? (i & 1) : 0; return true;
    }
};

template <class Epi>
__device__ __forceinline__ void gemm_phase(LAS unsigned char* lds, const int K, const Sched& S, const Epi& E) {
    const int tid = opaque_tid(), wid = __builtin_amdgcn_readfirstlane(tid >> 6), lane = tid & 63, wr = wid >> 2, wc = wid & 3, fr = lane & 15, fq = lane >> 4;
    const int nt = K / BK;
    unsigned voffA[2], voffB[2];
#pragma unroll
    for (int i = 0; i < 2; ++i) { int R, C; stage_rc(tid * 16 + i * 8192, R, C); const int Rb = Epi::PERM ? ((R & ~31) + perm32(R & 31)) : R;
        voffA[i] = (unsigned)(R * K + C) * 2u; voffB[i] = (unsigned)(Rb * K + C) * 2u; }
    const size_t kstep = (size_t)(BK * 2);
    const size_t hstep = (size_t)HALF * K * 2;
    const size_t tstep = 2 * hstep;
    const unsigned ldsw = (unsigned)wid * 1024u;
    const int aoff = lds_byte(wr * 64 + fr, fq * 8), boff = lds_byte(wc * 32 + fr, fq * 8);
#define PG8_SA(b, h) (((b) * 2 + (h)) * HTB)
#define PG8_SB(b, h) ((4 + (b) * 2 + (h)) * HTB)
#define PG8_STAGE(bufoff, gbase, voff) do { _Pragma("unroll") for (int _i = 0; _i < 2; ++_i) \
        __builtin_amdgcn_global_load_lds((const unsigned*)((const char*)(gbase) + (voff)[_i]), (LAS unsigned*)(lds + (bufoff) + ldsw + _i * 8192), 16, 0, 0); } while (0)
#define PG8_LDA(dst, b, h) do { _Pragma("unroll") for (int m = 0; m < 4; ++m) _Pragma("unroll") for (int k = 0; k < 2; ++k) dst[m][k] = *(const LAS bf16x8*)(lds + PG8_SA(b, h) + aoff + m * 2048 + k * 1024); } while (0)
#define PG8_LDB(dst, b, h) do { _Pragma("unroll") for (int n = 0; n < 2; ++n) _Pragma("unroll") for (int k = 0; k < 2; ++k) dst[n][k] = *(const LAS bf16x8*)(lds + PG8_SB(b, h) + boff + n * 2048 + k * 1024); } while (0)
#define PG8_MMA(ai, bj, At, Bt) do { __builtin_amdgcn_s_setprio(1); _Pragma("unroll") for (int m = 0; m < 4; ++m) _Pragma("unroll") for (int n = 0; n < 2; ++n) _Pragma("unroll") for (int k = 0; k < 2; ++k) \
        acc[ai][bj][m][n] = __builtin_amdgcn_mfma_f32_16x16x32_bf16(Bt[n][k], At[m][k], acc[ai][bj][m][n], 0, 0, 0); __builtin_amdgcn_s_setprio(0); } while (0)
#define PG8_WAIT_V(n) asm volatile("s_waitcnt vmcnt(" #n ")" ::: "memory")
#define PG8_WAIT_L(n) asm volatile("s_waitcnt lgkmcnt(" #n ")" ::: "memory")
#define PG8_BAR __builtin_amdgcn_s_barrier()
#define PG8_SCHED __builtin_amdgcn_sched_barrier(0)
    Unit cur, nxt; int ui = 0;
    if (!S.next(0, cur)) return;
    float ssv[8]; E.pre(cur, wr, fr, ssv);
    f32x4 acc[2][2][4][2];
#pragma unroll
    for (int a = 0; a < 2; ++a)
#pragma unroll
        for (int b = 0; b < 2; ++b)
#pragma unroll
            for (int m = 0; m < 4; ++m)
#pragma unroll
                for (int n = 0; n < 2; ++n) acc[a][b][m][n] = (f32x4){0.f, 0.f, 0.f, 0.f};
    bf16x8 At[4][2], B0[2][2], B1[2][2];
    const char* cA = (const char*)(cur.sel ? S.A1 : S.A0) + (size_t)cur.pm * tstep; const char* cB = (const char*)(cur.sel ? S.B1 : S.B0) + (size_t)cur.pn * tstep;
    PG8_STAGE(PG8_SB(0, 0), cB, voffB); PG8_STAGE(PG8_SA(0, 0), cA, voffA); PG8_STAGE(PG8_SB(0, 1), cB + hstep, voffB); PG8_STAGE(PG8_SA(0, 1), cA + hstep, voffA);
    if (wr == 1) PG8_BAR;
    PG8_WAIT_V(4); PG8_BAR;
    PG8_STAGE(PG8_SB(1, 0), cB + kstep, voffB); PG8_STAGE(PG8_SA(1, 0), cA + kstep, voffA); PG8_STAGE(PG8_SB(1, 1), cB + hstep + kstep, voffB);
    PG8_WAIT_V(6); PG8_BAR;
    for (;;) {
        const bool has_next = S.next(ui + 1, nxt);
        const char* nA = has_next ? (const char*)(nxt.sel ? S.A1 : S.A0) + (size_t)nxt.pm * tstep : cA; const char* nB = has_next ? (const char*)(nxt.sel ? S.B1 : S.B0) + (size_t)nxt.pn * tstep : cB;
        for (int t = 0; t < nt; t += 2) {
            const bool last = (t == nt - 2);
            const char* a1 = cA + (size_t)(t + 1) * kstep;
            const char* a2 = last ? nA : cA + (size_t)(t + 2) * kstep; const char* b2 = last ? nB : cB + (size_t)(t + 2) * kstep;
            const char* a3 = a2 + kstep; const char* b3 = b2 + kstep;
            PG8_LDB(B0, 0, 0); PG8_SCHED; PG8_LDA(At, 0, 0); PG8_STAGE(PG8_SA(1, 1), a1 + hstep, voffA);
            PG8_WAIT_L(8); PG8_BAR; PG8_WAIT_L(0); PG8_MMA(0, 0, At, B0); PG8_BAR; PG8_SCHED;
            PG8_LDB(B1, 0, 1); PG8_STAGE(PG8_SB(0, 0), b2, voffB);
            PG8_BAR; PG8_WAIT_L(0); PG8_MMA(0, 1, At, B1); PG8_BAR;
            PG8_LDA(At, 0, 1); PG8_STAGE(PG8_SA(0, 0), a2, voffA);
            PG8_BAR; PG8_WAIT_L(0); PG8_MMA(1, 0, At, B0); PG8_BAR; PG8_SCHED;
            PG8_STAGE(PG8_SB(0, 1), b2 + hstep, voffB);
            PG8_WAIT_V(6); PG8_BAR; PG8_MMA(1, 1, At, B1); PG8_BAR;
            PG8_LDB(B0, 1, 0); PG8_SCHED; PG8_LDA(At, 1, 0); PG8_STAGE(PG8_SA(0, 1), a2 + hstep, voffA);
            PG8_WAIT_L(8); PG8_BAR; PG8_WAIT_L(0); PG8_MMA(0, 0, At, B0); PG8_BAR; PG8_SCHED;
            PG8_LDB(B1, 1, 1); PG8_STAGE(PG8_SB(1, 0), b3, voffB);
            PG8_BAR; PG8_WAIT_L(0); PG8_MMA(0, 1, At, B1); PG8_BAR;
            PG8_LDA(At, 1, 1); PG8_STAGE(PG8_SA(1, 0), a3, voffA);
            PG8_BAR; PG8_WAIT_L(0); PG8_MMA(1, 0, At, B0); PG8_BAR; PG8_SCHED;
            PG8_STAGE(PG8_SB(1, 1), b3 + hstep, voffB);
            PG8_WAIT_V(6); PG8_BAR; PG8_MMA(1, 1, At, B1); PG8_BAR;
        }
        E(acc, cur, wr, wc, fr, fq, ssv);
        if (!has_next) break;
        if (!E.keep(cur)) {
#pragma unroll
            for (int a = 0; a < 2; ++a)
#pragma unroll
                for (int b = 0; b < 2; ++b)
#pragma unroll
                    for (int m = 0; m < 4; ++m)
#pragma unroll
                        for (int n = 0; n < 2; ++n) acc[a][b][m][n] = (f32x4){0.f, 0.f, 0.f, 0.f};
        }
        cur = nxt; cA = nA; cB = nB; ++ui;
        E.pre(cur, wr, fr, ssv);
    }
    PG8_WAIT_V(0);
    if (wr == 0) PG8_BAR;
    PG8_BAR;
#undef PG8_SA
#undef PG8_SB
#undef PG8_STAGE
#undef PG8_LDA
#undef PG8_LDB
#undef PG8_MMA
#undef PG8_WAIT_V
#undef PG8_WAIT_L
#undef PG8_BAR
#undef PG8_SCHED
}
}
using pg8::Unit;
typedef f32x4 Acc[2][2][4][2];

struct EpiGU {
    static constexpr bool PERM = true;
    bf16_t* O; const float* ss;
    __device__ __forceinline__ void pre(const Unit& u, int wr, int fr, float (&ssv)[8]) const {
#pragma unroll
        for (int ai = 0; ai < 2; ++ai)
#pragma unroll
            for (int m = 0; m < 4; ++m) ssv[ai * 4 + m] = ss[u.pm * 256 + ai * 128 + wr * 64 + m * 16 + fr];
    }
    __device__ __forceinline__ bool keep(const Unit&) const { return false; }
    __device__ __forceinline__ void operator()(Acc& acc, const Unit& u, int wr, int wc, int fr, int fq, const float (&ssv)[8]) const {
        const int row0 = u.pm * 256 + wr * 64 + fr, col0 = u.pn * 128 + wc * 32 + 8 * fq;
#pragma unroll
        for (int ai = 0; ai < 2; ++ai)
#pragma unroll
            for (int m = 0; m < 4; ++m) {
                const int row = row0 + ai * 128 + m * 16;
                const float rs = rsqrtf(ssv[ai * 4 + m] * (1.f / D) + EPS);
                const float rs2 = rs * rs, nrl = -1.4426950408889634f * rs;
                float o[8];
#pragma unroll
                for (int n = 0; n < 2; ++n)
#pragma unroll
                    for (int j = 0; j < 4; j += 2) {
                        typedef float f32x2v __attribute__((ext_vector_type(2)));
                        const f32x2v g = {acc[ai][0][m][n][j], acc[ai][0][m][n][j + 1]}, uu = {acc[ai][1][m][n][j], acc[ai][1][m][n][j + 1]};
                        const f32x2v t = g * nrl, p = (g * uu) * rs2;
                        f32x2v d; d.x = __builtin_amdgcn_exp2f(t.x); d.y = __builtin_amdgcn_exp2f(t.y); d = d + 1.0f;
                        f32x2v r; r.x = __builtin_amdgcn_rcpf(d.x); r.y = __builtin_amdgcn_rcpf(d.y);
                        const f32x2v q = p * r; o[n * 4 + j] = q.x; o[n * 4 + j + 1] = q.y;
                    }
                *(u32x4*)(O + (size_t)row * FF + col0) = pack8f(o);
            }
    }
};
struct EpiRes {
    static constexpr bool PERM = false;
    const float* base; float* out; bf16_t* ob; float* ssn; float scale;
    __device__ __forceinline__ void pre(const Unit&, int, int, float (&ssv)[8]) const {
#pragma unroll
        for (int i = 0; i < 8; ++i) ssv[i] = 0.f; }
    __device__ __forceinline__ bool keep(const Unit&) const { return false; }
    __device__ __forceinline__ void operator()(Acc& acc, const Unit& u, int wr, int wc, int fr, int fq, const float (&ssv)[8]) const {
        const int row0 = u.pm * 256 + wr * 64 + fr, col0 = u.pn * 256 + wc * 32 + 4 * fq;
#pragma unroll
        for (int ai = 0; ai < 2; ++ai) {
            f32x4 b[4][2][2];
#pragma unroll
            for (int m = 0; m < 4; ++m)
#pragma unroll
                for (int bj = 0; bj < 2; ++bj)
#pragma unroll
                    for (int n = 0; n < 2; ++n) b[m][bj][n] = *(const f32x4*)(base + (size_t)(row0 + ai * 128 + m * 16) * D + col0 + bj * 128 + n * 16);
#pragma unroll
            for (int m = 0; m < 4; ++m) {
                const int row = row0 + ai * 128 + m * 16; float sq = 0.f;
#pragma unroll
                for (int bj = 0; bj < 2; ++bj)
#pragma unroll
                    for (int n = 0; n < 2; ++n) {
                        const size_t off = (size_t)row * D + col0 + bj * 128 + n * 16;
                        const f32x4 v = b[m][bj][n] + acc[ai][bj][m][n] * scale;
                        *(f32x4*)(out + off) = v;
                        sq += (v[0] * v[0] + v[1] * v[1]) + (v[2] * v[2] + v[3] * v[3]);
                        u32x2 w; w.x = pk2(v[0], v[1]); w.y = pk2(v[2], v[3]);
                        *(u32x2*)(ob + off) = w;
                    }
                sq += __shfl_xor(sq, 16); sq += __shfl_xor(sq, 32);
                if (fq == 0) unsafeAtomicAdd(ssn + row, sq);
            }
        }
    }
};
struct EpiProj {
    static constexpr bool PERM = true;
    bf16_t* O; const float* ss;
    __device__ __forceinline__ void pre(const Unit& u, int wr, int fr, float (&ssv)[8]) const {
#pragma unroll
        for (int ai = 0; ai < 2; ++ai)
#pragma unroll
            for (int m = 0; m < 4; ++m) ssv[ai * 4 + m] = ss[u.pm * 256 + ai * 128 + wr * 64 + m * 16 + fr];
    }
    __device__ __forceinline__ bool keep(const Unit&) const { return false; }
    __device__ __forceinline__ void operator()(Acc& acc, const Unit& u, int wr, int wc, int fr, int fq, const float (&ssv)[8]) const {
        const int row0 = u.pm * 256 + wr * 64 + fr, col0 = u.pn * 256 + wc * 32 + 8 * fq;
#pragma unroll
        for (int ai = 0; ai < 2; ++ai)
#pragma unroll
            for (int m = 0; m < 4; ++m) {
                const int row = row0 + ai * 128 + m * 16;
                const float rs = rsqrtf(ssv[ai * 4 + m] * (1.f / D) + EPS);
#pragma unroll
                for (int bj = 0; bj < 2; ++bj) {
                    float o[8];
#pragma unroll
                    for (int n = 0; n < 2; ++n)
#pragma unroll
                        for (int j = 0; j < 4; ++j) o[n * 4 + j] = acc[ai][bj][m][n][j] * rs;
                    *(u32x4*)(O + (size_t)row * NIN + col0 + bj * 128) = pack8f(o);
                }
            }
    }
};
struct EpiMix {
    static constexpr bool PERM = true;
    const bf16_t* proj; bf16_t* O;
    __device__ __forceinline__ void pre(const Unit&, int, int, float (&ssv)[8]) const {
#pragma unroll
        for (int i = 0; i < 8; ++i) ssv[i] = 0.f; }
    __device__ __forceinline__ bool keep(const Unit& u) const { return u.sel == 0; }
    __device__ __forceinline__ void operator()(Acc& acc, const Unit& u, int wr, int wc, int fr, int fq, const float (&ssv)[8]) const {
        const int row0 = u.pm * 256 + wr * 64 + fr, col0 = u.pn * 256 + wc * 32 + 8 * fq;
#pragma unroll
        for (int ai = 0; ai < 2; ++ai) {
            u32x4 rga[4][2], rgb[4][2];
#pragma unroll
            for (int m = 0; m < 4; ++m)
#pragma unroll
                for (int bj = 0; bj < 2; ++bj) { const size_t o = (size_t)(row0 + ai * 128 + m * 16) * NIN + col0 + bj * 128;
                    rga[m][bj] = *(const u32x4*)(proj + o + C_GA); rgb[m][bj] = *(const u32x4*)(proj + o + C_GB); }
#pragma unroll
            for (int m = 0; m < 4; ++m) {
                const int row = row0 + ai * 128 + m * 16;
#pragma unroll
                for (int bj = 0; bj < 2; ++bj) {
                    const int col = col0 + bj * 128;
                    float ga[8], gb[8];
                    unpack8(rga[m][bj], ga);
                    unpack8(rgb[m][bj], gb);
                    if (u.sel == 0) {
#pragma unroll
                        for (int n = 0; n < 2; ++n)
#pragma unroll
                            for (int j = 0; j < 4; ++j) acc[ai][bj][m][n][j] *= (1.f + __expf(-gb[n * 4 + j])) * __builtin_amdgcn_rcpf(1.f + __expf(-ga[n * 4 + j]));
                    } else {
                        float o[8];
#pragma unroll
                        for (int n = 0; n < 2; ++n)
#pragma unroll
                            for (int j = 0; j < 4; ++j) o[n * 4 + j] = acc[ai][bj][m][n][j] * sigmoidf_(gb[n * 4 + j]);
                        *(u32x4*)(O + (size_t)row * D + col) = pack8f(o);
                    }
                }
            }
        }
    }
};
struct EpiF32 {
    static constexpr bool PERM = false;
    float* C;
    __device__ __forceinline__ void pre(const Unit&, int, int, float (&ssv)[8]) const {
#pragma unroll
        for (int i = 0; i < 8; ++i) ssv[i] = 0.f; }
    __device__ __forceinline__ bool keep(const Unit&) const { return false; }
    __device__ __forceinline__ void operator()(Acc& acc, const Unit& u, int wr, int wc, int fr, int fq, const float (&ssv)[8]) const {
        const int row0 = u.pm * 256 + wr * 64 + fr, col0 = u.pn * 256 + wc * 32 + 4 * fq;
#pragma unroll
        for (int ai = 0; ai < 2; ++ai)
#pragma unroll
            for (int m = 0; m < 4; ++m)
#pragma unroll
                for (int bj = 0; bj < 2; ++bj)
#pragma unroll
                    for (int n = 0; n < 2; ++n) *(f32x4*)(C + (size_t)(row0 + ai * 128 + m * 16) * D + col0 + bj * 128 + n * 16) = acc[ai][bj][m][n];
    }
};
struct EpiPle {
    static constexpr bool PERM = false;
    float* out; const float* R; const float* ss;
    __device__ __forceinline__ void pre(const Unit& u, int wr, int fr, float (&ssv)[8]) const {
#pragma unroll
        for (int ai = 0; ai < 2; ++ai)
#pragma unroll
            for (int m = 0; m < 4; ++m) ssv[ai * 4 + m] = ss[u.pm * 256 + ai * 128 + wr * 64 + m * 16 + fr];
    }
    __device__ __forceinline__ bool keep(const Unit&) const { return false; }
    __device__ __forceinline__ void operator()(Acc& acc, const Unit& u, int wr, int wc, int fr, int fq, const float (&ssv)[8]) const {
        const int row0 = u.pm * 256 + wr * 64 + fr, col0 = u.pn * 256 + wc * 32 + 4 * fq;
#pragma unroll
        for (int ai = 0; ai < 2; ++ai)
#pragma unroll
            for (int mp = 0; mp < 2; ++mp) {
                f32x4 bb[2][2][2], rr[2][2][2];
#pragma unroll
                for (int mm = 0; mm < 2; ++mm)
#pragma unroll
                    for (int bj = 0; bj < 2; ++bj)
#pragma unroll
                        for (int n = 0; n < 2; ++n) { const size_t off = (size_t)(row0 + ai * 128 + (2 * mp + mm) * 16) * D + col0 + bj * 128 + n * 16;
                            bb[mm][bj][n] = *(const f32x4*)(out + off); rr[mm][bj][n] = *(const f32x4*)(R + off); }
#pragma unroll
                for (int mm = 0; mm < 2; ++mm) {
                    const int m = 2 * mp + mm, row = row0 + ai * 128 + m * 16;
                    const float rs = rsqrtf(ssv[ai * 4 + m] * (1.f / D) + EPS);
#pragma unroll
                    for (int bj = 0; bj < 2; ++bj)
#pragma unroll
                        for (int n = 0; n < 2; ++n) {
                            const size_t off = (size_t)row * D + col0 + bj * 128 + n * 16;
                            f32x4 v;
#pragma unroll
                            for (int j = 0; j < 4; ++j) v[j] = bb[mm][bj][n][j] + sigmoidf_(acc[ai][bj][m][n][j] * rs) * rr[mm][bj][n][j];
                            *(f32x4*)(out + off) = v;
                        }
                }
            }
    }
};

struct Params {
    const float *x, *p, *ffn1_norm, *ffn1_w_gu, *ffn1_w_down, *mix_norm, *w_in, *conv_w, *a_log, *dt_bias, *gdn_norm, *q_norm, *k_norm, *rel_bias,
                *w_a, *w_b, *w_out, *ffn2_norm, *ffn2_w_gu, *ffn2_w_down, *ple_norm, *ple_gate, *ple_proj;
    float* out; unsigned char* ws; int ph_lo, ph_hi;
};

template <int MAP> __device__ __forceinline__ int src_col(int n) {
    if (MAP == 1) return ((n >> 7) & 1) * FF + (n >> 8) * 128 + (n & 127);
    if (MAP == 2) return n < 4096 ? n : (n < 11264 ? n + 16 : (n < 11280 ? n - 11264 + 4096 : -1));
    return n;
}
template <int MAP> __device__ __forceinline__ void transpose_item(const float* W, const float* nw, int K, int Nsrc, int Nd, bf16_t* WT, LAS float* scr, int item, int lane) {
    const int nblk = Nd / 64, kb = item / nblk, nb = item % nblk, k0 = 64 * kb, n0 = 64 * nb;
    const int r = lane >> 4, c4 = lane & 15;
    const int sc = src_col<MAP>(n0 + 4 * c4);
    f32x4 v[16];
#pragma unroll
    for (int i = 0; i < 16; ++i) v[i] = sc >= 0 ? __builtin_nontemporal_load((const f32x4*)(W + (size_t)(k0 + 4 * i + r) * Nsrc + sc)) : (f32x4){0.f, 0.f, 0.f, 0.f};
    if (nw) {
#pragma unroll
        for (int i = 0; i < 16; ++i) v[i] = v[i] * nw[k0 + 4 * i + r];
    }
#pragma unroll
    for (int i = 0; i < 16; ++i) { LAS float* p = scr + (4 * i + r) * 65 + 4 * c4; p[0] = v[i][0]; p[1] = v[i][1]; p[2] = v[i][2]; p[3] = v[i][3]; }
    asm volatile("s_waitcnt lgkmcnt(0)" ::: "memory"); __builtin_amdgcn_wave_barrier();
    const int ns = lane >> 3, kc = lane & 7;
#pragma unroll
    for (int j = 0; j < 8; ++j) { const LAS float* sp = scr + (8 * kc) * 65 + 8 * j + ns;
        u32x4 o; o.x = pk2(sp[0 * 65], sp[1 * 65]); o.y = pk2(sp[2 * 65], sp[3 * 65]); o.z = pk2(sp[4 * 65], sp[5 * 65]); o.w = pk2(sp[6 * 65], sp[7 * 65]);
        *(u32x4*)(WT + (size_t)(n0 + 8 * j + ns) * K + k0 + 8 * kc) = o; }
    asm volatile("s_waitcnt lgkmcnt(0)" ::: "memory"); __builtin_amdgcn_wave_barrier();
}
constexpr int I_GU = (D / 64) * (NGU / 64), I_DN = (FF / 64) * (D / 64), I_IN = (D / 64) * (NIN / 64), I_AB = (1024 / 64) * (D / 64), I_SQ = (D / 64) * (D / 64), I_PP = (PLE / 64) * (D / 64);
constexpr int N_EARLY = I_GU + I_DN + I_IN, N_LATE = I_GU + I_DN + 2 * I_AB + 2 * I_SQ + I_PP;
__device__ __forceinline__ void convert_early(const Params& P, LAS float* scr, int gw, int NGW, int lane, bool with_d1) {
    unsigned char* ws = P.ws;
    for (int it = gw; it < I_GU + I_IN + (with_d1 ? I_DN : 0); it += NGW) {
        int r = it;
        if (r < I_GU) { transpose_item<1>(P.ffn1_w_gu, P.ffn1_norm, D, NGU, NGU, (bf16_t*)(ws + WS_WGU1), scr, r, lane); continue; } r -= I_GU;
        if (r < I_IN) { transpose_item<2>(P.w_in, P.mix_norm, D, NINSRC, NIN, (bf16_t*)(ws + WS_WIN), scr, r, lane); continue; } r -= I_IN;
        transpose_item<0>(P.ffn1_w_down, nullptr, FF, D, D, (bf16_t*)(ws + WS_WD1), scr, r, lane);
    }
}
__device__ __forceinline__ void convert_d1(const Params& P, LAS float* scr, int gw, int NGW, int lane) {
    for (int it = gw; it < I_DN; it += NGW) transpose_item<0>(P.ffn1_w_down, nullptr, FF, D, D, (bf16_t*)(P.ws + WS_WD1), scr, it, lane);
}
__device__ __forceinline__ void convert_late(const Params& P, LAS float* scr, int lo_it, int hi_it, int gw, int NGW, int lane) {
    unsigned char* ws = P.ws;
    for (int it = lo_it + gw; it < hi_it; it += NGW) {
        int r = it;
        if (r < I_AB) { transpose_item<0>(P.w_a, nullptr, 1024, D, D, (bf16_t*)(ws + WS_WA), scr, r, lane); continue; } r -= I_AB;
        if (r < I_AB) { transpose_item<0>(P.w_b, nullptr, 1024, D, D, (bf16_t*)(ws + WS_WB), scr, r, lane); continue; } r -= I_AB;
        if (r < I_SQ) { transpose_item<0>(P.w_out, nullptr, D, D, D, (bf16_t*)(ws + WS_WOUT), scr, r, lane); continue; } r -= I_SQ;
        if (r < I_GU) { transpose_item<1>(P.ffn2_w_gu, P.ffn2_norm, D, NGU, NGU, (bf16_t*)(ws + WS_WGU2), scr, r, lane); continue; } r -= I_GU;
        if (r < I_DN) { transpose_item<0>(P.ffn2_w_down, nullptr, FF, D, D, (bf16_t*)(ws + WS_WD2), scr, r, lane); continue; } r -= I_DN;
        if (r < I_SQ) { transpose_item<0>(P.ple_gate, P.ple_norm, D, D, D, (bf16_t*)(ws + WS_WPG), scr, r, lane); continue; } r -= I_SQ;
        transpose_item<0>(P.ple_proj, nullptr, PLE, D, D, (bf16_t*)(ws + WS_WPP), scr, r, lane);
    }
}
constexpr int LATE_A = 2800, LATE_C = 2 * I_AB + I_SQ + I_GU;
__device__ __forceinline__ void idle_convert(const Params& P, LAS unsigned char* lds, int nwg, int G, int lo_it, int hi_it) {
    const int extra = nwg % G, c = blockIdx.x;
    if (extra == 0 || c < extra) return;
    const int tid = opaque_tid(), wave = tid >> 6;
    if (lo_it < 0) convert_d1(P, (LAS float*)(lds + wave * 17408), (c - extra) * 8 + wave, (G - extra) * 8, tid & 63);
    else convert_late(P, (LAS float*)(lds + wave * 17408), lo_it, hi_it, (c - extra) * 8 + wave, (G - extra) * 8, tid & 63);
}
__device__ __forceinline__ void phase_convert(const Params& P, LAS unsigned char* lds, int G) {
    const int tid = opaque_tid(), lane = tid & 63, wave = tid >> 6;
    LAS float* scr = (LAS float*)(lds + wave * 17408);
    const int gw = blockIdx.x * 8 + wave, NGW = G * 8;
    unsigned char* ws = P.ws;
    convert_early(P, scr, gw, NGW, lane, (((M / 256) * (NGU / 256)) % G) == 0);
    float* ss = (float*)(ws + WS_SS);
    bf16_t* xb = (bf16_t*)(ws + WS_XB); bf16_t* pb = (bf16_t*)(ws + WS_PB);
    for (int m0 = gw; m0 < M; m0 += 2 * NGW) {
        f32x4 xv[2][8], pv[2];
#pragma unroll
        for (int q = 0; q < 2; ++q) { const int m = m0 + q * NGW; if (m < M) {
            const f32x4* xr = (const f32x4*)(P.x + (size_t)m * D) + lane;
#pragma unroll
            for (int j = 0; j < 8; ++j) xv[q][j] = __builtin_nontemporal_load(xr + 64 * j);
            pv[q] = __builtin_nontemporal_load((const f32x4*)(P.p + (size_t)m * PLE) + lane); } }
#pragma unroll
        for (int q = 0; q < 2; ++q) { const int m = m0 + q * NGW; if (m < M) {
            u32x2* o8 = (u32x2*)(xb + (size_t)m * D) + lane; float s = 0.f;
#pragma unroll
            for (int j = 0; j < 8; ++j) { const f32x4 v = xv[q][j]; s += (v[0] * v[0] + v[1] * v[1]) + (v[2] * v[2] + v[3] * v[3]); u32x2 w; w.x = pk2(v[0], v[1]); w.y = pk2(v[2], v[3]); o8[64 * j] = w; }
            s = wave_sum(s); if (lane == 0) ss[m] = s;
            u32x2 w; w.x = pk2(pv[q][0], pv[q][1]); w.y = pk2(pv[q][2], pv[q][3]); *((u32x2*)(pb + (size_t)m * PLE) + lane) = w; } }
    }
    for (int i = blockIdx.x * 512 + tid; i < 3 * M; i += G * 512) ss[M + i] = 0.f;
    if (blockIdx.x == 0 && tid < 8) ((unsigned*)(ws + WS_PROG))[tid * 32] = 0u;
}

constexpr int L_LM = 0, L_GC = L_LM + 64 * 68 * 4, L_R = L_GC + 512, L_KBF = L_R + 65536, L_QBF = L_KBF + 64 * 136 * 2, L_VST = L_QBF + 64 * 136 * 2, L_END4 = L_VST + 64 * 136 * 2;
static_assert(L_END4 <= LDS_BYTES, "lds");
__device__ __forceinline__ void prep_item(const Params& P, LAS unsigned char* lds, int item, const int pflags) {
    const int tid = opaque_tid(), lane = tid & 63, wave = tid >> 6;
    const int n = item >> 3, h = item & 7;
    unsigned char* ws = P.ws;
    bf16_t* proj = (bf16_t*)(ws + WS_PROJ);
    LAS float* Rr = (LAS float*)(lds + L_R); LAS float* Lm = (LAS float*)(lds + L_LM);
    LAS bf16_t* kbf = (LAS bf16_t*)(lds + L_KBF); LAS bf16_t* qbf = (LAS bf16_t*)(lds + L_QBF); LAS bf16_t* vst = (LAS bf16_t*)(lds + L_VST);
    LAS float* gcs = (LAS float*)(lds + L_GC);
    const int l16 = tid & 15, rg = tid >> 4;
    float qv[2][8], kv[2][8], vv[2][8];
    u32x4 rawx[3][5];
#pragma unroll
    for (int X = 0; X < 3; ++X)
#pragma unroll
        for (int i = 0; i < 5; ++i) { const int gr = n * 64 + 2 * rg - 3 + i; const int colx = (X == 0 ? C_QA : (X == 1 ? C_KA : C_VA)) + h * DH + 8 * l16;
            rawx[X][i] = gr >= 0 ? __builtin_nontemporal_load((const u32x4*)(proj + (size_t)gr * NIN + colx)) : (u32x4){0u, 0u, 0u, 0u}; }
    if (wave == 0) {
        const size_t row = (size_t)n * 64 + lane;
        const float a = bf2f(proj[row * NIN + C_AR + h]), b = bf2f(proj[row * NIN + C_BR + h]);
        const float xx = a + P.dt_bias[h];
        const float sp = xx > 20.f ? xx : log1pf(expf(xx));
        float g = -expf(P.a_log[h]) * sp;
#pragma unroll
        for (int o = 1; o < 64; o <<= 1) { const float t = __shfl_up(g, o); if (lane >= o) g += t; }
        gcs[lane] = g; gcs[64 + lane] = 1.f / (1.f + expf(-b));
    }
#pragma unroll
    for (int X = 0; X < 3; ++X) {
        const int col = (X == 0 ? C_QA : (X == 1 ? C_KA : C_VA)) + h * DH + 8 * l16;
        const int ccol = X * 1024 + h * DH + 8 * l16;
        float xin[5][8];
#pragma unroll
        for (int i = 0; i < 5; ++i) unpack8(rawx[X][i], xin[i]);
        float y[2][8];
#pragma unroll
        for (int r = 0; r < 2; ++r)
#pragma unroll
            for (int e = 0; e < 8; ++e) y[r][e] = 0.f;
#pragma unroll
        for (int j = 0; j < 4; ++j) {
            const f32x4 c0 = *(const f32x4*)(P.conv_w + j * 3072 + ccol), c1 = *(const f32x4*)(P.conv_w + j * 3072 + ccol + 4);
#pragma unroll
            for (int r = 0; r < 2; ++r)
#pragma unroll
                for (int e = 0; e < 8; ++e) y[r][e] += (e < 4 ? c0[e] : c1[e - 4]) * xin[r + j][e];
        }
#pragma unroll
        for (int r = 0; r < 2; ++r) {
            float sq = 0.f;
#pragma unroll
            for (int e = 0; e < 8; ++e) { y[r][e] = siluf_(y[r][e]); sq += y[r][e] * y[r][e]; }
            if (X < 2) {
                sq += __shfl_xor(sq, 1); sq += __shfl_xor(sq, 2); sq += __shfl_xor(sq, 4); sq += __shfl_xor(sq, 8);
                const float rn = rsqrtf(sq + EPS) * (X == 0 ? 0.08838834764831845f : 1.f);
#pragma unroll
                for (int e = 0; e < 8; ++e) y[r][e] *= rn;
            }
#pragma unroll
            for (int e = 0; e < 8; ++e) { if (X == 0) qv[r][e] = y[r][e]; else if (X == 1) kv[r][e] = y[r][e]; else vv[r][e] = y[r][e]; }
        }
    }
    {
        u32x4 raw[2][3]; f32x4 gw[2][2];
#pragma unroll
        for (int r = 0; r < 2; ++r) { const size_t grow = (size_t)n * 64 + 2 * rg + r;
            raw[r][0] = __builtin_nontemporal_load((const u32x4*)(proj + grow * NIN + C_QB + h * DH + 8 * l16));
            raw[r][1] = __builtin_nontemporal_load((const u32x4*)(proj + grow * NIN + C_KB + h * DH + 8 * l16));
            raw[r][2] = __builtin_nontemporal_load((const u32x4*)(proj + grow * NIN + C_VB + h * DH + 8 * l16)); }
#pragma unroll
        for (int X = 0; X < 2; ++X) { const float* nwp = (X == 0 ? P.q_norm : P.k_norm) + 8 * l16; gw[X][0] = *(const f32x4*)nwp; gw[X][1] = *(const f32x4*)(nwp + 4); }
#pragma unroll
        for (int r = 0; r < 2; ++r) {
            const size_t grow = (size_t)n * 64 + 2 * rg + r;
#pragma unroll
            for (int X = 0; X < 2; ++X) {
                bf16_t* ptr = proj + grow * NIN + (X == 0 ? C_QB : C_KB) + h * DH + 8 * l16;
                float f[8]; unpack8(raw[r][X], f);
                float sq = 0.f;
#pragma unroll
                for (int e = 0; e < 8; ++e) sq += f[e] * f[e];
                sq += __shfl_xor(sq, 1); sq += __shfl_xor(sq, 2); sq += __shfl_xor(sq, 4); sq += __shfl_xor(sq, 8);
                const float rn = rsqrtf(sq * (1.f / DH) + EPS);
#pragma unroll
                for (int e = 0; e < 8; ++e) f[e] = f[e] * rn * (e < 4 ? gw[X][0][e] : gw[X][1][e - 4]);
                *(u32x4*)ptr = pack8f(f);
            }
            *(LAS u32x4*)(vst + (2 * rg + r) * 136 + 8 * l16) = raw[r][2];
        }
    }
    __syncthreads();
    {
        bf16_t* qd = (bf16_t*)(ws + WS_QD) + (size_t)item * 64 * 128;
        bf16_t* ktT = (bf16_t*)(ws + WS_KTT) + (size_t)item * 128 * 64;
        const float gl = gcs[63];
        float ktl[2][8];
#pragma unroll
        for (int r = 0; r < 2; ++r) {
            const int t = 2 * rg + r; const float gc = gcs[t], bt = gcs[64 + t];
            const float eg = __expf(gc), egl = __expf(gl - gc);
            float f[8];
#pragma unroll
            for (int e = 0; e < 8; ++e) f[e] = qv[r][e] * eg;
            *(u32x4*)(qd + ((((t >> 4) * 4 + (l16 >> 2)) * 64) + (l16 & 3) * 16 + (t & 15)) * 8) = pack8f(f);
#pragma unroll
            for (int e = 0; e < 8; ++e) ktl[r][e] = kv[r][e] * egl;
            *(LAS u32x4*)(qbf + t * 136 + 8 * l16) = pack8f(qv[r]);
            *(LAS u32x4*)(kbf + t * 136 + 8 * l16) = pack8f(kv[r]);
            LAS float* rr = Rr + t * 256 + 8 * l16;
            *(LAS f32x4*)(rr) = (f32x4){vv[r][0] * bt, vv[r][1] * bt, vv[r][2] * bt, vv[r][3] * bt};
            *(LAS f32x4*)(rr + 4) = (f32x4){vv[r][4] * bt, vv[r][5] * bt, vv[r][6] * bt, vv[r][7] * bt};
            const float be = bt * eg;
            *(LAS f32x4*)(rr + 128) = (f32x4){kv[r][0] * be, kv[r][1] * be, kv[r][2] * be, kv[r][3] * be};
            *(LAS f32x4*)(rr + 132) = (f32x4){kv[r][4] * be, kv[r][5] * be, kv[r][6] * be, kv[r][7] * be};
        }
#pragma unroll
        for (int e = 0; e < 8; ++e) { const int t0 = 2 * rg; *(unsigned*)(ktT + (((((l16 >> 1) * 2 + (t0 >> 5)) * 64) + ((t0 >> 3) & 3) * 16 + 8 * (l16 & 1) + e) * 8 + (t0 & 7))) = pk2(ktl[0][e], ktl[1][e]); }
        if (tid == 0) ((float*)(ws + WS_TAIL))[item] = __expf(gl);
        bf16_t* vt = (bf16_t*)(ws + WS_VT);
        const int d = tid & 127, tg = tid >> 7;
        unsigned pw[8];
#pragma unroll
        for (int i = 0; i < 8; ++i) { const unsigned lo = vst[(16 * tg + 2 * i) * 136 + d], hi = vst[(16 * tg + 2 * i + 1) * 136 + d]; pw[i] = lo | (hi << 16); }
        bf16_t* dst = vt + (size_t)(h * DH + d) * M + n * 64 + 16 * tg;
        *(u32x4*)dst = (u32x4){pw[0], pw[1], pw[2], pw[3]}; *(u32x4*)(dst + 8) = (u32x4){pw[4], pw[5], pw[6], pw[7]};
    }
    __syncthreads();
    {
        const int fr = lane & 15, fq = lane >> 4, which = wave >> 2, ti = wave & 3;
        LAS bf16_t* X = which ? qbf : kbf;
        bf16x8 a[4];
#pragma unroll
        for (int s = 0; s < 4; ++s) a[s] = *(const LAS bf16x8*)(X + (16 * ti + fr) * 136 + 32 * s + 8 * fq);
        bf16_t* aqk = (bf16_t*)(ws + WS_AQK) + (size_t)item * 64 * 64;
        for (int tj = 0; tj < 4; ++tj) {
            f32x4 c = {0.f, 0.f, 0.f, 0.f};
            if (tj <= ti) {
#pragma unroll
                for (int s = 0; s < 4; ++s) { const bf16x8 b = *(const LAS bf16x8*)(kbf + (16 * tj + fr) * 136 + 32 * s + 8 * fq); c = MFMA16(a[s], b, c); }
            }
            const int j = 16 * tj + fr; const float gj = gcs[j];
#pragma unroll
            for (int r = 0; r < 4; ++r) {
                const int i = 16 * ti + 4 * fq + r;
                const float dec = (i >= j) ? __expf(gcs[i] - gj) : 0.f;
                if (which == 0) { Lm[i * 68 + j] = (i > j) ? gcs[64 + i] * c[r] * dec : 0.f; }
                else { const float v = (i >= j) ? c[r] * dec : 0.f; aqk[((((i >> 4) * 2 + (j >> 5)) * 64) + ((j >> 3) & 3) * 16 + (i & 15)) * 8 + (j & 7)] = (bf16_t)(pk2(v, 0.f) & 0xffffu); }
            }
        }
    }
    __syncthreads();
    if (tid < 256) {
        int Lrow[64];
#pragma unroll
        for (int i = 0; i < 64; ++i) Lrow[i] = __float_as_int(Lm[i * 68 + lane]);
        float s[64];
#define LRD(i, j) __int_as_float(__builtin_amdgcn_readlane(Lrow[i], j))
#pragma unroll
        for (int g = 0; g < 16; ++g) {
            const int i0 = 4 * g;
            float a0 = Rr[(i0 + 0) * 256 + tid], a1 = Rr[(i0 + 1) * 256 + tid], a2 = Rr[(i0 + 2) * 256 + tid], a3 = Rr[(i0 + 3) * 256 + tid];
            if (!(pflags & 8)) {
#pragma unroll
            for (int j = 0; j < i0; ++j) { const float sj = s[j]; a0 -= LRD(i0, j) * sj; a1 -= LRD(i0 + 1, j) * sj; a2 -= LRD(i0 + 2, j) * sj; a3 -= LRD(i0 + 3, j) * sj; }
            a1 -= LRD(i0 + 1, i0) * a0;
            a2 -= LRD(i0 + 2, i0) * a0; a2 -= LRD(i0 + 2, i0 + 1) * a1;
            a3 -= LRD(i0 + 3, i0) * a0; a3 -= LRD(i0 + 3, i0 + 1) * a1; a3 -= LRD(i0 + 3, i0 + 2) * a2;
            }
            s[i0] = a0; s[i0 + 1] = a1; s[i0 + 2] = a2; s[i0 + 3] = a3;
        }
#undef LRD
        if (pflags & 32) { if (s[63] == 1.2345f) ((float*)(ws + WS_U))[tid] = s[5]; } else
        if (tid < 128) { float* u = (float*)(ws + WS_U) + (size_t)item * 64 * 128 + ((tid >> 4) * 256 + (tid & 15)) * 4;
#pragma unroll
            for (int i4 = 0; i4 < 16; ++i4) *(f32x4*)(u + ((i4 >> 2) * 64 + (i4 & 3) * 16) * 4) = (f32x4){s[4 * i4], s[4 * i4 + 1], s[4 * i4 + 2], s[4 * i4 + 3]}; }
        else { const int dk = tid - 128; bf16_t* w = (bf16_t*)(ws + WS_W) + (size_t)item * 64 * 128 + (((dk >> 5) * 64) + ((dk >> 3) & 3) * 16) * 8 + (dk & 7);
#pragma unroll
            for (int i = 0; i < 64; ++i) w[((i >> 4) * 256 + (i & 15)) * 8] = (bf16_t)(pk2(s[i], 0.f) & 0xffffu); }
    }
    __syncthreads();
}

struct ScanA { bf16x8 W[4], K0[2], K1[2]; f32x4 u; float tl; };
struct ScanB { bf16x8 Q[4], A[2]; };
struct ScanOff { unsigned w, aq, kt, u; };
__device__ __forceinline__ void scan_loadA(ScanA& o, const unsigned char* ws, int c, int h, const ScanOff& f) {
    const int item = c * 8 + h;
    const unsigned char* w = ws + WS_W + (size_t)item * 16384; const unsigned char* kt = ws + WS_KTT + (size_t)item * 16384; const unsigned char* u = ws + WS_U + (size_t)item * 32768;
#pragma unroll
    for (int s = 0; s < 4; ++s) o.W[s] = __builtin_bit_cast(bf16x8, *(const u32x4*)(w + f.w + 1024 * s));
#pragma unroll
    for (int s = 0; s < 2; ++s) { o.K0[s] = __builtin_bit_cast(bf16x8, *(const u32x4*)(kt + f.kt + 1024 * s)); o.K1[s] = __builtin_bit_cast(bf16x8, *(const u32x4*)(kt + f.kt + 2048 + 1024 * s)); }
    o.u = *(const f32x4*)(u + f.u);
    o.tl = ((const float*)(ws + WS_TAIL))[item];
}
__device__ __forceinline__ void scan_loadB(ScanB& o, const unsigned char* ws, int c, int h, const ScanOff& f) {
    const int item = c * 8 + h;
    const unsigned char* qd = ws + WS_QD + (size_t)item * 16384; const unsigned char* aq = ws + WS_AQK + (size_t)item * 8192;
#pragma unroll
    for (int s = 0; s < 4; ++s) o.Q[s] = __builtin_bit_cast(bf16x8, *(const u32x4*)(qd + f.w + 1024 * s));
#pragma unroll
    for (int s = 0; s < 2; ++s) o.A[s] = __builtin_bit_cast(bf16x8, *(const u32x4*)(aq + f.aq + 1024 * s));
}
__device__ __forceinline__ void scan_stepA(const ScanA& cur, f32x4& S0, f32x4& S1, LAS bf16_t* Sl, LAS bf16_t* Vl, int fr, int fq, int mt) {
    f32x4 wsv = {0.f, 0.f, 0.f, 0.f};
#pragma unroll
    for (int s = 0; s < 4; ++s) wsv = MFMA16(cur.W[s], *(const LAS bf16x8*)(Sl + fr * 136 + 32 * s + 8 * fq), wsv);
    const f32x4 vn = cur.u - wsv;
    { u32x2 pv; pv.x = pk2(vn[0], vn[1]); pv.y = pk2(vn[2], vn[3]); *(LAS u32x2*)(Vl + fr * 72 + 16 * mt + 4 * fq) = pv; }
    __syncthreads();
    S0 = S0 * cur.tl; S1 = S1 * cur.tl;
#pragma unroll
    for (int s = 0; s < 2; ++s) { const bf16x8 Vb = *(const LAS bf16x8*)(Vl + fr * 72 + 32 * s + 8 * fq); S0 = MFMA16(cur.K0[s], Vb, S0); S1 = MFMA16(cur.K1[s], Vb, S1); }
    { u32x2 p0, p1; p0.x = pk2(S0[0], S0[1]); p0.y = pk2(S0[2], S0[3]); p1.x = pk2(S1[0], S1[1]); p1.y = pk2(S1[2], S1[3]);
      *(LAS u32x2*)(Sl + fr * 136 + 32 * mt + 4 * fq) = p0; *(LAS u32x2*)(Sl + fr * 136 + 32 * mt + 16 + 4 * fq) = p1; }
    __syncthreads();
}
__device__ __forceinline__ void scan_stepB(const ScanB& cur, const LAS bf16_t* Sl, const LAS bf16_t* Vl, bf16_t* og, int fr, int fq) {
    f32x4 qs = {0.f, 0.f, 0.f, 0.f};
#pragma unroll
    for (int s = 0; s < 4; ++s) qs = MFMA16(*(const LAS bf16x8*)(Sl + fr * 136 + 32 * s + 8 * fq), cur.Q[s], qs);
    __syncthreads();
#pragma unroll
    for (int s = 0; s < 2; ++s) qs = MFMA16(*(const LAS bf16x8*)(Vl + fr * 72 + 32 * s + 8 * fq), cur.A[s], qs);
    { u32x2 w; w.x = pk2(qs[0], qs[1]); w.y = pk2(qs[2], qs[3]); *(u32x2*)og = w; }
    __syncthreads();
}
__device__ __forceinline__ void scan_wg(const Params& P, LAS unsigned char* lds, int h, int pair, const int VAR) {
    const int tid = opaque_tid(), lane = tid & 63, wave = tid >> 6, fr = lane & 15, fq = lane >> 4, mt = wave & 3, e0 = 16 * pair;
    const unsigned char* ws = P.ws;
    LAS bf16_t* Sl = (LAS bf16_t*)(lds);
    LAS bf16_t* Vl = (LAS bf16_t*)(lds + 4352);
    for (int i = tid; i < 4352 / 4; i += 512) ((LAS unsigned*)Sl)[i] = 0u;
    ScanOff f; f.w = (unsigned)(mt * 4096 + lane * 16); f.aq = (unsigned)(mt * 2048 + lane * 16); f.kt = (unsigned)(mt * 4096 + lane * 16); f.u = (unsigned)((((e0 >> 4) * 4 + mt) * 64 + lane) * 16);
    if (wave < 4) {
        f32x4 S0 = {0.f, 0.f, 0.f, 0.f}, S1 = {0.f, 0.f, 0.f, 0.f};
        ScanA a, b, c3; scan_loadA(a, ws, 0, h, f); scan_loadA(b, ws, 1, h, f);
        __syncthreads();
#pragma unroll 1
        for (int c = 0; c < NCH - 2; c += 3) {
            if (VAR != 3) scan_loadA(c3, ws, c + 2, h, f); scan_stepA(a, S0, S1, Sl, Vl, fr, fq, mt);
            if (VAR != 3) scan_loadA(a, ws, c + 3, h, f); scan_stepA(b, S0, S1, Sl, Vl, fr, fq, mt);
            if (VAR != 3) scan_loadA(b, ws, c + 4, h, f); scan_stepA(VAR == 3 ? a : c3, S0, S1, Sl, Vl, fr, fq, mt);
        }
        scan_stepA(a, S0, S1, Sl, Vl, fr, fq, mt); scan_stepA(b, S0, S1, Sl, Vl, fr, fq, mt);
    } else {
        bf16_t* Og = (bf16_t*)(P.ws + (VAR ? WS_END : WS_YA)) + (size_t)(16 * mt + fr) * 1024 + h * DH + e0 + 4 * fq;
        ScanB a, b, c3; scan_loadB(a, ws, 0, h, f); scan_loadB(b, ws, 1, h, f);
        __syncthreads();
#pragma unroll 1
        for (int c = 0; c < NCH - 2; c += 3) {
            if (VAR != 3) scan_loadB(c3, ws, c + 2, h, f); scan_stepB(a, Sl, Vl, Og + (size_t)c * 65536, fr, fq);
            if (VAR != 3) scan_loadB(a, ws, c + 3, h, f); scan_stepB(b, Sl, Vl, Og + (size_t)(c + 1) * 65536, fr, fq);
            if (VAR != 3) scan_loadB(b, ws, c + 4, h, f); scan_stepB(VAR == 3 ? a : c3, Sl, Vl, Og + (size_t)(c + 2) * 65536, fr, fq);
        }
        scan_stepB(a, Sl, Vl, Og + (size_t)(NCH - 2) * 65536, fr, fq); scan_stepB(b, Sl, Vl, Og + (size_t)(NCH - 1) * 65536, fr, fq);
    }
}

__device__ __forceinline__ void scan_helper(const Params& P, int h, int j, int NHp) {
    const int tid = threadIdx.x;
    const unsigned char* ws = P.ws;
    unsigned* prog = (unsigned*)(P.ws + WS_PROG) + h * 32;
    for (int c = j; c < NCH; c += NHp) {
        for (;;) { const unsigned pr = __hip_atomic_load(prog, __ATOMIC_RELAXED, __HIP_MEMORY_SCOPE_AGENT); if ((int)pr + 16 >= c) break; __builtin_amdgcn_s_sleep(16); }
        const int item = c * 8 + h;
        const u32x4* w16 = (const u32x4*)(ws + WS_W + (size_t)item * 16384); const u32x4* q16 = (const u32x4*)(ws + WS_QD + (size_t)item * 16384);
        const u32x4* k16 = (const u32x4*)(ws + WS_KTT + (size_t)item * 16384); const u32x4* a16 = (const u32x4*)(ws + WS_AQK + (size_t)item * 8192);
        const u32x4* u16 = (const u32x4*)(ws + WS_U + (size_t)item * 32768);
        u32x4 v[11];
        v[0] = w16[tid]; v[1] = w16[512 + tid]; v[2] = q16[tid]; v[3] = q16[512 + tid]; v[4] = k16[tid]; v[5] = k16[512 + tid]; v[6] = a16[tid];
        v[7] = u16[tid]; v[8] = u16[512 + tid]; v[9] = u16[1024 + tid]; v[10] = u16[1536 + tid];
#pragma unroll
        for (int i = 0; i < 11; ++i) asm volatile("" :: "v"(v[i]));
    }
}

constexpr int AL_K = 0, AL_V = 2 * 64 * 272, AL_B = AL_V + 2 * 128 * 144;
__device__ __forceinline__ void attn_compute(const LAS unsigned char* Kl, const LAS unsigned char* Vl, const LAS float* biasl, const bf16x8 (&Qb)[4], f32x4 (&Ot)[8], float& mrun, float& lrun,
                                             int c, int qi, int fr, int fq) {
    const float scale = 0.08838834764831845f;
    f32x4 st[4]; float mx = -1e30f;
#pragma unroll
    for (int kt = 0; kt < 4; ++kt) {
        f32x4 a = {0.f, 0.f, 0.f, 0.f};
#pragma unroll
        for (int s = 0; s < 4; ++s) a = MFMA16(*(const LAS bf16x8*)(Kl + (16 * kt + fr) * 272 + 64 * s + 16 * fq), Qb[s], a);
#pragma unroll
        for (int r = 0; r < 4; ++r) {
            const int ki = c * 64 + 16 * kt + 4 * fq + r; int dd = qi - ki; dd = dd < -63 ? -63 : (dd > 128 ? 128 : dd);
            a[r] = a[r] * scale + biasl[dd + 63]; mx = fmaxf(mx, a[r]);
        }
        st[kt] = a;
    }
    mx = fmaxf(mx, __shfl_xor(mx, 16)); mx = fmaxf(mx, __shfl_xor(mx, 32));
    const float mnew = fmaxf(mrun, mx), alpha = __expf(mrun - mnew); mrun = mnew;
    float rsum = 0.f;
#pragma unroll
    for (int kt = 0; kt < 4; ++kt)
#pragma unroll
        for (int r = 0; r < 4; ++r) { const float p = __expf(st[kt][r] - mnew); st[kt][r] = p; rsum += p; }
    lrun = lrun * alpha + rsum;
    bf16x8 Pb[2];
#pragma unroll
    for (int s = 0; s < 2; ++s) Pb[s] = pack_acc(st[2 * s], st[2 * s + 1]);
#pragma unroll
    for (int dt = 0; dt < 8; ++dt) {
        f32x4 o = Ot[dt] * alpha;
#pragma unroll
        for (int s = 0; s < 2; ++s) { const LAS unsigned char* pv = Vl + (16 * dt + fr) * 144 + 64 * s + 8 * fq;
            const u32x2 lo = *(const LAS u32x2*)pv, hi = *(const LAS u32x2*)(pv + 32); u32x4 av; av.x = lo.x; av.y = lo.y; av.z = hi.x; av.w = hi.y;
            o = MFMA16(__builtin_bit_cast(bf16x8, av), Pb[s], o); }
        Ot[dt] = o;
    }
}
__device__ __forceinline__ void attn_item(const Params& P, LAS unsigned char* lds, int m, int h) {
    const int tid = opaque_tid(), lane = tid & 63, wave = tid >> 6, fr = lane & 15, fq = lane >> 4;
    unsigned char* ws = P.ws;
    const bf16_t* proj = (const bf16_t*)(ws + WS_PROJ); const bf16_t* vt = (const bf16_t*)(ws + WS_VT); bf16_t* yb = (bf16_t*)(ws + WS_YB);
    LAS float* biasl = (LAS float*)(lds + AL_B);
    const int nq = 2 * m + (wave >> 2), w4 = wave & 3;
    const int qi = nq * 64 + 16 * w4 + fr;
    const int cbeg = 2 * m - 8 < 0 ? 0 : 2 * m - 8, cend = 2 * m + 1;
    const bf16_t* kg[2]; const bf16_t* vg[2]; int kl[2], vl[2];
#pragma unroll
    for (int i = 0; i < 2; ++i) { const int p = tid + 512 * i;
        kg[i] = proj + (size_t)(p >> 4) * NIN + C_KB + h * DH + 8 * (p & 15); kl[i] = (p >> 4) * 272 + 16 * (p & 15);
        vg[i] = vt + (size_t)(h * DH + (p >> 3)) * M + 8 * (p & 7); vl[i] = (p >> 3) * 144 + 16 * (p & 7); }
#define ATT_LOAD(KR, VR, C) do { _Pragma("unroll") for (int i = 0; i < 2; ++i) { KR[i] = *(const u32x4*)(kg[i] + (size_t)(C) * 64 * NIN); VR[i] = *(const u32x4*)(vg[i] + (C) * 64); } } while (0)
#define ATT_WRITE(KR, VR, BUF) do { _Pragma("unroll") for (int i = 0; i < 2; ++i) { *(LAS u32x4*)(lds + AL_K + (BUF) * (64 * 272) + kl[i]) = KR[i]; *(LAS u32x4*)(lds + AL_V + (BUF) * (128 * 144) + vl[i]) = VR[i]; } } while (0)
    u32x4 kA[2], vA[2], kB[2], vB[2];
    ATT_LOAD(kA, vA, cbeg);
    ATT_LOAD(kB, vB, cbeg + 1);
    if (tid < 192) biasl[tid] = P.rel_bias[h * 192 + tid];
    bf16x8 Qb[4];
#pragma unroll
    for (int s = 0; s < 4; ++s) Qb[s] = ld8(proj + (size_t)qi * NIN + C_QB + h * DH + 32 * s + 8 * fq);
    ATT_WRITE(kA, vA, 0);
    __syncthreads();
    float mrun = -1e30f, lrun = 0.f;
    f32x4 Ot[8];
#pragma unroll
    for (int i = 0; i < 8; ++i) Ot[i] = (f32x4){0.f, 0.f, 0.f, 0.f};
#pragma unroll 1
    for (int c = cbeg; c <= cend; c += 2) {
        if (c + 2 <= cend) ATT_LOAD(kA, vA, c + 2);
        if (c >= nq - 8 && c <= nq) attn_compute(lds + AL_K, lds + AL_V, biasl, Qb, Ot, mrun, lrun, c, qi, fr, fq);
        if (c + 1 <= cend) ATT_WRITE(kB, vB, 1);
        __syncthreads();
        if (c + 1 > cend) break;
        if (c + 3 <= cend) ATT_LOAD(kB, vB, c + 3);
        if (c + 1 >= nq - 8 && c + 1 <= nq) attn_compute(lds + AL_K + 64 * 272, lds + AL_V + 128 * 144, biasl, Qb, Ot, mrun, lrun, c + 1, qi, fr, fq);
        if (c + 2 <= cend) ATT_WRITE(kA, vA, 0);
        __syncthreads();
    }
#undef ATT_LOAD
#undef ATT_WRITE
    lrun += __shfl_xor(lrun, 16); lrun += __shfl_xor(lrun, 32);
    const float inv = 1.f / lrun;
#pragma unroll
    for (int dt = 0; dt < 8; ++dt) { u32x2 w; w.x = pk2(Ot[dt][0] * inv, Ot[dt][1] * inv); w.y = pk2(Ot[dt][2] * inv, Ot[dt][3] * inv);
        *(u32x2*)(yb + (size_t)qi * 1024 + h * DH + 16 * dt + 4 * fq) = w; }
}

__device__ __forceinline__ void phase_gnorm(const Params& P, int G) {
    unsigned char* ws = P.ws;
    bf16_t* ya = (bf16_t*)(ws + WS_YA); const bf16_t* proj = (const bf16_t*)(ws + WS_PROJ);
    const int gt = blockIdx.x * 512 + opaque_tid(), l16 = gt & 15;
    const f32x4 w0 = *(const f32x4*)(P.gdn_norm + 8 * l16), w1 = *(const f32x4*)(P.gdn_norm + 8 * l16 + 4);
    const int stride = (G * 512) >> 4;
    for (int g0 = gt >> 4; g0 < M * NH; g0 += 4 * stride) {
        u32x4 ro[4], rz[4]; bf16_t* po[4];
#pragma unroll
        for (int q = 0; q < 4; ++q) { const int g = g0 + q * stride; const int row = g >> 3, h = g & 7;
            po[q] = ya + (size_t)row * 1024 + h * DH + 8 * l16;
            if (g < M * NH) { ro[q] = *(const u32x4*)po[q]; rz[q] = __builtin_nontemporal_load((const u32x4*)(proj + (size_t)row * NIN + C_Z + h * DH + 8 * l16)); } }
#pragma unroll
        for (int q = 0; q < 4; ++q) if (g0 + q * stride < M * NH) {
            float o[8], z[8]; unpack8(ro[q], o); unpack8(rz[q], z);
            float sq = 0.f;
#pragma unroll
            for (int e = 0; e < 8; ++e) sq += o[e] * o[e];
            sq += __shfl_xor(sq, 1); sq += __shfl_xor(sq, 2); sq += __shfl_xor(sq, 4); sq += __shfl_xor(sq, 8);
            const float rn = rsqrtf(sq * (1.f / DH) + EPS);
#pragma unroll
            for (int e = 0; e < 8; ++e) o[e] = o[e] * rn * (e < 4 ? w0[e] : w1[e - 4]) * siluf_(z[e]);
            *(u32x4*)po[q] = pack8f(o);
        }
    }
}

#define XB_TMO      128
#define XB_XCNT(j)  (256  + 64 * (j))
#define XB_XSUB(j)  (1280 + 64 * (j))
#define XB_XGEN(j)  (2304 + 64 * (j))
#define XB_TOP      3328
#define XB_TOPGEN   3392
#define XCD_BAR_WORDS 3456
#define XB_SPIN_CAP (1u << 18)
__device__ __forceinline__ unsigned xb_ld(unsigned* p)              { return __hip_atomic_load(p, __ATOMIC_RELAXED, __HIP_MEMORY_SCOPE_AGENT); }
__device__ __forceinline__ unsigned xb_add(unsigned* p, unsigned v) { return __hip_atomic_fetch_add(p, v, __ATOMIC_RELAXED, __HIP_MEMORY_SCOPE_AGENT); }
__device__ __forceinline__ unsigned xb_xcc_id() { return (unsigned)__builtin_amdgcn_s_getreg((3 << 11) | 20) & 0xFu; }
#define XB_SPIN(cond, bar) do { unsigned _sp = 0; while (cond) { __builtin_amdgcn_s_sleep(1); \
    if ((++_sp & 255u) == 0u) { if (xb_ld(&(bar)[XB_TMO])) break; if (_sp > XB_SPIN_CAP) { atomicAdd(&(bar)[XB_TMO], 1u); break; } } } } while (0)
struct XcdBarrier { unsigned* bar; unsigned x; volatile LAS unsigned* st; };
__device__ __forceinline__ XcdBarrier xcd_barrier_post(unsigned* bar, volatile LAS unsigned* st) {
    XcdBarrier b; b.bar = bar; b.x = xb_xcc_id(); b.st = st;
    if (threadIdx.x == 0) (void)xb_add(&bar[XB_XCNT(b.x)], 1u);
    return b;
}
__device__ __forceinline__ void xcd_barrier_complete(unsigned* bar, unsigned x, unsigned& nloc, unsigned& nx) {
    const unsigned G = gridDim.x * gridDim.y * gridDim.z;
    unsigned sum, cnt, mine, sp = 0u;
    for (;;) {
        sum = 0u; cnt = 0u; mine = 0u;
#pragma unroll
        for (unsigned j = 0; j < 16; ++j) { const unsigned c = xb_ld(&bar[XB_XCNT(j)]); sum += c; cnt += (c > 0u) ? 1u : 0u; mine = (j == x) ? c : mine; }
        if (sum == G) break;
        __builtin_amdgcn_s_sleep(1);
        if ((++sp & 255u) == 0u) { if (xb_ld(&bar[XB_TMO])) break; if (sp > XB_SPIN_CAP) { atomicAdd(&bar[XB_TMO], 1u); break; } }
    }
    nloc = mine > 0u ? mine : 1u; nx = cnt > 0u ? cnt : 1u;
}
__device__ __forceinline__ void xcd_barrier(const XcdBarrier& b) {
    asm volatile("s_waitcnt vmcnt(0)" ::: "memory");
    __syncthreads();
    if (threadIdx.x == 0) {
        unsigned* bar = b.bar;
        __builtin_amdgcn_s_waitcnt(0);
        unsigned nloc = b.st[0], nx = b.st[1];
        if (nloc == 0u) { xcd_barrier_complete(bar, b.x, nloc, nx); b.st[0] = nloc; b.st[1] = nx; }
        const unsigned old = xb_add(&bar[XB_XSUB(b.x)], 1u);
        const unsigned gen = old / nloc;
        if (old + 1u == (gen + 1u) * nloc) {
            __builtin_amdgcn_fence(__ATOMIC_RELEASE, "agent");
            asm volatile("s_waitcnt vmcnt(0)" ::: "memory");
            const unsigned og = xb_add(&bar[XB_TOP], 1u);
            const unsigned tg = og / nx;
            if (og + 1u == (tg + 1u) * nx) xb_add(&bar[XB_TOPGEN], 1u);
            else XB_SPIN(xb_ld(&bar[XB_TOPGEN]) == tg, bar);
            __builtin_amdgcn_fence(__ATOMIC_ACQUIRE, "agent");
            xb_add(&bar[XB_XGEN(b.x)], 1u);
            asm volatile("s_waitcnt vmcnt(0)" ::: "memory");
        } else {
            XB_SPIN(xb_ld(&bar[XB_XGEN(b.x)]) == gen, bar);
            __builtin_amdgcn_fence(__ATOMIC_ACQUIRE, "agent");
            asm volatile("s_waitcnt vmcnt(0)" ::: "memory");
        }
    }
    __syncthreads();
}

constexpr int NPHASE = 11;
__global__ void __launch_bounds__(512, 2) fwd_megakernel(Params P) {
    extern __shared__ __attribute__((aligned(16))) unsigned char smem[];
    LAS unsigned char* lds = (LAS unsigned char*)smem;
    cg::grid_group grid = cg::this_grid();
    const int G = gridDim.x, lo = P.ph_lo, hi = P.ph_hi & 255, pflags = P.ph_hi >> 8;
    unsigned char* ws = P.ws;
    float* ss = (float*)(ws + WS_SS);
    bf16_t* xb = (bf16_t*)(ws + WS_XB); bf16_t* act = (bf16_t*)(ws + WS_ACT); bf16_t* proj = (bf16_t*)(ws + WS_PROJ);
#ifndef NREP5
#define NREP5 1
#endif
#ifndef REP_PHASE
#define REP_PHASE -1
#endif
#define IN(k) (lo <= (k) && (k) < hi)
    volatile LAS unsigned* xst = (volatile LAS unsigned*)(lds + LDS_BYTES - 16);
    if (threadIdx.x == 0) { xst[0] = 0u; xst[1] = 0u; }
    __syncthreads();
    XcdBarrier xbar = xcd_barrier_post((unsigned*)(ws + WS_BAR), xst);
    if (lo < 0) grid.sync();
#define SEAM(k) do { if (IN(k) && IN((k) + 1)) xcd_barrier(xbar); } while (0)
    for (int rep = 0; rep < (REP_PHASE == 0 ? 2 : 1); ++rep) { if (IN(0)) phase_convert(P, lds, G);
    SEAM(0); }
    for (int rep = 0; rep < (REP_PHASE == 1 ? 2 : 1); ++rep) {
    if (IN(1)) { pg8::Sched S; S.init(xb, (const bf16_t*)(ws + WS_WGU1), nullptr, nullptr, M, NGU, G, blockIdx.x, 0); EpiGU E{act, ss}; pg8::gemm_phase(lds, D, S, E);
        idle_convert(P, lds, (M / 256) * (NGU / 256), G, -1, 0); }
    SEAM(1); }
    if (IN(2)) { pg8::Sched S; S.init(act, (const bf16_t*)(ws + WS_WD1), nullptr, nullptr, M, D, G, blockIdx.x, 0); EpiRes E{P.x, P.out, xb, ss + M, 0.5f}; pg8::gemm_phase(lds, FF, S, E); }
    SEAM(2);
    if (IN(3)) { pg8::Sched S; S.init(xb, (const bf16_t*)(ws + WS_WIN), nullptr, nullptr, M, NIN, G, blockIdx.x, 0); EpiProj E{proj, ss + M}; pg8::gemm_phase(lds, D, S, E);
        idle_convert(P, lds, (M / 256) * (NIN / 256), G, 0, LATE_A); }
    SEAM(3);
    if (IN(4)) { const int nit = (NCH * NH - 1 - (int)blockIdx.x) / G; for (int k = nit; k >= 0; --k) prep_item(P, lds, blockIdx.x + k * G, pflags); }
    SEAM(4);
_Pragma("unroll 1")
    for (int rep = 0; rep < NREP5; ++rep) {
    if (IN(5)) {
        const int tid5 = opaque_tid(), wave = tid5 >> 6, b = blockIdx.x;
        if (b < 64) { if (!(pflags & 4)) scan_wg(P, lds, b & 7, b >> 3, 0); }
        else { if (!(pflags & 2)) for (int it = b - 64; it < (NCH / 2) * NH; it += G - 64) attn_item(P, lds, it >> 3, it & 7);
            if (!(pflags & 1)) convert_late(P, (LAS float*)(lds + wave * 17408), ((((M / 256) * (NIN / 256)) % G) ? LATE_A : 0), ((((M / 256) * (NGU / 256)) % G) ? LATE_C : N_LATE), (b - 64) * 8 + wave, (G - 64) * 8, tid5 & 63); }
    }
    SEAM(5); }
    if (IN(6)) phase_gnorm(P, G);
    SEAM(6);
    if (IN(7)) { pg8::Sched S; S.init((const bf16_t*)(ws + WS_YA), (const bf16_t*)(ws + WS_WA), (const bf16_t*)(ws + WS_YB), (const bf16_t*)(ws + WS_WB), M, D, G, blockIdx.x, 1);
        EpiMix E{proj, (bf16_t*)(ws + WS_MIX)}; pg8::gemm_phase(lds, 1024, S, E); }
    SEAM(7);
    if (IN(8)) { pg8::Sched S; S.init((const bf16_t*)(ws + WS_MIX), (const bf16_t*)(ws + WS_WOUT), nullptr, nullptr, M, D, G, blockIdx.x, 0); EpiRes E{P.out, P.out, xb, ss + 2 * M, 1.0f}; pg8::gemm_phase(lds, D, S, E); }
    SEAM(8);
    if (IN(9)) { pg8::Sched S; S.init(xb, (const bf16_t*)(ws + WS_WGU2), nullptr, nullptr, M, NGU, G, blockIdx.x, 0); EpiGU E{act, ss + 2 * M}; pg8::gemm_phase(lds, D, S, E);
        idle_convert(P, lds, (M / 256) * (NGU / 256), G, LATE_C, N_LATE); }
    SEAM(9);
    if (IN(10)) { pg8::Sched S; S.init(act, (const bf16_t*)(ws + WS_WD2), nullptr, nullptr, M, D, G, blockIdx.x, 0); EpiRes E{P.out, P.out, xb, ss + 3 * M, 0.5f}; pg8::gemm_phase(lds, FF, S, E); }
    SEAM(10);
    if (IN(11)) {
        { pg8::Sched S; S.init((const bf16_t*)(ws + WS_PB), (const bf16_t*)(ws + WS_WPP), nullptr, nullptr, M, D, G, blockIdx.x, 0); EpiF32 E{(float*)(ws + WS_RBUF)}; pg8::gemm_phase(lds, PLE, S, E); }
        { pg8::Sched S; S.init(xb, (const bf16_t*)(ws + WS_WPG), nullptr, nullptr, M, D, G, blockIdx.x, 0); EpiPle E{P.out, (const float*)(ws + WS_RBUF), ss + 3 * M}; pg8::gemm_phase(lds, D, S, E); }
    }
#undef IN
#undef SEAM
}


#ifdef PROBE_VAR
__global__ void __launch_bounds__(512, 2) probe_scan(Params P) {
    extern __shared__ __attribute__((aligned(16))) unsigned char smem[];
    scan_wg(P, (LAS unsigned char*)smem, blockIdx.x & 7, blockIdx.x >> 3, PROBE_VAR);
}
#endif
#ifndef N_LAUNCH_MODE
#define N_LAUNCH_MODE 0
#endif
extern "C" void kernel_launch(void* const* d_in, const int* in_sizes, int n_in, void* d_out, int out_size, void* d_ws, size_t ws_size, hipStream_t stream) {
    static int grid = 0;
    if (grid == 0) {
        if (n_in != 23 || out_size != M * D || ws_size < WS_END) { fprintf(stderr, "kernel_launch: unexpected problem (n_in %d out %d ws %zu need %zu)\n", n_in, out_size, ws_size, (size_t)WS_END); grid = -1; return; }
        int dev = 0, cus = 0, per_cu = 0;
        hipGetDevice(&dev); hipDeviceGetAttribute(&cus, hipDeviceAttributeMultiprocessorCount, dev);
        if (hipFuncSetAttribute((const void*)fwd_megakernel, hipFuncAttributeMaxDynamicSharedMemorySize, LDS_BYTES) != hipSuccess) { fprintf(stderr, "kernel_launch: hipFuncSetAttribute failed\n"); grid = -1; return; }
        if (hipOccupancyMaxActiveBlocksPerMultiprocessor(&per_cu, (const void*)fwd_megakernel, 512, LDS_BYTES) != hipSuccess || per_cu < 1) { fprintf(stderr, "kernel_launch: occupancy query failed (%d)\n", per_cu); (void)hipGetLastError(); per_cu = 1; }
        grid = cus * 1;
        if (grid < 192) { fprintf(stderr, "kernel_launch: grid too small\n"); grid = -1; return; }
    }
    if (grid < 0) return;
    if (hipMemsetAsync((char*)d_ws + WS_BAR, 0, 16384, stream) != hipSuccess) { fprintf(stderr, "kernel_launch: memset of the barrier words failed\n"); return; }
    Params p{};
    const float** pp = (const float**)&p;
    for (int i = 0; i < 23; ++i) pp[i] = (const float*)d_in[i];
    p.out = (float*)d_out; p.ws = (unsigned char*)d_ws;
#if N_LAUNCH_MODE == 0
    p.ph_lo = 0; p.ph_hi = NPHASE + 1;
    void* args[] = {&p};
    hipError_t e = hipLaunchCooperativeKernel((const void*)fwd_megakernel, dim3(grid), dim3(512), args, LDS_BYTES, stream);
    if (e != hipSuccess) fprintf(stderr, "cooperative launch failed: %s (grid %d)\n", hipGetErrorString(e), grid);
#ifdef PROBE_VAR
    hipLaunchKernelGGL(probe_scan, dim3(64), dim3(512), 16384, stream, p);
#endif
#ifdef PROBE_PHASE
    p.ph_lo = PROBE_PHASE; p.ph_hi = (PROBE_PHASE + 1) | (PROBE_FLAGS << 8); hipLaunchKernelGGL(fwd_megakernel, dim3(grid), dim3(512), LDS_BYTES, stream, p);
#endif
#else
    for (int ph = 0; ph <= NPHASE; ++ph) { p.ph_lo = ph; p.ph_hi = ph + 1; hipLaunchKernelGGL(fwd_megakernel, dim3(grid), dim3(512), LDS_BYTES, stream, p); }
#endif
}
```

```cpp
#include <hip/hip_runtime.h>
#include <hip/hip_cooperative_groups.h>
#include <cstdio>
namespace cg = cooperative_groups;

#define LAS __attribute__((address_space(3)))
typedef unsigned short bf16_t;
typedef short bf16x8 __attribute__((ext_vector_type(8)));
typedef float f32x4 __attribute__((ext_vector_type(4)));
typedef unsigned u32x4 __attribute__((ext_vector_type(4)));
typedef unsigned u32x2 __attribute__((ext_vector_type(2)));
typedef __bf16 bf16v2 __attribute__((ext_vector_type(2)));

constexpr int M = 8192, D = 2048, FF = 5632, NGU = 11264, NIN = 11520, NINSRC = 11280, PLE = 256;
constexpr int NH = 8, DH = 128, NCH = 128;
constexpr int C_QA = 0, C_KA = 1024, C_VA = 2048, C_Z = 3072, C_QB = 4096, C_KB = 5120, C_VB = 6144, C_GA = 7168, C_GB = 9216, C_AR = 11264, C_BR = 11272;
constexpr float EPS = 1e-6f;
constexpr size_t WS_WGU1 = 0;
constexpr size_t WS_WD1  = WS_WGU1 + (size_t)NGU * D * 2;
constexpr size_t WS_WIN  = WS_WD1 + (size_t)D * FF * 2;
constexpr size_t WS_WA   = WS_WIN + (size_t)NIN * D * 2;
constexpr size_t WS_WB   = WS_WA + (size_t)D * 1024 * 2;
constexpr size_t WS_WOUT = WS_WB + (size_t)D * 1024 * 2;
constexpr size_t WS_WGU2 = WS_WOUT + (size_t)D * D * 2;
constexpr size_t WS_WD2  = WS_WGU2 + (size_t)NGU * D * 2;
constexpr size_t WS_WPG  = WS_WD2 + (size_t)D * FF * 2;
constexpr size_t WS_WPP  = WS_WPG + (size_t)D * D * 2;
constexpr size_t WS_XB   = WS_WPP + (size_t)D * PLE * 2;
constexpr size_t WS_PROJ = WS_XB + (size_t)M * D * 2;
constexpr size_t WS_AQK  = WS_PROJ + (size_t)M * NIN * 2;
constexpr size_t WS_KTT  = WS_AQK + (size_t)1024 * 64 * 64 * 2;
constexpr size_t WS_PB   = WS_KTT + (size_t)M * 1024 * 2;
constexpr size_t WS_VT   = WS_PB + (size_t)M * PLE * 2;
constexpr size_t WS_SS   = WS_VT + (size_t)M * 1024 * 2;
constexpr size_t WS_TAIL = WS_SS + (size_t)4 * M * 4;
constexpr size_t WS_PROG = WS_TAIL + 4096;
constexpr size_t WS_BAR  = WS_PROG + 4096;
constexpr size_t WS_END  = WS_BAR + 16384;
constexpr size_t WS_ACT  = WS_PROJ;
constexpr size_t WS_RBUF = WS_PROJ;
constexpr size_t WS_U    = 0;
constexpr size_t WS_W    = WS_U + (size_t)M * 1024 * 4;
constexpr size_t WS_QD   = WS_W + (size_t)M * 1024 * 2;
constexpr size_t WS_MIX  = 0;
constexpr size_t WS_YB   = WS_XB;
constexpr size_t WS_YA   = WS_XB + (size_t)M * 1024 * 2;
static_assert(WS_QD + (size_t)M * 1024 * 2 <= WS_WIN, "gdn scratch overlaps live weights");

constexpr int LDS_BYTES = 147456;

__device__ __forceinline__ unsigned pk2(float lo, float hi) { bf16v2 v = {(__bf16)lo, (__bf16)hi}; return __builtin_bit_cast(unsigned, v); }
__device__ __forceinline__ float bf2f(bf16_t b) { return __uint_as_float(((unsigned)b) << 16); }
__device__ __forceinline__ float bflo(unsigned w) { return __uint_as_float(w << 16); }
__device__ __forceinline__ float bfhi(unsigned w) { return __uint_as_float(w & 0xffff0000u); }
__device__ __forceinline__ void unpack8(u32x4 w, float (&f)[8]) { f[0] = bflo(w.x); f[1] = bfhi(w.x); f[2] = bflo(w.y); f[3] = bfhi(w.y); f[4] = bflo(w.z); f[5] = bfhi(w.z); f[6] = bflo(w.w); f[7] = bfhi(w.w); }
__device__ __forceinline__ u32x4 pack8f(const float (&f)[8]) { u32x4 w; w.x = pk2(f[0], f[1]); w.y = pk2(f[2], f[3]); w.z = pk2(f[4], f[5]); w.w = pk2(f[6], f[7]); return w; }
__device__ __forceinline__ bf16x8 pack_acc(f32x4 a, f32x4 b) { u32x4 p; p.x = pk2(a[0], a[1]); p.y = pk2(a[2], a[3]); p.z = pk2(b[0], b[1]); p.w = pk2(b[2], b[3]); return __builtin_bit_cast(bf16x8, p); }
__device__ __forceinline__ bf16x8 ld2x8(const bf16_t* p0, const bf16_t* p1) { const u32x2 a = *(const u32x2*)p0, b = *(const u32x2*)p1; u32x4 v; v.x = a.x; v.y = a.y; v.z = b.x; v.w = b.y; return __builtin_bit_cast(bf16x8, v); }
__device__ __forceinline__ bf16x8 ld8(const bf16_t* p) { return __builtin_bit_cast(bf16x8, *(const u32x4*)p); }
__device__ __forceinline__ float sigmoidf_(float x) { return __builtin_amdgcn_rcpf(1.f + __expf(-x)); }
__device__ __forceinline__ float siluf_(float x) { return x * __builtin_amdgcn_rcpf(1.f + __expf(-x)); }
__device__ __forceinline__ float wave_sum(float v) {
#pragma unroll
    for (int o = 1; o < 64; o <<= 1) v += __shfl_xor(v, o);
    return v;
}
__device__ __forceinline__ int opaque_tid() { int t = threadIdx.x; asm volatile("" : "+v"(t)); return t; }
#define MFMA16(a, b, c) __builtin_amdgcn_mfma_f32_16x16x32_bf16((a), (b), (c), 0, 0, 0)

namespace pg8 {
constexpr int BM = 256, BK = 64, HALF = 128, HTB = HALF * BK * 2, STAGE_BYTES = 8 * HTB, NXCD = 8, WGM = 8;
__device__ __forceinline__ int lds_byte(int r, int c) { const int st = (r >> 4) * 2 + (c >> 5), rr = r & 15, cc = c & 31, ob = rr * 64 + cc * 2; return st * 1024 + (ob ^ (((ob >> 9) & 1) << 5)); }
__device__ __forceinline__ void stage_rc(int b, int& R, int& C) { const int st = b / 1024, sb = b % 1024, swz = sb ^ (((sb >> 9) & 1) << 5); R = (st >> 1) * 16 + swz / 64; C = (st & 1) * 32 + (swz % 64) / 2; }
__device__ __forceinline__ int perm32(int rho) { const int n = rho >> 4, i = rho & 15; return 8 * (i >> 2) + 4 * n + (i & 3); }

struct Unit { int pm, pn, sel; };
struct Sched {
    const bf16_t *A0, *B0, *A1, *B1;
    int nM, nN, nwg, G, c, dual;
    __device__ __forceinline__ void init(const bf16_t* a0, const bf16_t* b0, const bf16_t* a1, const bf16_t* b1, int Mr, int Nc, int G_, int c_, int dual_) {
        A0 = a0; B0 = b0; A1 = a1; B1 = b1; nM = Mr / BM; nN = Nc / BM; nwg = nM * nN; G = G_; c = c_; dual = dual_; }
    __device__ __forceinline__ bool next(int i, Unit& u) const {
        const int tile = dual ? (i >> 1) : i;
        const long L = (long)tile * G + c; if (L >= nwg) return false;
        int wgid = (int)L; { const int q = nwg / NXCD, r = nwg % NXCD, xcd = wgid % NXCD, off = wgid / NXCD; wgid = (xcd < r ? xcd * (q + 1) : r * (q + 1) + (xcd - r) * q) + off; }
        const int nig = WGM * nN, gid = wgid / nig, fm = gid * WGM, gsz = (nM - fm) < WGM ? (nM - fm) : WGM;
        u.pm = fm + ((wgid % nig) % gsz); u.pn = (wgid % nig) / gsz; u.sel = dual ? (i & 1) : 0; return true;
    }
};

template <class Epi>
__device__ __forceinline__ void gemm_phase(LAS unsigned char* lds, const int K, const Sched& S, const Epi& E) {
    const int tid = opaque_tid(), wid = __builtin_amdgcn_readfirstlane(tid >> 6), lane = tid & 63, wr = wid >> 2, wc = wid & 3, fr = lane & 15, fq = lane >> 4;
    const int nt = K / BK;
    unsigned voffA[2], voffB[2];
#pragma unroll
    for (int i = 0; i < 2; ++i) { int R, C; stage_rc(tid * 16 + i * 8192, R, C); const int Rb = Epi::PERM ? ((R & ~31) + perm32(R & 31)) : R;
        voffA[i] = (unsigned)(R * K + C) * 2u; voffB[i] = (unsigned)(Rb * K + C) * 2u; }
    const size_t kstep = (size_t)(BK * 2);
    const size_t hstep = (size_t)HALF * K * 2;
    const size_t tstep = 2 * hstep;
    const unsigned ldsw = (unsigned)wid * 1024u;
    const int aoff = lds_byte(wr * 64 + fr, fq * 8), boff = lds_byte(wc * 32 + fr, fq * 8);
#define PG8_SA(b, h) (((b) * 2 + (h)) * HTB)
#define PG8_SB(b, h) ((4 + (b) * 2 + (h)) * HTB)
#define PG8_STAGE(bufoff, gbase, voff) do { _Pragma("unroll") for (int _i = 0; _i < 2; ++_i) \
        __builtin_amdgcn_global_load_lds((const unsigned*)((const char*)(gbase) + (voff)[_i]), (LAS unsigned*)(lds + (bufoff) + ldsw + _i * 8192), 16, 0, 0); } while (0)
#define PG8_LDA(dst, b, h) do { _Pragma("unroll") for (int m = 0; m < 4; ++m) _Pragma("unroll") for (int k = 0; k < 2; ++k) dst[m][k] = *(const LAS bf16x8*)(lds + PG8_SA(b, h) + aoff + m * 2048 + k * 1024); } while (0)
#define PG8_LDB(dst, b, h) do { _Pragma("unroll") for (int n = 0; n < 2; ++n) _Pragma("unroll") for (int k = 0; k < 2; ++k) dst[n][k] = *(const LAS bf16x8*)(lds + PG8_SB(b, h) + boff + n * 2048 + k * 1024); } while (0)
#define PG8_MMA(ai, bj, At, Bt) do { __builtin_amdgcn_s_setprio(1); _Pragma("unroll") for (int m = 0; m < 4; ++m) _Pragma("unroll") for (int n = 0; n < 2; ++n) _Pragma("unroll") for (int k = 0; k < 2; ++k) \
        acc[ai][bj][m][n] = __builtin_amdgcn_mfma_f32_16x16x32_bf16(Bt[n][k], At[m][k], acc[ai][bj][m][n], 0, 0, 0); __builtin_amdgcn_s_setprio(0); } while (0)
#define PG8_WAIT_V(n) asm volatile("s_waitcnt vmcnt(" #n ")" ::: "memory")
#define PG8_WAIT_L(n) asm volatile("s_waitcnt lgkmcnt(" #n ")" ::: "memory")
#define PG8_BAR __builtin_amdgcn_s_barrier()
#define PG8_SCHED __builtin_amdgcn_sched_barrier(0)
    Unit cur, nxt; int ui = 0;
    if (!S.next(0, cur)) return;
    float ssv[8]; E.pre(cur, wr, fr, ssv);
    f32x4 acc[2][2][4][2];
#pragma unroll
    for (int a = 0; a < 2; ++a)
#pragma unroll
        for (int b = 0; b < 2; ++b)
#pragma unroll
            for (int m = 0; m < 4; ++m)
#pragma unroll
                for (int n = 0; n < 2; ++n) acc[a][b][m][n] = (f32x4){0.f, 0.f, 0.f, 0.f};
    bf16x8 At[4][2], B0[2][2], B1[2][2];
    const char* cA = (const char*)(cur.sel ? S.A1 : S.A0) + (size_t)cur.pm * tstep; const char* cB = (const char*)(cur.sel ? S.B1 : S.B0) + (size_t)cur.pn * tstep;
    PG8_STAGE(PG8_SB(0, 0), cB, voffB); PG8_STAGE(PG8_SA(0, 0), cA, voffA); PG8_STAGE(PG8_SB(0, 1), cB + hstep, voffB); PG8_STAGE(PG8_SA(0, 1), cA + hstep, voffA);
    if (wr == 1) PG8_BAR;
    PG8_WAIT_V(4); PG8_BAR;
    PG8_STAGE(PG8_SB(1, 0), cB + kstep, voffB); PG8_STAGE(PG8_SA(1, 0), cA + kstep, voffA); PG8_STAGE(PG8_SB(1, 1), cB + hstep + kstep, voffB);
    PG8_WAIT_V(6); PG8_BAR;
    for (;;) {
        const bool has_next = S.next(ui + 1, nxt);
        const char* nA = has_next ? (const char*)(nxt.sel ? S.A1 : S.A0) + (size_t)nxt.pm * tstep : cA; const char* nB = has_next ? (const char*)(nxt.sel ? S.B1 : S.B0) + (size_t)nxt.pn * tstep : cB;
        for (int t = 0; t < nt; t += 2) {
            const bool last = (t == nt - 2);
            const char* a1 = cA + (size_t)(t + 1) * kstep;
            const char* a2 = last ? nA : cA + (size_t)(t + 2) * kstep; const char* b2 = last ? nB : cB + (size_t)(t + 2) * kstep;
            const char* a3 = a2 + kstep; const char* b3 = b2 + kstep;
            PG8_LDB(B0, 0, 0); PG8_SCHED; PG8_LDA(At, 0, 0); PG8_STAGE(PG8_SA(1, 1), a1 + hstep, voffA);
            PG8_WAIT_L(8); PG8_BAR; PG8_WAIT_L(0); PG8_MMA(0, 0, At, B0); PG8_BAR; PG8_SCHED;
            PG8_LDB(B1, 0, 1); PG8_STAGE(PG8_SB(0, 0), b2, voffB);
            PG8_BAR; PG8_WAIT_L(0); PG8_MMA(0, 1, At, B1); PG8_BAR;
            PG8_LDA(At, 0, 1); PG8_STAGE(PG8_SA(0, 0), a2, voffA);
            PG8_BAR; PG8_WAIT_L(0); PG8_MMA(1, 0, At, B0); PG8_BAR; PG8_SCHED;
            PG8_STAGE(PG8_SB(0, 1), b2 + hstep, voffB);
            PG8_WAIT_V(6); PG8_BAR; PG8_MMA(1, 1, At, B1); PG8_BAR;
            PG8_LDB(B0, 1, 0); PG8_SCHED; PG8_LDA(At, 1, 0); PG8_STAGE(PG8_SA(0, 1), a2 + hstep, voffA);
            PG8_WAIT_L(8); PG8_BAR; PG8_WAIT_L(0); PG8_MMA(0, 0, At, B0); PG8_BAR; PG8_SCHED;
            PG8_LDB(B1, 1, 1); PG8_STAGE(PG8_SB(1, 0), b3, voffB);
            PG8_BAR; PG8_WAIT_L(0); PG8_MMA(0, 1, At, B1); PG8_BAR;
            PG8_LDA(At, 1, 1); PG8_STAGE(PG8_SA(1, 0), a3, voffA);
            PG8_BAR; PG8_WAIT_L(0); PG8_MMA(1, 0, At, B0); PG8_BAR; PG8_SCHED;
            PG8_STAGE(PG8_SB(1, 1), b3 + hstep, voffB);
            PG8_WAIT_V(6); PG8_BAR; PG8_MMA(1, 1, At, B1); PG8_BAR;
        }
        E(acc, cur, wr, wc, fr, fq, ssv);
        if (!has_next) break;
        if (!E.keep(cur)) {
#pragma unroll
            for (int a = 0; a < 2; ++a)
#pragma unroll
                for (int b = 0; b < 2; ++b)
#pragma unroll
                    for (int m = 0; m < 4; ++m)
#pragma unroll
                        for (int n = 0; n < 2; ++n) acc[a][b][m][n] = (f32x4){0.f, 0.f, 0.f, 0.f};
        }
        cur = nxt; cA = nA; cB = nB; ++ui;
        E.pre(cur, wr, fr, ssv);
    }
    PG8_WAIT_V(0);
    if (wr == 0) PG8_BAR;
    PG8_BAR;
#undef PG8_SA
#undef PG8_SB
#undef PG8_STAGE
#undef PG8_LDA
#undef PG8_LDB
#undef PG8_MMA
#undef PG8_WAIT_V
#undef PG8_WAIT_L
#undef PG8_BAR
#undef PG8_SCHED
}
}
using pg8::Unit;
typedef f32x4 Acc[2][2][4][2];

struct EpiGU {
    static constexpr bool PERM = true;
    bf16_t* O; const float* ss;
    __device__ __forceinline__ void pre(const Unit& u, int wr, int fr, float (&ssv)[8]) const {
#pragma unroll
        for (int ai = 0; ai < 2; ++ai)
#pragma unroll
            for (int m = 0; m < 4; ++m) ssv[ai * 4 + m] = ss[u.pm * 256 + ai * 128 + wr * 64 + m * 16 + fr];
    }
    __device__ __forceinline__ bool keep(const Unit&) const { return false; }
    __device__ __forceinline__ void operator()(Acc& acc, const Unit& u, int wr, int wc, int fr, int fq, const float (&ssv)[8]) const {
        const int row0 = u.pm * 256 + wr * 64 + fr, col0 = u.pn * 128 + wc * 32 + 8 * fq;
#pragma unroll
        for (int ai = 0; ai < 2; ++ai)
#pragma unroll
            for (int m = 0; m < 4; ++m) {
                const int row = row0 + ai * 128 + m * 16;
                const float rs = rsqrtf(ssv[ai * 4 + m] * (1.f / D) + EPS);
                const float rs2 = rs * rs, nrl = -1.4426950408889634f * rs;
                float o[8];
#pragma unroll
                for (int n = 0; n < 2; ++n)
#pragma unroll
                    for (int j = 0; j < 4; j += 2) {
                        typedef float f32x2v __attribute__((ext_vector_type(2)));
                        const f32x2v g = {acc[ai][0][m][n][j], acc[ai][0][m][n][j + 1]}, uu = {acc[ai][1][m][n][j], acc[ai][1][m][n][j + 1]};
                        const f32x2v t = g * nrl, p = (g * uu) * rs2;
                        f32x2v d; d.x = __builtin_amdgcn_exp2f(t.x); d.y = __builtin_amdgcn_exp2f(t.y); d = d + 1.0f;
                        f32x2v r; r.x = __builtin_amdgcn_rcpf(d.x); r.y = __builtin_amdgcn_rcpf(d.y);
                        const f32x2v q = p * r; o[n * 4 + j] = q.x; o[n * 4 + j + 1] = q.y;
                    }
                *(u32x4*)(O + (size_t)row * FF + col0) = pack8f(o);
            }
    }
};
struct EpiRes {
    static constexpr bool PERM = false;
    const float* base; float* out; bf16_t* ob; float* ssn; float scale;
    __device__ __forceinline__ void pre(const Unit&, int, int, float (&ssv)[8]) const {
#pragma unroll
        for (int i = 0; i < 8; ++i) ssv[i] = 0.f; }
    __device__ __forceinline__ bool keep(const Unit&) const { return false; }
    __device__ __forceinline__ void operator()(Acc& acc, const Unit& u, int wr, int wc, int fr, int fq, const float (&ssv)[8]) const {
        const int row0 = u.pm * 256 + wr * 64 + fr, col0 = u.pn * 256 + wc * 32 + 4 * fq;
#pragma unroll
        for (int ai = 0; ai < 2; ++ai) {
            f32x4 b[4][2][2];
#pragma unroll
            for (int m = 0; m < 4; ++m)
#pragma unroll
                for (int bj = 0; bj < 2; ++bj)
#pragma unroll
                    for (int n = 0; n < 2; ++n) b[m][bj][n] = *(const f32x4*)(base + (size_t)(row0 + ai * 128 + m * 16) * D + col0 + bj * 128 + n * 16);
#pragma unroll
            for (int m = 0; m < 4; ++m) {
                const int row = row0 + ai * 128 + m * 16; float sq = 0.f;
#pragma unroll
                for (int bj = 0; bj < 2; ++bj)
#pragma unroll
                    for (int n = 0; n < 2; ++n) {
                        const size_t off = (size_t)row * D + col0 + bj * 128 + n * 16;
                        const f32x4 v = b[m][bj][n] + acc[ai][bj][m][n] * scale;
                        *(f32x4*)(out + off) = v;
                        sq += (v[0] * v[0] + v[1] * v[1]) + (v[2] * v[2] + v[3] * v[3]);
                        u32x2 w; w.x = pk2(v[0], v[1]); w.y = pk2(v[2], v[3]);
                        *(u32x2*)(ob + off) = w;
                    }
                sq += __shfl_xor(sq, 16); sq += __shfl_xor(sq, 32);
                if (fq == 0) unsafeAtomicAdd(ssn + row, sq);
            }
        }
    }
};
struct EpiProj {
    static constexpr bool PERM = true;
    bf16_t* O; const float* ss;
    __device__ __forceinline__ void pre(const Unit& u, int wr, int fr, float (&ssv)[8]) const {
#pragma unroll
        for (int ai = 0; ai < 2; ++ai)
#pragma unroll
            for (int m = 0; m < 4; ++m) ssv[ai * 4 + m] = ss[u.pm * 256 + ai * 128 + wr * 64 + m * 16 + fr];
    }
    __device__ __forceinline__ bool keep(const Unit&) const { return false; }
    __device__ __forceinline__ void operator()(Acc& acc, const Unit& u, int wr, int wc, int fr, int fq, const float (&ssv)[8]) const {
        const int row0 = u.pm * 256 + wr * 64 + fr, col0 = u.pn * 256 + wc * 32 + 8 * fq;
#pragma unroll
        for (int ai = 0; ai < 2; ++ai)
#pragma unroll
            for (int m = 0; m < 4; ++m) {
                const int row = row0 + ai * 128 + m * 16;
                const float rs = rsqrtf(ssv[ai * 4 + m] * (1.f / D) + EPS);
#pragma unroll
                for (int bj = 0; bj < 2; ++bj) {
                    float o[8];
#pragma unroll
                    for (int n = 0; n < 2; ++n)
#pragma unroll
                        for (int j = 0; j < 4; ++j) o[n * 4 + j] = acc[ai][bj][m][n][j] * rs;
                    *(u32x4*)(O + (size_t)row * NIN + col0 + bj * 128) = pack8f(o);
                }
            }
    }
};
struct EpiMix {
    static constexpr bool PERM = true;
    const bf16_t* proj; bf16_t* O;
    __device__ __forceinline__ void pre(const Unit&, int, int, float (&ssv)[8]) const {
#pragma unroll
        for (int i = 0; i < 8; ++i) ssv[i] = 0.f; }
    __device__ __forceinline__ bool keep(const Unit& u) const { return u.sel == 0; }
    __device__ __forceinline__ void operator()(Acc& acc, const Unit& u, int wr, int wc, int fr, int fq, const float (&ssv)[8]) const {
        const int row0 = u.pm * 256 + wr * 64 + fr, col0 = u.pn * 256 + wc * 32 + 8 * fq;
#pragma unroll
        for (int ai = 0; ai < 2; ++ai) {
            u32x4 rga[4][2], rgb[4][2];
#pragma unroll
            for (int m = 0; m < 4; ++m)
#pragma unroll
                for (int bj = 0; bj < 2; ++bj) { const size_t o = (size_t)(row0 + ai * 128 + m * 16) * NIN + col0 + bj * 128;
                    rga[m][bj] = *(const u32x4*)(proj + o + C_GA); rgb[m][bj] = *(const u32x4*)(proj + o + C_GB); }
#pragma unroll
            for (int m = 0; m < 4; ++m) {
                const int row = row0 + ai * 128 + m * 16;
#pragma unroll
                for (int bj = 0; bj < 2; ++bj) {
                    const int col = col0 + bj * 128;
                    float ga[8], gb[8];
                    unpack8(rga[m][bj], ga);
                    unpack8(rgb[m][bj], gb);
                    if (u.sel == 0) {
#pragma unroll
                        for (int n = 0; n < 2; ++n)
#pragma unroll
                            for (int j = 0; j < 4; ++j) acc[ai][bj][m][n][j] *= (1.f + __expf(-gb[n * 4 + j])) * __builtin_amdgcn_rcpf(1.f + __expf(-ga[n * 4 + j]));
                    } else {
                        float o[8];
#pragma unroll
                        for (int n = 0; n < 2; ++n)
#pragma unroll
                            for (int j = 0; j < 4; ++j) o[n * 4 + j] = acc[ai][bj][m][n][j] * sigmoidf_(gb[n * 4 + j]);
                        *(u32x4*)(O + (size_t)row * D + col) = pack8f(o);
                    }
                }
            }
        }
    }
};
struct EpiF32 {
    static constexpr bool PERM = false;
    float* C;
    __device__ __forceinline__ void pre(const Unit&, int, int, float (&ssv)[8]) const {
#pragma unroll
        for (int i = 0; i < 8; ++i) ssv[i] = 0.f; }
    __device__ __forceinline__ bool keep(const Unit&) const { return false; }
    __device__ __forceinline__ void operator()(Acc& acc, const Unit& u, int wr, int wc, int fr, int fq, const float (&ssv)[8]) const {
        const int row0 = u.pm * 256 + wr * 64 + fr, col0 = u.pn * 256 + wc * 32 + 4 * fq;
#pragma unroll
        for (int ai = 0; ai < 2; ++ai)
#pragma unroll
            for (int m = 0; m < 4; ++m)
#pragma unroll
                for (int bj = 0; bj < 2; ++bj)
#pragma unroll
                    for (int n = 0; n < 2; ++n) *(f32x4*)(C + (size_t)(row0 + ai * 128 + m * 16) * D + col0 + bj * 128 + n * 16) = acc[ai][bj][m][n];
    }
};
struct EpiPle {
    static constexpr bool PERM = false;
    float* out; const float* R; const float* ss;
    __device__ __forceinline__ void pre(const Unit& u, int wr, int fr, float (&ssv)[8]) const {
#pragma unroll
        for (int ai = 0; ai < 2; ++ai)
#pragma unroll
            for (int m = 0; m < 4; ++m) ssv[ai * 4 + m] = ss[u.pm * 256 + ai * 128 + wr * 64 + m * 16 + fr];
    }
    __device__ __forceinline__ bool keep(const Unit&) const { return false; }
    __device__ __forceinline__ void operator()(Acc& acc, const Unit& u, int wr, int wc, int fr, int fq, const float (&ssv)[8]) const {
        const int row0 = u.pm * 256 + wr * 64 + fr, col0 = u.pn * 256 + wc * 32 + 4 * fq;
#pragma unroll
        for (int ai = 0; ai < 2; ++ai)
#pragma unroll
            for (int mp = 0; mp < 2; ++mp) {
                f32x4 bb[2][2][2], rr[2][2][2];
#pragma unroll
                for (int mm = 0; mm < 2; ++mm)
#pragma unroll
                    for (int bj = 0; bj < 2; ++bj)
#pragma unroll
                        for (int n = 0; n < 2; ++n) { const size_t off = (size_t)(row0 + ai * 128 + (2 * mp + mm) * 16) * D + col0 + bj * 128 + n * 16;
                            bb[mm][bj][n] = *(const f32x4*)(out + off); rr[mm][bj][n] = *(const f32x4*)(R + off); }
#pragma unroll
                for (int mm = 0; mm < 2; ++mm) {
                    const int m = 2 * mp + mm, row = row0 + ai * 128 + m * 16;
                    const float rs = rsqrtf(ssv[ai * 4 + m] * (1.f / D) + EPS);
#pragma unroll
                    for (int bj = 0; bj < 2; ++bj)
#pragma unroll
                        for (int n = 0; n < 2; ++n) {
                            const size_t off = (size_t)row * D + col0 + bj * 128 + n * 16;
                            f32x4 v;
#pragma unroll
                            for (int j = 0; j < 4; ++j) v[j] = bb[mm][bj][n][j] + sigmoidf_(acc[ai][bj][m][n][j] * rs) * rr[mm][bj][n][j];
                            *(f32x4*)(out + off) = v;
                        }
                }
            }
    }
};

struct Params {
    const float *x, *p, *ffn1_norm, *ffn1_w_gu, *ffn1_w_down, *mix_norm, *w_in, *conv_w, *a_log, *dt_bias, *gdn_norm, *q_norm, *k_norm, *rel_bias,
                *w_a, *w_b, *w_out, *ffn2_norm, *ffn2_w_gu, *ffn2_w_down, *ple_norm, *ple_gate, *ple_proj;
    float* out; unsigned char* ws; int ph_lo, ph_hi;
};

template <int MAP> __device__ __forceinline__ int src_col(int n) {
    if (MAP == 1) return ((n >> 7) & 1) * FF + (n >> 8) * 128 + (n & 127);
    if (MAP == 2) return n < 4096 ? n : (n < 11264 ? n + 16 : (n < 11280 ? n - 11264 + 4096 : -1));
    return n;
}
template <int MAP> __device__ __forceinline__ void transpose_item(const float* W, const float* nw, int K, int Nsrc, int Nd, bf16_t* WT, LAS float* scr, int item, int lane) {
    const int nblk = Nd / 64, kb = item / nblk, nb = item % nblk, k0 = 64 * kb, n0 = 64 * nb;
    const int r = lane >> 4, c4 = lane & 15;
    const int sc = src_col<MAP>(n0 + 4 * c4);
    f32x4 v[16];
#pragma unroll
    for (int i = 0; i < 16; ++i) v[i] = sc >= 0 ? __builtin_nontemporal_load((const f32x4*)(W + (size_t)(k0 + 4 * i + r) * Nsrc + sc)) : (f32x4){0.f, 0.f, 0.f, 0.f};
    if (nw) {
#pragma unroll
        for (int i = 0; i < 16; ++i) v[i] = v[i] * nw[k0 + 4 * i + r];
    }
#pragma unroll
    for (int i = 0; i < 16; ++i) { LAS float* p = scr + (4 * i + r) * 65 + 4 * c4; p[0] = v[i][0]; p[1] = v[i][1]; p[2] = v[i][2]; p[3] = v[i][3]; }
    asm volatile("s_waitcnt lgkmcnt(0)" ::: "memory"); __builtin_amdgcn_wave_barrier();
    const int ns = lane >> 3, kc = lane & 7;
#pragma unroll
    for (int j = 0; j < 8; ++j) { const LAS float* sp = scr + (8 * kc) * 65 + 8 * j + ns;
        u32x4 o; o.x = pk2(sp[0 * 65], sp[1 * 65]); o.y = pk2(sp[2 * 65], sp[3 * 65]); o.z = pk2(sp[4 * 65], sp[5 * 65]); o.w = pk2(sp[6 * 65], sp[7 * 65]);
        *(u32x4*)(WT + (size_t)(n0 + 8 * j + ns) * K + k0 + 8 * kc) = o; }
    asm volatile("s_waitcnt lgkmcnt(0)" ::: "memory"); __builtin_amdgcn_wave_barrier();
}
constexpr int I_GU = (D / 64) * (NGU / 64), I_DN = (FF / 64) * (D / 64), I_IN = (D / 64) * (NIN / 64), I_AB = (1024 / 64) * (D / 64), I_SQ = (D / 64) * (D / 64), I_PP = (PLE / 64) * (D / 64);
constexpr int N_EARLY = I_GU + I_DN + I_IN, N_LATE = I_GU + I_DN + 2 * I_AB + 2 * I_SQ + I_PP;
__device__ __forceinline__ void convert_early(const Params& P, LAS float* scr, int gw, int NGW, int lane, bool with_d1) {
    unsigned char* ws = P.ws;
    for (int it = gw; it < I_GU + I_IN + (with_d1 ? I_DN : 0); it += NGW) {
        int r = it;
        if (r < I_GU) { transpose_item<1>(P.ffn1_w_gu, P.ffn1_norm, D, NGU, NGU, (bf16_t*)(ws + WS_WGU1), scr, r, lane); continue; } r -= I_GU;
        if (r < I_IN) { transpose_item<2>(P.w_in, P.mix_norm, D, NINSRC, NIN, (bf16_t*)(ws + WS_WIN), scr, r, lane); continue; } r -= I_IN;
        transpose_item<0>(P.ffn1_w_down, nullptr, FF, D, D, (bf16_t*)(ws + WS_WD1), scr, r, lane);
    }
}
__device__ __forceinline__ void convert_d1(const Params& P, LAS float* scr, int gw, int NGW, int lane) {
    for (int it = gw; it < I_DN; it += NGW) transpose_item<0>(P.ffn1_w_down, nullptr, FF, D, D, (bf16_t*)(P.ws + WS_WD1), scr, it, lane);
}
__device__ __forceinline__ void convert_late(const Params& P, LAS float* scr, int lo_it, int hi_it, int gw, int NGW, int lane) {
    unsigned char* ws = P.ws;
    for (int it = lo_it + gw; it < hi_it; it += NGW) {
        int r = it;
        if (r < I_AB) { transpose_item<0>(P.w_a, nullptr, 1024, D, D, (bf16_t*)(ws + WS_WA), scr, r, lane); continue; } r -= I_AB;
        if (r < I_AB) { transpose_item<0>(P.w_b, nullptr, 1024, D, D, (bf16_t*)(ws + WS_WB), scr, r, lane); continue; } r -= I_AB;
        if (r < I_SQ) { transpose_item<0>(P.w_out, nullptr, D, D, D, (bf16_t*)(ws + WS_WOUT), scr, r, lane); continue; } r -= I_SQ;
        if (r < I_GU) { transpose_item<1>(P.ffn2_w_gu, P.ffn2_norm, D, NGU, NGU, (bf16_t*)(ws + WS_WGU2), scr, r, lane); continue; } r -= I_GU;
        if (r < I_DN) { transpose_item<0>(P.ffn2_w_down, nullptr, FF, D, D, (bf16_t*)(ws + WS_WD2), scr, r, lane); continue; } r -= I_DN;
        if (r < I_SQ) { transpose_item<0>(P.ple_gate, P.ple_norm, D, D, D, (bf16_t*)(ws + WS_WPG), scr, r, lane); continue; } r -= I_SQ;
        transpose_item<0>(P.ple_proj, nullptr, PLE, D, D, (bf16_t*)(ws + WS_WPP), scr, r, lane);
    }
}
constexpr int LATE_A = 2800, LATE_C = 2 * I_AB + I_SQ + I_GU;
__device__ __forceinline__ void idle_convert(const Params& P, LAS unsigned char* lds, int nwg, int G, int lo_it, int hi_it) {
    const int extra = nwg % G, c = blockIdx.x;
    if (extra == 0 || c < extra) return;
    const int tid = opaque_tid(), wave = tid >> 6;
    if (lo_it < 0) convert_d1(P, (LAS float*)(lds + wave * 17408), (c - extra) * 8 + wave, (G - extra) * 8, tid & 63);
    else convert_late(P, (LAS float*)(lds + wave * 17408), lo_it, hi_it, (c - extra) * 8 + wave, (G - extra) * 8, tid & 63);
}
__device__ __forceinline__ void phase_convert(const Params& P, LAS unsigned char* lds, int G) {
    const int tid = opaque_tid(), lane = tid & 63, wave = tid >> 6;
    LAS float* scr = (LAS float*)(lds + wave * 17408);
    const int gw = blockIdx.x * 8 + wave, NGW = G * 8;
    unsigned char* ws = P.ws;
    convert_early(P, scr, gw, NGW, lane, (((M / 256) * (NGU / 256)) % G) == 0);
    float* ss = (float*)(ws + WS_SS);
    bf16_t* xb = (bf16_t*)(ws + WS_XB); bf16_t* pb = (bf16_t*)(ws + WS_PB);
    for (int m0 = gw; m0 < M; m0 += 2 * NGW) {
        f32x4 xv[2][8], pv[2];
#pragma unroll
        for (int q = 0; q < 2; ++q) { const int m = m0 + q * NGW; if (m < M) {
            const f32x4* xr = (const f32x4*)(P.x + (size_t)m * D) + lane;
#pragma unroll
            for (int j = 0; j < 8; ++j) xv[q][j] = __builtin_nontemporal_load(xr + 64 * j);
            pv[q] = __builtin_nontemporal_load((const f32x4*)(P.p + (size_t)m * PLE) + lane); } }
#pragma unroll
        for (int q = 0; q < 2; ++q) { const int m = m0 + q * NGW; if (m < M) {
            u32x2* o8 = (u32x2*)(xb + (size_t)m * D) + lane; float s = 0.f;
#pragma unroll
            for (int j = 0; j < 8; ++j) { const f32x4 v = xv[q][j]; s += (v[0] * v[0] + v[1] * v[1]) + (v[2] * v[2] + v[3] * v[3]); u32x2 w; w.x = pk2(v[0], v[1]); w.y = pk2(v[2], v[3]); o8[64 * j] = w; }
            s = wave_sum(s); if (lane == 0) ss[m] = s;
            u32x2 w; w.x = pk2(pv[q][0], pv[q][1]); w.y = pk2(pv[q][2], pv[q][3]); *((u32x2*)(pb + (size_t)m * PLE) + lane) = w; } }
    }
    for (int i = blockIdx.x * 512 + tid; i < 3 * M; i += G * 512) ss[M + i] = 0.f;
    if (blockIdx.x == 0 && tid < 8) ((unsigned*)(ws + WS_PROG))[tid * 32] = 0u;
}

constexpr int L_LM = 0, L_GC = L_LM + 64 * 68 * 4, L_R = L_GC + 512, L_KBF = L_R + 65536, L_QBF = L_KBF + 64 * 136 * 2, L_VST = L_QBF + 64 * 136 * 2, L_END4 = L_VST + 64 * 136 * 2;
static_assert(L_END4 <= LDS_BYTES, "lds");
__device__ __forceinline__ void prep_item(const Params& P, LAS unsigned char* lds, int item, const int pflags) {
    const int tid = opaque_tid(), lane = tid & 63, wave = tid >> 6;
    const int n = item >> 3, h = item & 7;
    unsigned char* ws = P.ws;
    bf16_t* proj = (bf16_t*)(ws + WS_PROJ);
    LAS float* Rr = (LAS float*)(lds + L_R); LAS float* Lm = (LAS float*)(lds + L_LM);
    LAS bf16_t* kbf = (LAS bf16_t*)(lds + L_KBF); LAS bf16_t* qbf = (LAS bf16_t*)(lds + L_QBF); LAS bf16_t* vst = (LAS bf16_t*)(lds + L_VST);
    LAS float* gcs = (LAS float*)(lds + L_GC);
    const int l16 = tid & 15, rg = tid >> 4;
    float qv[2][8], kv[2][8], vv[2][8];
    u32x4 rawx[3][5];
#pragma unroll
    for (int X = 0; X < 3; ++X)
#pragma unroll
        for (int i = 0; i < 5; ++i) { const int gr = n * 64 + 2 * rg - 3 + i; const int colx = (X == 0 ? C_QA : (X == 1 ? C_KA : C_VA)) + h * DH + 8 * l16;
            rawx[X][i] = gr >= 0 ? __builtin_nontemporal_load((const u32x4*)(proj + (size_t)gr * NIN + colx)) : (u32x4){0u, 0u, 0u, 0u}; }
    if (wave == 0) {
        const size_t row = (size_t)n * 64 + lane;
        const float a = bf2f(proj[row * NIN + C_AR + h]), b = bf2f(proj[row * NIN + C_BR + h]);
        const float xx = a + P.dt_bias[h];
        const float sp = xx > 20.f ? xx : log1pf(expf(xx));
        float g = -expf(P.a_log[h]) * sp;
#pragma unroll
        for (int o = 1; o < 64; o <<= 1) { const float t = __shfl_up(g, o); if (lane >= o) g += t; }
        gcs[lane] = g; gcs[64 + lane] = 1.f / (1.f + expf(-b));
    }
#pragma unroll
    for (int X = 0; X < 3; ++X) {
        const int col = (X == 0 ? C_QA : (X == 1 ? C_KA : C_VA)) + h * DH + 8 * l16;
        const int ccol = X * 1024 + h * DH + 8 * l16;
        float xin[5][8];
#pragma unroll
        for (int i = 0; i < 5; ++i) unpack8(rawx[X][i], xin[i]);
        float y[2][8];
#pragma unroll
        for (int r = 0; r < 2; ++r)
#pragma unroll
            for (int e = 0; e < 8; ++e) y[r][e] = 0.f;
#pragma unroll
        for (int j = 0; j < 4; ++j) {
            const f32x4 c0 = *(const f32x4*)(P.conv_w + j * 3072 + ccol), c1 = *(const f32x4*)(P.conv_w + j * 3072 + ccol + 4);
#pragma unroll
            for (int r = 0; r < 2; ++r)
#pragma unroll
                for (int e = 0; e < 8; ++e) y[r][e] += (e < 4 ? c0[e] : c1[e - 4]) * xin[r + j][e];
        }
#pragma unroll
        for (int r = 0; r < 2; ++r) {
            float sq = 0.f;
#pragma unroll
            for (int e = 0; e < 8; ++e) { y[r][e] = siluf_(y[r][e]); sq += y[r][e] * y[r][e]; }
            if (X < 2) {
                sq += __shfl_xor(sq, 1); sq += __shfl_xor(sq, 2); sq += __shfl_xor(sq, 4); sq += __shfl_xor(sq, 8);
                const float rn = rsqrtf(sq + EPS) * (X == 0 ? 0.08838834764831845f : 1.f);
#pragma unroll
                for (int e = 0; e < 8; ++e) y[r][e] *= rn;
            }
#pragma unroll
            for (int e = 0; e < 8; ++e) { if (X == 0) qv[r][e] = y[r][e]; else if (X == 1) kv[r][e] = y[r][e]; else vv[r][e] = y[r][e]; }
        }
    }
    {
        u32x4 raw[2][3]; f32x4 gw[2][2];
#pragma unroll
        for (int r = 0; r < 2; ++r) { const size_t grow = (size_t)n * 64 + 2 * rg + r;
            raw[r][0] = __builtin_nontemporal_load((const u32x4*)(proj + grow * NIN + C_QB + h * DH + 8 * l16));
            raw[r][1] = __builtin_nontemporal_load((const u32x4*)(proj + grow * NIN + C_KB + h * DH + 8 * l16));
            raw[r][2] = __builtin_nontemporal_load((const u32x4*)(proj + grow * NIN + C_VB + h * DH + 8 * l16)); }
#pragma unroll
        for (int X = 0; X < 2; ++X) { const float* nwp = (X == 0 ? P.q_norm : P.k_norm) + 8 * l16; gw[X][0] = *(const f32x4*)nwp; gw[X][1] = *(const f32x4*)(nwp + 4); }
#pragma unroll
        for (int r = 0; r < 2; ++r) {
            const size_t grow = (size_t)n * 64 + 2 * rg + r;
#pragma unroll
            for (int X = 0; X < 2; ++X) {
                bf16_t* ptr = proj + grow * NIN + (X == 0 ? C_QB : C_KB) + h * DH + 8 * l16;
                float f[8]; unpack8(raw[r][X], f);
                float sq = 0.f;
#pragma unroll
                for (int e = 0; e < 8; ++e) sq += f[e] * f[e];
                sq += __shfl_xor(sq, 1); sq += __shfl_xor(sq, 2); sq += __shfl_xor(sq, 4); sq += __shfl_xor(sq, 8);
                const float rn = rsqrtf(sq * (1.f / DH) + EPS);
#pragma unroll
                for (int e = 0; e < 8; ++e) f[e] = f[e] * rn * (e < 4 ? gw[X][0][e] : gw[X][1][e - 4]);
                *(u32x4*)ptr = pack8f(f);
            }
            *(LAS u32x4*)(vst + (2 * rg + r) * 136 + 8 * l16) = raw[r][2];
        }
    }
    __syncthreads();
    {
        bf16_t* qd = (bf16_t*)(ws + WS_QD) + (size_t)item * 64 * 128;
        bf16_t* ktT = (bf16_t*)(ws + WS_KTT) + (size_t)item * 128 * 64;
        const float gl = gcs[63];
        float ktl[2][8];
#pragma unroll
        for (int r = 0; r < 2; ++r) {
            const int t = 2 * rg + r; const float gc = gcs[t], bt = gcs[64 + t];
            const float eg = __expf(gc), egl = __expf(gl - gc);
            float f[8];
#pragma unroll
            for (int e = 0; e < 8; ++e) f[e] = qv[r][e] * eg;
            *(u32x4*)(qd + ((((t >> 4) * 4 + (l16 >> 2)) * 64) + (l16 & 3) * 16 + (t & 15)) * 8) = pack8f(f);
#pragma unroll
            for (int e = 0; e < 8; ++e) ktl[r][e] = kv[r][e] * egl;
            *(LAS u32x4*)(qbf + t * 136 + 8 * l16) = pack8f(qv[r]);
            *(LAS u32x4*)(kbf + t * 136 + 8 * l16) = pack8f(kv[r]);
            LAS float* rr = Rr + t * 256 + 8 * l16;
            *(LAS f32x4*)(rr) = (f32x4){vv[r][0] * bt, vv[r][1] * bt, vv[r][2] * bt, vv[r][3] * bt};
            *(LAS f32x4*)(rr + 4) = (f32x4){vv[r][4] * bt, vv[r][5] * bt, vv[r][6] * bt, vv[r][7] * bt};
            const float be = bt * eg;
            *(LAS f32x4*)(rr + 128) = (f32x4){kv[r][0] * be, kv[r][1] * be, kv[r][2] * be, kv[r][3] * be};
            *(LAS f32x4*)(rr + 132) = (f32x4){kv[r][4] * be, kv[r][5] * be, kv[r][6] * be, kv[r][7] * be};
        }
#pragma unroll
        for (int e = 0; e < 8; ++e) { const int t0 = 2 * rg; *(unsigned*)(ktT + (((((l16 >> 1) * 2 + (t0 >> 5)) * 64) + ((t0 >> 3) & 3) * 16 + 8 * (l16 & 1) + e) * 8 + (t0 & 7))) = pk2(ktl[0][e], ktl[1][e]); }
        if (tid == 0) ((float*)(ws + WS_TAIL))[item] = __expf(gl);
        bf16_t* vt = (bf16_t*)(ws + WS_VT);
        const int d = tid & 127, tg = tid >> 7;
        unsigned pw[8];
#pragma unroll
        for (int i = 0; i < 8; ++i) { const unsigned lo = vst[(16 * tg + 2 * i) * 136 + d], hi = vst[(16 * tg + 2 * i + 1) * 136 + d]; pw[i] = lo | (hi << 16); }
        bf16_t* dst = vt + (size_t)(h * DH + d) * M + n * 64 + 16 * tg;
        *(u32x4*)dst = (u32x4){pw[0], pw[1], pw[2], pw[3]}; *(u32x4*)(dst + 8) = (u32x4){pw[4], pw[5], pw[6], pw[7]};
    }
    __syncthreads();
    {
        const int fr = lane & 15, fq = lane >> 4, which = wave >> 2, ti = wave & 3;
        LAS bf16_t* X = which ? qbf : kbf;
        bf16x8 a[4];
#pragma unroll
        for (int s = 0; s < 4; ++s) a[s] = *(const LAS bf16x8*)(X + (16 * ti + fr) * 136 + 32 * s + 8 * fq);
        bf16_t* aqk = (bf16_t*)(ws + WS_AQK) + (size_t)item * 64 * 64;
        for (int tj = 0; tj < 4; ++tj) {
            f32x4 c = {0.f, 0.f, 0.f, 0.f};
            if (tj <= ti) {
#pragma unroll
                for (int s = 0; s < 4; ++s) { const bf16x8 b = *(const LAS bf16x8*)(kbf + (16 * tj + fr) * 136 + 32 * s + 8 * fq); c = MFMA16(a[s], b, c); }
            }
            const int j = 16 * tj + fr; const float gj = gcs[j];
#pragma unroll
            for (int r = 0; r < 4; ++r) {
                const int i = 16 * ti + 4 * fq + r;
                const float dec = (i >= j) ? __expf(gcs[i] - gj) : 0.f;
                if (which == 0) { Lm[i * 68 + j] = (i > j) ? gcs[64 + i] * c[r] * dec : 0.f; }
                else { const float v = (i >= j) ? c[r] * dec : 0.f; aqk[((((i >> 4) * 2 + (j >> 5)) * 64) + ((j >> 3) & 3) * 16 + (i & 15)) * 8 + (j & 7)] = (bf16_t)(pk2(v, 0.f) & 0xffffu); }
            }
        }
    }
    __syncthreads();
    if (tid < 256) {
        int Lrow[64];
#pragma unroll
        for (int i = 0; i < 64; ++i) Lrow[i] = __float_as_int(Lm[i * 68 + lane]);
        float s[64];
#define LRD(i, j) __int_as_float(__builtin_amdgcn_readlane(Lrow[i], j))
#pragma unroll
        for (int g = 0; g < 16; ++g) {
            const int i0 = 4 * g;
            float a0 = Rr[(i0 + 0) * 256 + tid], a1 = Rr[(i0 + 1) * 256 + tid], a2 = Rr[(i0 + 2) * 256 + tid], a3 = Rr[(i0 + 3) * 256 + tid];
            if (!(pflags & 8)) {
#pragma unroll
            for (int j = 0; j < i0; ++j) { const float sj = s[j]; a0 -= LRD(i0, j) * sj; a1 -= LRD(i0 + 1, j) * sj; a2 -= LRD(i0 + 2, j) * sj; a3 -= LRD(i0 + 3, j) * sj; }
            a1 -= LRD(i0 + 1, i0) * a0;
            a2 -= LRD(i0 + 2, i0) * a0; a2 -= LRD(i0 + 2, i0 + 1) * a1;
            a3 -= LRD(i0 + 3, i0) * a0; a3 -= LRD(i0 + 3, i0 + 1) * a1; a3 -= LRD(i0 + 3, i0 + 2) * a2;
            }
            s[i0] = a0; s[i0 + 1] = a1; s[i0 + 2] = a2; s[i0 + 3] = a3;
        }
#undef LRD
        if (pflags & 32) { if (s[63] == 1.2345f) ((float*)(ws + WS_U))[tid] = s[5]; } else
        if (tid < 128) { float* u = (float*)(ws + WS_U) + (size_t)item * 64 * 128 + ((tid >> 4) * 256 + (tid & 15)) * 4;
#pragma unroll
            for (int i4 = 0; i4 < 16; ++i4) *(f32x4*)(u + ((i4 >> 2) * 64 + (i4 & 3) * 16) * 4) = (f32x4){s[4 * i4], s[4 * i4 + 1], s[4 * i4 + 2], s[4 * i4 + 3]}; }
        else { const int dk = tid - 128; bf16_t* w = (bf16_t*)(ws + WS_W) + (size_t)item * 64 * 128 + (((dk >> 5) * 64) + ((dk >> 3) & 3) * 16) * 8 + (dk & 7);
#pragma unroll
            for (int i = 0; i < 64; ++i) w[((i >> 4) * 256 + (i & 15)) * 8] = (bf16_t)(pk2(s[i], 0.f) & 0xffffu); }
    }
    __syncthreads();
}

struct ScanA { bf16x8 W[4], K0[2], K1[2]; f32x4 u; float tl; };
struct ScanB { bf16x8 Q[4], A[2]; };
struct ScanOff { unsigned w, aq, kt, u; };
__device__ __forceinline__ void scan_loadA(ScanA& o, const unsigned char* ws, int c, int h, const ScanOff& f) {
    const int item = c * 8 + h;
    const unsigned char* w = ws + WS_W + (size_t)item * 16384; const unsigned char* kt = ws + WS_KTT + (size_t)item * 16384; const unsigned char* u = ws + WS_U + (size_t)item * 32768;
#pragma unroll
    for (int s = 0; s < 4; ++s) o.W[s] = __builtin_bit_cast(bf16x8, *(const u32x4*)(w + f.w + 1024 * s));
#pragma unroll
    for (int s = 0; s < 2; ++s) { o.K0[s] = __builtin_bit_cast(bf16x8, *(const u32x4*)(kt + f.kt + 1024 * s)); o.K1[s] = __builtin_bit_cast(bf16x8, *(const u32x4*)(kt + f.kt + 2048 + 1024 * s)); }
    o.u = *(const f32x4*)(u + f.u);
    o.tl = ((const float*)(ws + WS_TAIL))[item];
}
__device__ __forceinline__ void scan_loadB(ScanB& o, const unsigned char* ws, int c, int h, const ScanOff& f) {
    const int item = c * 8 + h;
    const unsigned char* qd = ws + WS_QD + (size_t)item * 16384; const unsigned char* aq = ws + WS_AQK + (size_t)item * 8192;
#pragma unroll
    for (int s = 0; s < 4; ++s) o.Q[s] = __builtin_bit_cast(bf16x8, *(const u32x4*)(qd + f.w + 1024 * s));
#pragma unroll
    for (int s = 0; s < 2; ++s) o.A[s] = __builtin_bit_cast(bf16x8, *(const u32x4*)(aq + f.aq + 1024 * s));
}
__device__ __forceinline__ void scan_stepA(const ScanA& cur, f32x4& S0, f32x4& S1, LAS bf16_t* Sl, LAS bf16_t* Vl, int fr, int fq, int mt) {
    f32x4 wsv = {0.f, 0.f, 0.f, 0.f};
#pragma unroll
    for (int s = 0; s < 4; ++s) wsv = MFMA16(cur.W[s], *(const LAS bf16x8*)(Sl + fr * 136 + 32 * s + 8 * fq), wsv);
    const f32x4 vn = cur.u - wsv;
    { u32x2 pv; pv.x = pk2(vn[0], vn[1]); pv.y = pk2(vn[2], vn[3]); *(LAS u32x2*)(Vl + fr * 72 + 16 * mt + 4 * fq) = pv; }
    __syncthreads();
    S0 = S0 * cur.tl; S1 = S1 * cur.tl;
#pragma unroll
    for (int s = 0; s < 2; ++s) { const bf16x8 Vb = *(const LAS bf16x8*)(Vl + fr * 72 + 32 * s + 8 * fq); S0 = MFMA16(cur.K0[s], Vb, S0); S1 = MFMA16(cur.K1[s], Vb, S1); }
    { u32x2 p0, p1; p0.x = pk2(S0[0], S0[1]); p0.y = pk2(S0[2], S0[3]); p1.x = pk2(S1[0], S1[1]); p1.y = pk2(S1[2], S1[3]);
      *(LAS u32x2*)(Sl + fr * 136 + 32 * mt + 4 * fq) = p0; *(LAS u32x2*)(Sl + fr * 136 + 32 * mt + 16 + 4 * fq) = p1; }
    __syncthreads();
}
__device__ __forceinline__ void scan_stepB(const ScanB& cur, const LAS bf16_t* Sl, const LAS bf16_t* Vl, bf16_t* og, int fr, int fq) {
    f32x4 qs = {0.f, 0.f, 0.f, 0.f};
#pragma unroll
    for (int s = 0; s < 4; ++s) qs = MFMA16(*(const LAS bf16x8*)(Sl + fr * 136 + 32 * s + 8 * fq), cur.Q[s], qs);
    __syncthreads();
#pragma unroll
    for (int s = 0; s < 2; ++s) qs = MFMA16(*(const LAS bf16x8*)(Vl + fr * 72 + 32 * s + 8 * fq), cur.A[s], qs);
    { u32x2 w; w.x = pk2(qs[0], qs[1]); w.y = pk2(qs[2], qs[3]); *(u32x2*)og = w; }
    __syncthreads();
}
__device__ __forceinline__ void scan_wg(const Params& P, LAS unsigned char* lds, int h, int pair, const int VAR) {
    const int tid = opaque_tid(), lane = tid & 63, wave = tid >> 6, fr = lane & 15, fq = lane >> 4, mt = wave & 3, e0 = 16 * pair;
    const unsigned char* ws = P.ws;
    LAS bf16_t* Sl = (LAS bf16_t*)(lds);
    LAS bf16_t* Vl = (LAS bf16_t*)(lds + 4352);
    for (int i = tid; i < 4352 / 4; i += 512) ((LAS unsigned*)Sl)[i] = 0u;
    ScanOff f; f.w = (unsigned)(mt * 4096 + lane * 16); f.aq = (unsigned)(mt * 2048 + lane * 16); f.kt = (unsigned)(mt * 4096 + lane * 16); f.u = (unsigned)((((e0 >> 4) * 4 + mt) * 64 + lane) * 16);
    if (wave < 4) {
        f32x4 S0 = {0.f, 0.f, 0.f, 0.f}, S1 = {0.f, 0.f, 0.f, 0.f};
        ScanA a, b, c3; scan_loadA(a, ws, 0, h, f); scan_loadA(b, ws, 1, h, f);
        __syncthreads();
#pragma unroll 1
        for (int c = 0; c < NCH - 2; c += 3) {
            if (VAR != 3) scan_loadA(c3, ws, c + 2, h, f); scan_stepA(a, S0, S1, Sl, Vl, fr, fq, mt);
            if (VAR != 3) scan_loadA(a, ws, c + 3, h, f); scan_stepA(b, S0, S1, Sl, Vl, fr, fq, mt);
            if (VAR != 3) scan_loadA(b, ws, c + 4, h, f); scan_stepA(VAR == 3 ? a : c3, S0, S1, Sl, Vl, fr, fq, mt);
        }
        scan_stepA(a, S0, S1, Sl, Vl, fr, fq, mt); scan_stepA(b, S0, S1, Sl, Vl, fr, fq, mt);
    } else {
        bf16_t* Og = (bf16_t*)(P.ws + (VAR ? WS_END : WS_YA)) + (size_t)(16 * mt + fr) * 1024 + h * DH + e0 + 4 * fq;
        ScanB a, b, c3; scan_loadB(a, ws, 0, h, f); scan_loadB(b, ws, 1, h, f);
        __syncthreads();
#pragma unroll 1
        for (int c = 0; c < NCH - 2; c += 3) {
            if (VAR != 3) scan_loadB(c3, ws, c + 2, h, f); scan_stepB(a, Sl, Vl, Og + (size_t)c * 65536, fr, fq);
            if (VAR != 3) scan_loadB(a, ws, c + 3, h, f); scan_stepB(b, Sl, Vl, Og + (size_t)(c + 1) * 65536, fr, fq);
            if (VAR != 3) scan_loadB(b, ws, c + 4, h, f); scan_stepB(VAR == 3 ? a : c3, Sl, Vl, Og + (size_t)(c + 2) * 65536, fr, fq);
        }
        scan_stepB(a, Sl, Vl, Og + (size_t)(NCH - 2) * 65536, fr, fq); scan_stepB(b, Sl, Vl, Og + (size_t)(NCH - 1) * 65536, fr, fq);
    }
}

__device__ __forceinline__ void scan_helper(const Params& P, int h, int j, int NHp) {
    const int tid = threadIdx.x;
    const unsigned char* ws = P.ws;
    unsigned* prog = (unsigned*)(P.ws + WS_PROG) + h * 32;
    for (int c = j; c < NCH; c += NHp) {
        for (;;) { const unsigned pr = __hip_atomic_load(prog, __ATOMIC_RELAXED, __HIP_MEMORY_SCOPE_AGENT); if ((int)pr + 16 >= c) break; __builtin_amdgcn_s_sleep(16); }
        const int item = c * 8 + h;
        const u32x4* w16 = (const u32x4*)(ws + WS_W + (size_t)item * 16384); const u32x4* q16 = (const u32x4*)(ws + WS_QD + (size_t)item * 16384);
        const u32x4* k16 = (const u32x4*)(ws + WS_KTT + (size_t)item * 16384); const u32x4* a16 = (const u32x4*)(ws + WS_AQK + (size_t)item * 8192);
        const u32x4* u16 = (const u32x4*)(ws + WS_U + (size_t)item * 32768);
        u32x4 v[11];
        v[0] = w16[tid]; v[1] = w16[512 + tid]; v[2] = q16[tid]; v[3] = q16[512 + tid]; v[4] = k16[tid]; v[5] = k16[512 + tid]; v[6] = a16[tid];
        v[7] = u16[tid]; v[8] = u16[512 + tid]; v[9] = u16[1024 + tid]; v[10] = u16[1536 + tid];
#pragma unroll
        for (int i = 0; i < 11; ++i) asm volatile("" :: "v"(v[i]));
    }
}

constexpr int AL_K = 0, AL_V = 2 * 64 * 272, AL_B = AL_V + 2 * 128 * 144;
__device__ __forceinline__ void attn_compute(const LAS unsigned char* Kl, const LAS unsigned char* Vl, const LAS float* biasl, const bf16x8 (&Qb)[4], f32x4 (&Ot)[8], float& mrun, float& lrun,
                                             int c, int qi, int fr, int fq) {
    const float scale = 0.08838834764831845f;
    f32x4 st[4]; float mx = -1e30f;
#pragma unroll
    for (int kt = 0; kt < 4; ++kt) {
        f32x4 a = {0.f, 0.f, 0.f, 0.f};
#pragma unroll
        for (int s = 0; s < 4; ++s) a = MFMA16(*(const LAS bf16x8*)(Kl + (16 * kt + fr) * 272 + 64 * s + 16 * fq), Qb[s], a);
#pragma unroll
        for (int r = 0; r < 4; ++r) {
            const int ki = c * 64 + 16 * kt + 4 * fq + r; int dd = qi - ki; dd = dd < -63 ? -63 : (dd > 128 ? 128 : dd);
            a[r] = a[r] * scale + biasl[dd + 63]; mx = fmaxf(mx, a[r]);
        }
        st[kt] = a;
    }
    mx = fmaxf(mx, __shfl_xor(mx, 16)); mx = fmaxf(mx, __shfl_xor(mx, 32));
    const float mnew = fmaxf(mrun, mx), alpha = __expf(mrun - mnew); mrun = mnew;
    float rsum = 0.f;
#pragma unroll
    for (int kt = 0; kt < 4; ++kt)
#pragma unroll
        for (int r = 0; r < 4; ++r) { const float p = __expf(st[kt][r] - mnew); st[kt][r] = p; rsum += p; }
    lrun = lrun * alpha + rsum;
    bf16x8 Pb[2];
#pragma unroll
    for (int s = 0; s < 2; ++s) Pb[s] = pack_acc(st[2 * s], st[2 * s + 1]);
#pragma unroll
    for (int dt = 0; dt < 8; ++dt) {
        f32x4 o = Ot[dt] * alpha;
#pragma unroll
        for (int s = 0; s < 2; ++s) { const LAS unsigned char* pv = Vl + (16 * dt + fr) * 144 + 64 * s + 8 * fq;
            const u32x2 lo = *(const LAS u32x2*)pv, hi = *(const LAS u32x2*)(pv + 32); u32x4 av; av.x = lo.x; av.y = lo.y; av.z = hi.x; av.w = hi.y;
            o = MFMA16(__builtin_bit_cast(bf16x8, av), Pb[s], o); }
        Ot[dt] = o;
    }
}
__device__ __forceinline__ void attn_item(const Params& P, LAS unsigned char* lds, int m, int h) {
    const int tid = opaque_tid(), lane = tid & 63, wave = tid >> 6, fr = lane & 15, fq = lane >> 4;
    unsigned char* ws = P.ws;
    const bf16_t* proj = (const bf16_t*)(ws + WS_PROJ); const bf16_t* vt = (const bf16_t*)(ws + WS_VT); bf16_t* yb = (bf16_t*)(ws + WS_YB);
    LAS float* biasl = (LAS float*)(lds + AL_B);
    const int nq = 2 * m + (wave >> 2), w4 = wave & 3;
    const int qi = nq * 64 + 16 * w4 + fr;
    const int cbeg = 2 * m - 8 < 0 ? 0 : 2 * m - 8, cend = 2 * m + 1;
    const bf16_t* kg[2]; const bf16_t* vg[2]; int kl[2], vl[2];
#pragma unroll
    for (int i = 0; i < 2; ++i) { const int p = tid + 512 * i;
        kg[i] = proj + (size_t)(p >> 4) * NIN + C_KB + h * DH + 8 * (p & 15); kl[i] = (p >> 4) * 272 + 16 * (p & 15);
        vg[i] = vt + (size_t)(h * DH + (p >> 3)) * M + 8 * (p & 7); vl[i] = (p >> 3) * 144 + 16 * (p & 7); }
#define ATT_LOAD(KR, VR, C) do { _Pragma("unroll") for (int i = 0; i < 2; ++i) { KR[i] = *(const u32x4*)(kg[i] + (size_t)(C) * 64 * NIN); VR[i] = *(const u32x4*)(vg[i] + (C) * 64); } } while (0)
#define ATT_WRITE(KR, VR, BUF) do { _Pragma("unroll") for (int i = 0; i < 2; ++i) { *(LAS u32x4*)(lds + AL_K + (BUF) * (64 * 272) + kl[i]) = KR[i]; *(LAS u32x4*)(lds + AL_V + (BUF) * (128 * 144) + vl[i]) = VR[i]; } } while (0)
    u32x4 kA[2], vA[2], kB[2], vB[2];
    ATT_LOAD(kA, vA, cbeg);
    ATT_LOAD(kB, vB, cbeg + 1);
    if (tid < 192) biasl[tid] = P.rel_bias[h * 192 + tid];
    bf16x8 Qb[4];
#pragma unroll
    for (int s = 0; s < 4; ++s) Qb[s] = ld8(proj + (size_t)qi * NIN + C_QB + h * DH + 32 * s + 8 * fq);
    ATT_WRITE(kA, vA, 0);
    __syncthreads();
    float mrun = -1e30f, lrun = 0.f;
    f32x4 Ot[8];
#pragma unroll
    for (int i = 0; i < 8; ++i) Ot[i] = (f32x4){0.f, 0.f, 0.f, 0.f};
#pragma unroll 1
    for (int c = cbeg; c <= cend; c += 2) {
        if (c + 2 <= cend) ATT_LOAD(kA, vA, c + 2);
        if (c >= nq - 8 && c <= nq) attn_compute(lds + AL_K, lds + AL_V, biasl, Qb, Ot, mrun, lrun, c, qi, fr, fq);
        if (c + 1 <= cend) ATT_WRITE(kB, vB, 1);
        __syncthreads();
        if (c + 1 > cend) break;
        if (c + 3 <= cend) ATT_LOAD(kB, vB, c + 3);
        if (c + 1 >= nq - 8 && c + 1 <= nq) attn_compute(lds + AL_K + 64 * 272, lds + AL_V + 128 * 144, biasl, Qb, Ot, mrun, lrun, c + 1, qi, fr, fq);
        if (c + 2 <= cend) ATT_WRITE(kA, vA, 0);
        __syncthreads();
    }
#undef ATT_LOAD
#undef ATT_WRITE
    lrun += __shfl_xor(lrun, 16); lrun += __shfl_xor(lrun, 32);
    const float inv = 1.f / lrun;
#pragma unroll
    for (int dt = 0; dt < 8; ++dt) { u32x2 w; w.x = pk2(Ot[dt][0] * inv, Ot[dt][1] * inv); w.y = pk2(Ot[dt][2] * inv, Ot[dt][3] * inv);
        *(u32x2*)(yb + (size_t)qi * 1024 + h * DH + 16 * dt + 4 * fq) = w; }
}

__device__ __forceinline__ void phase_gnorm(const Params& P, int G) {
    unsigned char* ws = P.ws;
    bf16_t* ya = (bf16_t*)(ws + WS_YA); const bf16_t* proj = (const bf16_t*)(ws + WS_PROJ);
    const int gt = blockIdx.x * 512 + opaque_tid(), l16 = gt & 15;
    const f32x4 w0 = *(const f32x4*)(P.gdn_norm + 8 * l16), w1 = *(const f32x4*)(P.gdn_norm + 8 * l16 + 4);
    const int stride = (G * 512) >> 4;
    for (int g0 = gt >> 4; g0 < M * NH; g0 += 8 * stride) {
        u32x4 ro[8], rz[8]; bf16_t* po[8];
#pragma unroll
        for (int q = 0; q < 8; ++q) { const int g = g0 + q * stride; const int row = g >> 3, h = g & 7;
            po[q] = ya + (size_t)row * 1024 + h * DH + 8 * l16;
            if (g < M * NH) { ro[q] = *(const u32x4*)po[q]; rz[q] = __builtin_nontemporal_load((const u32x4*)(proj + (size_t)row * NIN + C_Z + h * DH + 8 * l16)); } }
#pragma unroll
        for (int q = 0; q < 8; ++q) if (g0 + q * stride < M * NH) {
            float o[8], z[8]; unpack8(ro[q], o); unpack8(rz[q], z);
            float sq = 0.f;
#pragma unroll
            for (int e = 0; e < 8; ++e) sq += o[e] * o[e];
            sq += __shfl_xor(sq, 1); sq += __shfl_xor(sq, 2); sq += __shfl_xor(sq, 4); sq += __shfl_xor(sq, 8);
            const float rn = rsqrtf(sq * (1.f / DH) + EPS);
#pragma unroll
            for (int e = 0; e < 8; ++e) o[e] = o[e] * rn * (e < 4 ? w0[e] : w1[e - 4]) * siluf_(z[e]);
            *(u32x4*)po[q] = pack8f(o);
        }
    }
}

#define XB_TMO      128
#define XB_XCNT(j)  (256  + 64 * (j))
#define XB_XSUB(j)  (1280 + 64 * (j))
#define XB_XGEN(j)  (2304 + 64 * (j))
#define XB_TOP      3328
#define XB_TOPGEN   3392
#define XCD_BAR_WORDS 3456
#define XB_SPIN_CAP (1u << 18)
__device__ __forceinline__ unsigned xb_ld(unsigned* p)              { return __hip_atomic_load(p, __ATOMIC_RELAXED, __HIP_MEMORY_SCOPE_AGENT); }
__device__ __forceinline__ unsigned xb_add(unsigned* p, unsigned v) { return __hip_atomic_fetch_add(p, v, __ATOMIC_RELAXED, __HIP_MEMORY_SCOPE_AGENT); }
__device__ __forceinline__ unsigned xb_xcc_id() { return (unsigned)__builtin_amdgcn_s_getreg((3 << 11) | 20) & 0xFu; }
#define XB_SPIN(cond, bar) do { unsigned _sp = 0; while (cond) { __builtin_amdgcn_s_sleep(1); \
    if ((++_sp & 255u) == 0u) { if (xb_ld(&(bar)[XB_TMO])) break; if (_sp > XB_SPIN_CAP) { atomicAdd(&(bar)[XB_TMO], 1u); break; } } } } while (0)
struct XcdBarrier { unsigned* bar; unsigned x; volatile LAS unsigned* st; };
__device__ __forceinline__ XcdBarrier xcd_barrier_post(unsigned* bar, volatile LAS unsigned* st) {
    XcdBarrier b; b.bar = bar; b.x = xb_xcc_id(); b.st = st;
    if (threadIdx.x == 0) (void)xb_add(&bar[XB_XCNT(b.x)], 1u);
    return b;
}
__device__ __forceinline__ void xcd_barrier_complete(unsigned* bar, unsigned x, unsigned& nloc, unsigned& nx) {
    const unsigned G = gridDim.x * gridDim.y * gridDim.z;
    unsigned sum, cnt, mine, sp = 0u;
    for (;;) {
        sum = 0u; cnt = 0u; mine = 0u;
#pragma unroll
        for (unsigned j = 0; j < 16; ++j) { const unsigned c = xb_ld(&bar[XB_XCNT(j)]); sum += c; cnt += (c > 0u) ? 1u : 0u; mine = (j == x) ? c : mine; }
        if (sum == G) break;
        __builtin_amdgcn_s_sleep(1);
        if ((++sp & 255u) == 0u) { if (xb_ld(&bar[XB_TMO])) break; if (sp > XB_SPIN_CAP) { atomicAdd(&bar[XB_TMO], 1u); break; } }
    }
    nloc = mine > 0u ? mine : 1u; nx = cnt > 0u ? cnt : 1u;
}
__device__ __forceinline__ void xcd_barrier(const XcdBarrier& b) {
    asm volatile("s_waitcnt vmcnt(0)" ::: "memory");
    __syncthreads();
    if (threadIdx.x == 0) {
        unsigned* bar = b.bar;
        __builtin_amdgcn_s_waitcnt(0);
        unsigned nloc = b.st[0], nx = b.st[1];
        if (nloc == 0u) { xcd_barrier_complete(bar, b.x, nloc, nx); b.st[0] = nloc; b.st[1] = nx; }
        const unsigned old = xb_add(&bar[XB_XSUB(b.x)], 1u);
        const unsigned gen = old / nloc;
        if (old + 1u == (gen + 1u) * nloc) {
            __builtin_amdgcn_fence(__ATOMIC_RELEASE, "agent");
            asm volatile("s_waitcnt vmcnt(0)" ::: "memory");
            const unsigned og = xb_add(&bar[XB_TOP], 1u);
            const unsigned tg = og / nx;
            if (og + 1u == (tg + 1u) * nx) xb_add(&bar[XB_TOPGEN], 1u);
            else XB_SPIN(xb_ld(&bar[XB_TOPGEN]) == tg, bar);
            __builtin_amdgcn_fence(__ATOMIC_ACQUIRE, "agent");
            xb_add(&bar[XB_XGEN(b.x)], 1u);
            asm volatile("s_waitcnt vmcnt(0)" ::: "memory");
        } else {
            XB_SPIN(xb_ld(&bar[XB_XGEN(b.x)]) == gen, bar);
            __builtin_amdgcn_fence(__ATOMIC_ACQUIRE, "agent");
            asm volatile("s_waitcnt vmcnt(0)" ::: "memory");
        }
    }
    __syncthreads();
}

constexpr int NPHASE = 11;
__global__ void __launch_bounds__(512, 2) fwd_megakernel(Params P) {
    extern __shared__ __attribute__((aligned(16))) unsigned char smem[];
    LAS unsigned char* lds = (LAS unsigned char*)smem;
    cg::grid_group grid = cg::this_grid();
    const int G = gridDim.x, lo = P.ph_lo, hi = P.ph_hi & 255, pflags = P.ph_hi >> 8;
    unsigned char* ws = P.ws;
    float* ss = (float*)(ws + WS_SS);
    bf16_t* xb = (bf16_t*)(ws + WS_XB); bf16_t* act = (bf16_t*)(ws + WS_ACT); bf16_t* proj = (bf16_t*)(ws + WS_PROJ);
#ifndef NREP5
#define NREP5 1
#endif
#ifndef REP_PHASE
#define REP_PHASE -1
#endif
#define IN(k) (lo <= (k) && (k) < hi)
    volatile LAS unsigned* xst = (volatile LAS unsigned*)(lds + LDS_BYTES - 16);
    if (threadIdx.x == 0) { xst[0] = 0u; xst[1] = 0u; }
    __syncthreads();
    XcdBarrier xbar = xcd_barrier_post((unsigned*)(ws + WS_BAR), xst);
    if (lo < 0) grid.sync();
#define SEAM(k) do { if (IN(k) && IN((k) + 1)) xcd_barrier(xbar); } while (0)
    for (int rep = 0; rep < (REP_PHASE == 0 ? 2 : 1); ++rep) { if (IN(0)) phase_convert(P, lds, G);
    SEAM(0); }
    for (int rep = 0; rep < (REP_PHASE == 1 ? 2 : 1); ++rep) {
    if (IN(1)) { pg8::Sched S; S.init(xb, (const bf16_t*)(ws + WS_WGU1), nullptr, nullptr, M, NGU, G, blockIdx.x, 0); EpiGU E{act, ss}; pg8::gemm_phase(lds, D, S, E);
        idle_convert(P, lds, (M / 256) * (NGU / 256), G, -1, 0); }
    SEAM(1); }
    if (IN(2)) { pg8::Sched S; S.init(act, (const bf16_t*)(ws + WS_WD1), nullptr, nullptr, M, D, G, blockIdx.x, 0); EpiRes E{P.x, P.out, xb, ss + M, 0.5f}; pg8::gemm_phase(lds, FF, S, E); }
    SEAM(2);
    if (IN(3)) { pg8::Sched S; S.init(xb, (const bf16_t*)(ws + WS_WIN), nullptr, nullptr, M, NIN, G, blockIdx.x, 0); EpiProj E{proj, ss + M}; pg8::gemm_phase(lds, D, S, E);
        idle_convert(P, lds, (M / 256) * (NIN / 256), G, 0, LATE_A); }
    SEAM(3);
    if (IN(4)) { const int nit = (NCH * NH - 1 - (int)blockIdx.x) / G; for (int k = nit; k >= 0; --k) prep_item(P, lds, blockIdx.x + k * G, pflags); }
    SEAM(4);
_Pragma("unroll 1")
    for (int rep = 0; rep < NREP5; ++rep) {
    if (IN(5)) {
        const int tid5 = opaque_tid(), wave = tid5 >> 6, b = blockIdx.x;
        if (b < 64) { if (!(pflags & 4)) scan_wg(P, lds, b & 7, b >> 3, 0); }
        else { if (!(pflags & 2)) for (int it = b - 64; it < (NCH / 2) * NH; it += G - 64) attn_item(P, lds, it >> 3, it & 7);
            if (!(pflags & 1)) convert_late(P, (LAS float*)(lds + wave * 17408), ((((M / 256) * (NIN / 256)) % G) ? LATE_A : 0), ((((M / 256) * (NGU / 256)) % G) ? LATE_C : N_LATE), (b - 64) * 8 + wave, (G - 64) * 8, tid5 & 63); }
    }
    SEAM(5); }
    if (IN(6)) phase_gnorm(P, G);
    SEAM(6);
    if (IN(7)) { pg8::Sched S; S.init((const bf16_t*)(ws + WS_YA), (const bf16_t*)(ws + WS_WA), (const bf16_t*)(ws + WS_YB), (const bf16_t*)(ws + WS_WB), M, D, G, blockIdx.x, 1);
        EpiMix E{proj, (bf16_t*)(ws + WS_MIX)}; pg8::gemm_phase(lds, 1024, S, E); }
    SEAM(7);
    if (IN(8)) { pg8::Sched S; S.init((const bf16_t*)(ws + WS_MIX), (const bf16_t*)(ws + WS_WOUT), nullptr, nullptr, M, D, G, blockIdx.x, 0); EpiRes E{P.out, P.out, xb, ss + 2 * M, 1.0f}; pg8::gemm_phase(lds, D, S, E); }
    SEAM(8);
    if (IN(9)) { pg8::Sched S; S.init(xb, (const bf16_t*)(ws + WS_WGU2), nullptr, nullptr, M, NGU, G, blockIdx.x, 0); EpiGU E{act, ss + 2 * M}; pg8::gemm_phase(lds, D, S, E);
        idle_convert(P, lds, (M / 256) * (NGU / 256), G, LATE_C, N_LATE); }
    SEAM(9);
    if (IN(10)) { pg8::Sched S; S.init(act, (const bf16_t*)(ws + WS_WD2), nullptr, nullptr, M, D, G, blockIdx.x, 0); EpiRes E{P.out, P.out, xb, ss + 3 * M, 0.5f}; pg8::gemm_phase(lds, FF, S, E); }
    SEAM(10);
    if (IN(11)) {
        { pg8::Sched S; S.init((const bf16_t*)(ws + WS_PB), (const bf16_t*)(ws + WS_WPP), nullptr, nullptr, M, D, G, blockIdx.x, 0); EpiF32 E{(float*)(ws + WS_RBUF)}; pg8::gemm_phase(lds, PLE, S, E); }
        { pg8::Sched S; S.init(xb, (const bf16_t*)(ws + WS_WPG), nullptr, nullptr, M, D, G, blockIdx.x, 0); EpiPle E{P.out, (const float*)(ws + WS_RBUF), ss + 3 * M}; pg8::gemm_phase(lds, D, S, E); }
    }
#undef IN
#undef SEAM
}


#ifdef PROBE_VAR
__global__ void __launch_bounds__(512, 2) probe_scan(Params P) {
    extern __shared__ __attribute__((aligned(16))) unsigned char smem[];
    scan_wg(P, (LAS unsigned char*)smem, blockIdx.x & 7, blockIdx.x >> 3, PROBE_VAR);
}
#endif
#ifndef N_LAUNCH_MODE
#define N_LAUNCH_MODE 0
#endif
extern "C" void kernel_launch(void* const* d_in, const int* in_sizes, int n_in, void* d_out, int out_size, void* d_ws, size_t ws_size, hipStream_t stream) {
    static int grid = 0;
    if (grid == 0) {
        if (n_in != 23 || out_size != M * D || ws_size < WS_END) { fprintf(stderr, "kernel_launch: unexpected problem (n_in %d out %d ws %zu need %zu)\n", n_in, out_size, ws_size, (size_t)WS_END); grid = -1; return; }
        int dev = 0, cus = 0, per_cu = 0;
        hipGetDevice(&dev); hipDeviceGetAttribute(&cus, hipDeviceAttributeMultiprocessorCount, dev);
        if (hipFuncSetAttribute((const void*)fwd_megakernel, hipFuncAttributeMaxDynamicSharedMemorySize, LDS_BYTES) != hipSuccess) { fprintf(stderr, "kernel_launch: hipFuncSetAttribute failed\n"); grid = -1; return; }
        if (hipOccupancyMaxActiveBlocksPerMultiprocessor(&per_cu, (const void*)fwd_megakernel, 512, LDS_BYTES) != hipSuccess || per_cu < 1) { fprintf(stderr, "kernel_launch: occupancy query failed (%d)\n", per_cu); (void)hipGetLastError(); per_cu = 1; }
        grid = cus * 1;
        if (grid < 192) { fprintf(stderr, "kernel_launch: grid too small\n"); grid = -1; return; }
    }
    if (grid < 0) return;
    if (hipMemsetAsync((char*)d_ws + WS_BAR, 0, 16384, stream) != hipSuccess) { fprintf(stderr, "kernel_launch: memset of the barrier words failed\n"); return; }
    Params p{};
    const float** pp = (const float**)&p;
    for (int i = 0; i < 23; ++i) pp[i] = (const float*)d_in[i];
    p.out = (float*)d_out; p.ws = (unsigned char*)d_ws;
#if N_LAUNCH_MODE == 0
    p.ph_lo = 0; p.ph_hi = NPHASE + 1;
    void* args[] = {&p};
    hipError_t e = hipLaunchCooperativeKernel((const void*)fwd_megakernel, dim3(grid), dim3(512), args, LDS_BYTES, stream);
    if (e != hipSuccess) fprintf(stderr, "cooperative launch failed: %s (grid %d)\n", hipGetErrorString(e), grid);
#ifdef PROBE_VAR
    hipLaunchKernelGGL(probe_scan, dim3(64), dim3(512), 16384, stream, p);
#endif
#ifdef PROBE_PHASE
    p.ph_lo = PROBE_PHASE; p.ph_hi = (PROBE_PHASE + 1) | (PROBE_FLAGS << 8); hipLaunchKernelGGL(fwd_megakernel, dim3(grid), dim3(512), LDS_BYTES, stream, p);
#endif
#else
    for (int ph = 0; ph <= NPHASE; ++ph) { p.ph_lo = ph; p.ph_hi = ph + 1; hipLaunchKernelGGL(fwd_megakernel, dim3(grid), dim3(512), LDS_BYTES, stream, p); }
#endif
}
```
